# Optimizing an MI355X kernel written in HIP

```python
import jax
import jax.numpy as jnp
from jax import lax
import numpy as np

D_MODEL = 2048
BATCH = 1
SEQ = 8192
DEPTH = 4

MLSTM_WIDTH = D_MODEL // 2
MLSTM_HEADS = 4
MLSTM_HEAD_DIM = MLSTM_WIDTH // MLSTM_HEADS
MLSTM_CHUNK = 64
MOBA_WIDTH = D_MODEL // 2
MOBA_HEADS = 8
MOBA_HEAD_DIM = MOBA_WIDTH // MOBA_HEADS
MOBA_BLOCK = 256
MOBA_TOPK = 3
MOBA_QCHUNK = 64
LRU_WIDTH = D_MODEL // 2
LRU_BLOCKS = 8
LRU_BLOCK_DIM = LRU_WIDTH // LRU_BLOCKS
LRU_CONV = 4
LRU_C = 8.0
D_FF = ((8 * D_MODEL // 3 + 127) // 128) * 128
EPS = 1e-6
IN_SPLITS = (MLSTM_WIDTH, MLSTM_WIDTH, MLSTM_WIDTH, MLSTM_WIDTH, MLSTM_HEADS, MLSTM_HEADS, MOBA_WIDTH, MOBA_WIDTH, MOBA_WIDTH, LRU_WIDTH, LRU_WIDTH, D_MODEL, D_MODEL, D_MODEL)
N_IN = sum(IN_SPLITS)

kernel_name = 'hybrid_mlstm_moba_rglru_macaron'


def rms_norm(x, g):
    xf = x.astype(jnp.float32)
    y = xf * lax.rsqrt(jnp.mean(xf * xf, axis=-1, keepdims=True) + EPS)
    return (y * g.astype(jnp.float32)).astype(x.dtype)


def swiglu(h, w_gate, w_up, w_down):
    return (jax.nn.silu(h @ w_gate) * (h @ w_up)) @ w_down


def to_heads(t, n_heads):
    b, s, w = t.shape
    return t.reshape(b, s, n_heads, w // n_heads).transpose(0, 2, 1, 3)


def from_heads(t):
    b, h, s, d = t.shape
    return t.transpose(0, 2, 1, 3).reshape(b, s, h * d)


def mlstm_chunkwise(q, k, v, i_pre, log_f):
    b, h, s, d = q.shape
    nc = s // MLSTM_CHUNK

    def to_chunks(t):
        return jnp.moveaxis(t.reshape(b, h, nc, MLSTM_CHUNK, *t.shape[3:]), 2, 0)

    causal = jnp.tril(jnp.ones((MLSTM_CHUNK, MLSTM_CHUNK), dtype=bool))

    def step(carry, inp):
        c_state, n_state, m_state = carry
        qc, kc, vc, ic, fc = inp
        bcum = jnp.cumsum(fc, axis=-1)
        d_intra = jnp.where(causal, bcum[..., :, None] - bcum[..., None, :] + ic[..., None, :], -jnp.inf)
        d_inter = bcum + m_state[..., None]
        m_t = jnp.maximum(jnp.max(d_intra, axis=-1), d_inter)
        w_intra = jnp.exp(d_intra - m_t[..., None])
        w_inter = jnp.exp(d_inter - m_t)
        sc = jnp.einsum('bhtd,bhsd->bhts', qc, kc) * w_intra
        num = jnp.einsum('bhts,bhsd->bhtd', sc, vc) + w_inter[..., None] * jnp.einsum('bhtk,bhvk->bhtv', qc, c_state)
        den = jnp.sum(sc, axis=-1) + w_inter * jnp.einsum('bhtk,bhk->bht', qc, n_state)
        h_out = num / jnp.maximum(jnp.abs(den), jnp.exp(-m_t))[..., None]
        b_last = bcum[..., -1]
        g = b_last[..., None] - bcum + ic
        m_new = jnp.maximum(b_last + m_state, jnp.max(g, axis=-1))
        decay = jnp.exp(b_last + m_state - m_new)
        w = jnp.exp(g - m_new[..., None])
        c_new = decay[..., None, None] * c_state + jnp.einsum('bhs,bhsv,bhsk->bhvk', w, vc, kc)
        n_new = decay[..., None] * n_state + jnp.einsum('bhs,bhsk->bhk', w, kc)
        return (c_new, n_new, m_new), h_out

    init = (jnp.zeros((b, h, d, d), jnp.float32), jnp.zeros((b, h, d), jnp.float32), jnp.zeros((b, h), jnp.float32))
    _, hs = lax.scan(step, init, (to_chunks(q), to_chunks(k), to_chunks(v), to_chunks(i_pre), to_chunks(log_f)))
    return jnp.moveaxis(hs, 0, 2).reshape(b, h, s, d)


def mlstm_branch(q, k, v, o_pre, i_pre, f_pre, b_i, b_f, head_gain):
    f32 = jnp.float32
    qh = to_heads(q.astype(f32), MLSTM_HEADS)
    kh = to_heads(k.astype(f32), MLSTM_HEADS) * (MLSTM_HEAD_DIM ** -0.5)
    vh = to_heads(v.astype(f32), MLSTM_HEADS)
    ig = (i_pre.astype(f32) + b_i.astype(f32)).transpose(0, 2, 1)
    lf = jax.nn.log_sigmoid(f_pre.astype(f32) + b_f.astype(f32)).transpose(0, 2, 1)
    hh = mlstm_chunkwise(qh, kh, vh, ig, lf)
    hh = hh * lax.rsqrt(jnp.mean(hh * hh, axis=-1, keepdims=True) + EPS)
    hh = from_heads(hh) * head_gain.astype(f32)
    return (jax.nn.sigmoid(o_pre.astype(f32)) * hh).astype(q.dtype)


def moba_attention(q, k, v):
    f32 = jnp.float32
    b, h, s, d = q.shape
    n_blk = -(-s // MOBA_BLOCK)
    s_pad = n_blk * MOBA_BLOCK
    pad = ((0, 0), (0, 0), (0, s_pad - s), (0, 0))
    q, k, v = jnp.pad(q, pad), jnp.pad(k, pad), jnp.pad(v, pad)
    kb = k.reshape(b, h, n_blk, MOBA_BLOCK, d)
    vb = v.reshape(b, h, n_blk, MOBA_BLOCK, d)
    k_mean = jnp.mean(kb.astype(f32), axis=3)
    q_blk = jnp.arange(s_pad) // MOBA_BLOCK
    past = jnp.arange(n_blk)[None, :] < q_blk[:, None]
    gate = jnp.einsum('bhtd,bhnd->bhtn', q.astype(f32), k_mean)
    gate = jnp.where(past, gate, -jnp.inf)
    top_k = min(MOBA_TOPK, n_blk)
    _, sel = lax.top_k(gate, top_k)
    sel_valid = sel < q_blk[None, None, :, None]
    scale = d ** -0.5
    bi = jnp.arange(b)[:, None, None, None]
    hi = jnp.arange(h)[None, :, None, None]

    def one_block(c):
        start = c * MOBA_QCHUNK
        qc = lax.dynamic_slice_in_dim(q, start, MOBA_QCHUNK, axis=2)
        sc = lax.dynamic_slice_in_dim(sel, start, MOBA_QCHUNK, axis=2)
        ok = lax.dynamic_slice_in_dim(sel_valid, start, MOBA_QCHUNK, axis=2)
        k_sel = kb[bi, hi, sc]
        v_sel = vb[bi, hi, sc]
        s_sel = jnp.einsum('bhqd,bhqnkd->bhqnk', qc, k_sel).astype(f32) * scale
        s_sel = jnp.where(ok[..., None], s_sel, -jnp.inf).reshape(b, h, MOBA_QCHUNK, top_k * MOBA_BLOCK)
        own = start // MOBA_BLOCK
        k_own = lax.dynamic_index_in_dim(kb, own, axis=2, keepdims=False)
        v_own = lax.dynamic_index_in_dim(vb, own, axis=2, keepdims=False)
        s_own = jnp.einsum('bhqd,bhkd->bhqk', qc, k_own).astype(f32) * scale
        q_pos = start + jnp.arange(MOBA_QCHUNK)
        k_pos = own * MOBA_BLOCK + jnp.arange(MOBA_BLOCK)
        s_own = jnp.where(k_pos[None, :] <= q_pos[:, None], s_own, -jnp.inf)
        p = jax.nn.softmax(jnp.concatenate([s_sel, s_own], axis=-1), axis=-1).astype(v.dtype)
        p_sel = p[..., :top_k * MOBA_BLOCK].reshape(b, h, MOBA_QCHUNK, top_k, MOBA_BLOCK)
        p_own = p[..., top_k * MOBA_BLOCK:]
        return jnp.einsum('bhqnk,bhqnkd->bhqd', p_sel, v_sel) + jnp.einsum('bhqk,bhkd->bhqd', p_own, v_own)

    out = lax.map(one_block, jnp.arange(s_pad // MOBA_QCHUNK))
    out = jnp.moveaxis(out, 0, 2).reshape(b, h, s_pad, d)
    return out[:, :, :s]


def moba_branch(q, k, v):
    return from_heads(moba_attention(to_heads(q, MOBA_HEADS), to_heads(k, MOBA_HEADS), to_heads(v, MOBA_HEADS)))


def linear_recurrence_combine(e1, e2):
    a1, b1 = e1
    a2, b2 = e2
    return a1 * a2, a2 * b1 + b2


def rglru_branch(xr, gate, conv_w, conv_b, w_a, b_a, w_x, b_x, lam):
    f32 = jnp.float32
    b, s, c = xr.shape
    xc = lax.conv_general_dilated(xr, conv_w[:, None, :], window_strides=(1,), padding=[(LRU_CONV - 1, 0)], dimension_numbers=('NWC', 'WIO', 'NWC'), feature_group_count=c) + conv_b

    def block_diag(t, w, bias):
        return jnp.einsum('bsnc,ncd->bsnd', t.reshape(b, s, LRU_BLOCKS, LRU_BLOCK_DIM), w).reshape(b, s, c) + bias

    r = jax.nn.sigmoid(block_diag(xc, w_a, b_a).astype(f32))
    i = jax.nn.sigmoid(block_diag(xc, w_x, b_x).astype(f32))
    log_a = -LRU_C * r * jax.nn.softplus(-lam.astype(f32))
    a = jnp.exp(log_a)
    u = jnp.sqrt(-jnp.expm1(2.0 * log_a)) * (i * xc.astype(f32))
    _, hseq = lax.associative_scan(linear_recurrence_combine, (a, u), axis=1)
    return (hseq * jax.nn.gelu(gate.astype(f32))).astype(xr.dtype)


def setup_inputs(seed: int = 0) -> dict:
    key = jax.random.key(seed)
    ks = iter(jax.random.split(key, 40))
    f32 = jnp.float32
    L = DEPTH

    def nrm(shape, fan_in):
        return jax.random.normal(next(ks), shape, f32) * (fan_in ** -0.5)

    def gain(shape):
        return 1.0 + 0.01 * jax.random.normal(next(ks), shape, f32)

    def small(shape, scale=0.01):
        return scale * jax.random.normal(next(ks), shape, f32)

    x = jax.random.normal(next(ks), (BATCH, SEQ, D_MODEL), f32)
    ffn1_norm = gain((L, D_MODEL))
    ffn1_w_gate = nrm((L, D_MODEL, D_FF), D_MODEL)
    ffn1_w_up = nrm((L, D_MODEL, D_FF), D_MODEL)
    ffn1_w_down = nrm((L, D_FF, D_MODEL), D_FF)
    mix_norm = gain((L, D_MODEL))
    w_in = nrm((L, D_MODEL, N_IN), D_MODEL)
    mlstm_b_i = small((L, MLSTM_HEADS), 0.1)
    mlstm_b_f = jnp.linspace(3.0, 6.0, MLSTM_HEADS, dtype=f32)[None, :] + small((L, MLSTM_HEADS), 0.1)
    mlstm_head_norm = gain((L, MLSTM_WIDTH))
    lru_conv_w = nrm((L, LRU_CONV, LRU_WIDTH), LRU_CONV)
    lru_conv_b = small((L, LRU_WIDTH))
    lru_w_a = nrm((L, LRU_BLOCKS, LRU_BLOCK_DIM, LRU_BLOCK_DIM), LRU_BLOCK_DIM)
    lru_b_a = small((L, LRU_WIDTH))
    lru_w_x = nrm((L, LRU_BLOCKS, LRU_BLOCK_DIM, LRU_BLOCK_DIM), LRU_BLOCK_DIM)
    lru_b_x = small((L, LRU_WIDTH))
    a0 = jax.random.uniform(next(ks), (L, LRU_WIDTH), f32, 0.9, 0.999)
    p0 = a0 ** (1.0 / LRU_C)
    lru_lambda = jnp.log(p0) - jnp.log1p(-p0)
    w_up_a = nrm((L, MLSTM_WIDTH, D_MODEL), MLSTM_WIDTH)
    w_up_b = nrm((L, MOBA_WIDTH, D_MODEL), MOBA_WIDTH)
    w_up_c = nrm((L, LRU_WIDTH, D_MODEL), LRU_WIDTH)
    w_out = nrm((L, D_MODEL, D_MODEL), D_MODEL)
    ffn2_norm = gain((L, D_MODEL))
    ffn2_w_gate = nrm((L, D_MODEL, D_FF), D_MODEL)
    ffn2_w_up = nrm((L, D_MODEL, D_FF), D_MODEL)
    ffn2_w_down = nrm((L, D_FF, D_MODEL), D_FF)
    final_norm = gain((D_MODEL,))
    return {'x': x, 'ffn1_norm': ffn1_norm, 'ffn1_w_gate': ffn1_w_gate, 'ffn1_w_up': ffn1_w_up, 'ffn1_w_down': ffn1_w_down,
            'mix_norm': mix_norm, 'w_in': w_in, 'mlstm_b_i': mlstm_b_i, 'mlstm_b_f': mlstm_b_f, 'mlstm_head_norm': mlstm_head_norm,
            'lru_conv_w': lru_conv_w, 'lru_conv_b': lru_conv_b, 'lru_w_a': lru_w_a, 'lru_b_a': lru_b_a, 'lru_w_x': lru_w_x,
            'lru_b_x': lru_b_x, 'lru_lambda': lru_lambda, 'w_up_a': w_up_a, 'w_up_b': w_up_b, 'w_up_c': w_up_c, 'w_out': w_out,
            'ffn2_norm': ffn2_norm, 'ffn2_w_gate': ffn2_w_gate, 'ffn2_w_up': ffn2_w_up, 'ffn2_w_down': ffn2_w_down,
            'final_norm': final_norm}


def reference(x, ffn1_norm, ffn1_w_gate, ffn1_w_up, ffn1_w_down, mix_norm, w_in, mlstm_b_i, mlstm_b_f, mlstm_head_norm,
              lru_conv_w, lru_conv_b, lru_w_a, lru_b_a, lru_w_x, lru_b_x, lru_lambda, w_up_a, w_up_b, w_up_c, w_out,
              ffn2_norm, ffn2_w_gate, ffn2_w_up, ffn2_w_down, final_norm):
    split_points = np.cumsum(np.array(IN_SPLITS))[:-1].tolist()
    for l in range(DEPTH):
        x = x + 0.5 * swiglu(rms_norm(x, ffn1_norm[l]), ffn1_w_gate[l], ffn1_w_up[l], ffn1_w_down[l])
        h = rms_norm(x, mix_norm[l])
        z = h @ w_in[l]
        (aq, ak, av, ao, ai, af, bq, bk, bv, cx, cg, ga, gb, gc) = jnp.split(z, split_points, axis=-1)
        y_a = mlstm_branch(aq, ak, av, ao, ai, af, mlstm_b_i[l], mlstm_b_f[l], mlstm_head_norm[l]) @ w_up_a[l]
        y_b = moba_branch(bq, bk, bv) @ w_up_b[l]
        y_c = rglru_branch(cx, cg, lru_conv_w[l], lru_conv_b[l], lru_w_a[l], lru_b_a[l], lru_w_x[l], lru_b_x[l], lru_lambda[l]) @ w_up_c[l]
        merged = jax.nn.sigmoid(ga) * y_a + jax.nn.sigmoid(gb) * y_b + jax.nn.sigmoid(gc) * y_c
        x = x + merged @ w_out[l]
        x = x + 0.5 * swiglu(rms_norm(x, ffn2_norm[l]), ffn2_w_gate[l], ffn2_w_up[l], ffn2_w_down[l])
    return rms_norm(x, final_norm)
```

```cpp
#include <hip/hip_runtime.h>
#include <cstdio>
#include <cstdint>
#include <cstring>
#define LAS __attribute__((address_space(3)))
typedef unsigned short bf16;
constexpr int T_SEQ = 8192, DM = 2048, DFF = 5504, NLAYER = 4;
constexpr int NGU = 2 * DFF;
constexpr int NZ = 13312;
constexpr int NZP = 15616;
constexpr int NZT = 2048;
constexpr int Z_AQ = 0, Z_AK = 1024, Z_AO = 2048, Z_BQ = 3072, Z_BK = 4096, Z_CX = 5120, Z_CG = 6144, Z_GA = 7168, Z_GB = 9216, Z_GC = 11264;
constexpr int ZT_AV = 0, ZT_BV = 1024;
constexpr float RMS_EPS = 1e-6f;
__device__ __forceinline__ float bf2f(unsigned short b) { return __uint_as_float(((unsigned)b) << 16); }
__device__ __forceinline__ unsigned short f2bf(float f) { unsigned u = __float_as_uint(f); return (unsigned short)((u + 0x7fffu + ((u >> 16) & 1u)) >> 16); }
__device__ __forceinline__ float sigmoidf_(float x) { return 1.f / (1.f + __expf(-x)); }
__device__ __forceinline__ float lo_bf(unsigned w) { return __uint_as_float(w << 16); }
__device__ __forceinline__ float hi_bf(unsigned w) { return __uint_as_float(w & 0xffff0000u); }
__device__ __forceinline__ int win_src_col(int n) {
    if (n < 2048) return n;
    if (n < 3072) return 3072 + (n - 2048);
    if (n < 5120) return n + 1032;
    if (n < 13312) return n + 2056;
    if (n < 13320) return 4096 + (n - 13312);
    if (n < 13568) return -1;
    if (n < 14592) return 2048 + (n - 13568);
    return 6152 + (n - 14592);
}
#define MIX_LRU 1
#define MIX_ML 1
#define MIX_MOBA 1
namespace pg8 {
#define PG8_LAS __attribute__((address_space(3)))
typedef unsigned short bf16_t;
typedef short bf16x8 __attribute__((ext_vector_type(8)));
typedef float f32x4 __attribute__((ext_vector_type(4)));
typedef unsigned u32x4 __attribute__((ext_vector_type(4)));
constexpr int BM = 256, BK = 64, HALF = 128, HTB = HALF * BK * 2  , STAGE_BYTES = 8 * HTB, NXCD = 8, WGM = 8;

__host__ __device__ __forceinline__ int lds_byte(int r, int c) { const int st = (r >> 4) * 2 + (c >> 5), rr = r & 15, cc = c & 31, ob = rr * 64 + cc * 2; return st * 1024 + (ob ^ (((ob >> 9) & 1) << 5)); }
__host__ __device__ __forceinline__ void stage_rc(int b, int& R, int& C) { const int st = b / 1024, sb = b % 1024, swz = sb ^ (((sb >> 9) & 1) << 5); R = (st >> 1) * 16 + swz / 64; C = (st & 1) * 32 + (swz % 64) / 2; }
__host__ __device__ __forceinline__ int perm32(int rho) { const int n = rho >> 4, i = rho & 15; return 8 * (i >> 2) + 4 * n + (i & 3); }

struct Unit { int pm, pn, aux; };
struct Gemm { const bf16_t* A; const bf16_t* Bt; int M, N, K; };

struct StaticOrder {
    int nM, nN, nwg, G, c;
    __host__ __device__ void init(int M, int N, int G_, int c_) { nM = M / BM; nN = N / BM; nwg = nM * nN; G = G_; c = c_; }
    __host__ __device__ __forceinline__ bool next(int i, Unit& u) const {
        const long L = (long)i * G + c; if (L >= nwg) return false;
        int wgid = (int)L; { const int q = nwg / NXCD, r = nwg % NXCD, xcd = wgid % NXCD, off = wgid / NXCD; wgid = (xcd < r ? xcd * (q + 1) : r * (q + 1) + (xcd - r) * q) + off; }
        const int nig = WGM * nN, gid = wgid / nig, fm = gid * WGM, gsz = (nM - fm) < WGM ? (nM - fm) : WGM;
        u.pm = fm + ((wgid % nig) % gsz); u.pn = (wgid % nig) / gsz; u.aux = 0; return true;
    }
    __device__ __forceinline__ void bases(const Gemm& g, const Unit& u, size_t tstep, const char*& a, const char*& b) const { a = (const char*)g.A + (size_t)u.pm * tstep; b = (const char*)g.Bt + (size_t)u.pn * tstep; }
    __device__ __forceinline__ void a_ready(const Unit&) const {}
    __device__ __forceinline__ void done(const Unit&) const {}
};
__device__ __forceinline__ unsigned cvt_pk_bf16(float lo, float hi) { unsigned r; asm volatile("v_cvt_pk_bf16_f32 %0, %1, %2" : "=v"(r) : "v"(lo), "v"(hi)); return r; }
typedef float f32x2 __attribute__((ext_vector_type(2)));
typedef unsigned u32x2 __attribute__((ext_vector_type(2)));
__device__ __forceinline__ float fast_sigmoid(float x) { return __builtin_amdgcn_rcpf(1.f + __expf(-x)); }
__device__ __forceinline__ void row_rstd8(const PG8_LAS float* tab, int rloc, float (&rs)[2][4]) {
#pragma unroll
    for (int ai = 0; ai < 2; ++ai)
#pragma unroll
        for (int m = 0; m < 4; ++m) rs[ai][m] = tab[rloc + ai * HALF + m * 16];
}
__device__ __forceinline__ void rstd_table(const float* SSQ, PG8_LAS float* tab, int panel, int tid) {
    asm volatile("" : "+v"(tid));
    const float* p = SSQ + ((size_t)panel * BM + (tid >> 1)) * 32 + (tid & 1) * 16; float t = 0.f;
#pragma unroll
    for (int q = 0; q < 4; ++q) { const f32x4 a = *(const f32x4*)(p + 4 * q); t += (a[0] + a[1]) + (a[2] + a[3]); }
    t += __shfl_xor(t, 1);
    if ((tid & 1) == 0) tab[tid >> 1] = __builtin_amdgcn_rsqf(t * (1.f / 2048.f) + 1e-6f);
    asm volatile("s_waitcnt lgkmcnt(0)" ::: "memory"); __builtin_amdgcn_s_barrier(); asm volatile("" ::: "memory");
}
struct EpiSwiGLU {
    static constexpr bool PERM = true, AFTER_DRAIN = false;
    bf16_t* O; const float* SSQ; const PG8_LAS float* tab; int ldc; int panel;
    __device__ __forceinline__ void operator()(const f32x4 (&acc)[2][2][4][2], const Unit& u, int wr, int wc, int fr, int fq) const {
        const int row0 = u.pm * BM + wr * 64 + fr, col0 = u.pn * HALF + wc * 32 + 8 * fq;
        float rs[2][4]; row_rstd8(tab, wr * 64 + fr, rs);
#pragma unroll
        for (int ai = 0; ai < 2; ++ai)
#pragma unroll
            for (int m = 0; m < 4; ++m) { bf16_t* rowp = O + (size_t)(row0 + ai * HALF + m * 16) * ldc + col0;
                const f32x2 r2 = (f32x2){rs[ai][m], rs[ai][m]}; f32x2 h2[4];
#pragma unroll
                for (int n = 0; n < 2; ++n)
#pragma unroll
                    for (int q = 0; q < 2; ++q) { const f32x2 g = (f32x2){acc[ai][0][m][n][2 * q], acc[ai][0][m][n][2 * q + 1]} * r2, up = (f32x2){acc[ai][1][m][n][2 * q], acc[ai][1][m][n][2 * q + 1]} * r2;
                        const f32x2 t = g * (-1.4426950408889634f); f32x2 d; d.x = __builtin_amdgcn_exp2f(t.x); d.y = __builtin_amdgcn_exp2f(t.y); d = d + 1.0f;
                        f32x2 rc; rc.x = __builtin_amdgcn_rcpf(d.x); rc.y = __builtin_amdgcn_rcpf(d.y); h2[n * 2 + q] = (g * up) * rc; }
                u32x4 w; w.x = cvt_pk_bf16(h2[0].x, h2[0].y); w.y = cvt_pk_bf16(h2[1].x, h2[1].y); w.z = cvt_pk_bf16(h2[2].x, h2[2].y); w.w = cvt_pk_bf16(h2[3].x, h2[3].y);
                *(u32x4*)rowp = w; }
    }
};
struct EpiResAdd {
    static constexpr bool PERM = false, AFTER_DRAIN = false;
    float* X; bf16_t* XB; float* SSQ; int ldc; float alpha;
    __device__ __forceinline__ void operator()(const f32x4 (&acc)[2][2][4][2], const Unit& u, int wr, int wc, int fr, int fq) const {
        const int row0 = u.pm * BM + wr * 64 + fr, col0 = u.pn * BM + wc * 32 + 4 * fq;
#pragma unroll
        for (int ai = 0; ai < 2; ++ai)
#pragma unroll
            for (int m = 0; m < 4; ++m) { const size_t row = (size_t)(row0 + ai * HALF + m * 16); float* rowp = X + row * ldc + col0; bf16_t* rowb = XB + row * ldc + col0; float ss = 0.f;
#pragma unroll
                for (int bj = 0; bj < 2; ++bj)
#pragma unroll
                    for (int n = 0; n < 2; ++n) { f32x4* p = (f32x4*)(rowp + bj * HALF + n * 16); const f32x4 v = *p + acc[ai][bj][m][n] * alpha; *p = v;
                        ss += (v[0] * v[0] + v[1] * v[1]) + (v[2] * v[2] + v[3] * v[3]);
                        u32x2 w; w.x = cvt_pk_bf16(v[0], v[1]); w.y = cvt_pk_bf16(v[2], v[3]); *(u32x2*)(rowb + bj * HALF + n * 16) = w; }
                ss += __shfl_xor(ss, 16); ss += __shfl_xor(ss, 32);
                if (fq == 0) SSQ[row * 32 + u.pn * 4 + wc] = ss; }
    }
};
struct EpiZ {
    static constexpr bool PERM = true, AFTER_DRAIN = false;
    bf16_t* Z; float* G; bf16_t* ZT; const float* SSQ; const PG8_LAS float* tab; int ldz; int ldt; int panel; int pad;
    __device__ __forceinline__ void operator()(const f32x4 (&acc)[2][2][4][2], const Unit& u, int wr, int wc, int fr, int fq) const {
        const int row0 = u.pm * BM + wr * 64 + fr;
        if (u.aux == 0) {
            float rs[2][4]; row_rstd8(tab, wr * 64 + fr, rs);
            const int col0 = u.pn * BM + wc * 64 + 8 * fq;
#pragma unroll
            for (int ai = 0; ai < 2; ++ai)
#pragma unroll
                for (int m = 0; m < 4; ++m) { bf16_t* rowp = Z + (size_t)(row0 + ai * HALF + m * 16) * ldz + col0; const float r = rs[ai][m];
#pragma unroll
                    for (int bj = 0; bj < 2; ++bj) { const f32x4 v0 = acc[ai][bj][m][0] * r, v1 = acc[ai][bj][m][1] * r;
                        u32x4 w; w.x = cvt_pk_bf16(v0[0], v0[1]); w.y = cvt_pk_bf16(v0[2], v0[3]); w.z = cvt_pk_bf16(v1[0], v1[1]); w.w = cvt_pk_bf16(v1[2], v1[3]);
                        *(u32x4*)(rowp + bj * 32) = w; } }
        } else if (u.aux == 1) {
            float rs[2][4]; row_rstd8(tab, wr * 64 + fr, rs);
            if (wc == 0 && fq == 0) {
#pragma unroll
                for (int ai = 0; ai < 2; ++ai)
#pragma unroll
                    for (int m = 0; m < 4; ++m) { float* gp = G + (size_t)(row0 + ai * HALF + m * 16) * 8;
                        *(f32x4*)gp = acc[ai][0][m][0] * rs[ai][m]; *(f32x4*)(gp + 4) = acc[ai][0][m][1] * rs[ai][m]; } }
        } else {
            const int tb = u.pn * BM + wc * 32 + 8 * fq; float rt[16];
#pragma unroll
            for (int j = 0; j < 16; ++j) rt[j] = tab[wc * 32 + 8 * fq + 128 * (j >> 3) + (j & 7)];
            const int col0 = tb;
#pragma unroll
            for (int ai = 0; ai < 2; ++ai)
#pragma unroll
                for (int m = 0; m < 4; ++m) { bf16_t* rowp = ZT + (size_t)(row0 + ai * HALF + m * 16) * ldt + col0;
#pragma unroll
                    for (int bj = 0; bj < 2; ++bj) { const f32x4 v0 = acc[ai][bj][m][0], v1 = acc[ai][bj][m][1];
                        u32x4 w; w.x = cvt_pk_bf16(v0[0] * rt[8 * bj], v0[1] * rt[8 * bj + 1]); w.y = cvt_pk_bf16(v0[2] * rt[8 * bj + 2], v0[3] * rt[8 * bj + 3]);
                        w.z = cvt_pk_bf16(v1[0] * rt[8 * bj + 4], v1[1] * rt[8 * bj + 5]); w.w = cvt_pk_bf16(v1[2] * rt[8 * bj + 6], v1[3] * rt[8 * bj + 7]);
                        *(u32x4*)(rowp + bj * HALF) = w; } }
        }
    }
};
struct ZOrder : StaticOrder {
    __device__ __forceinline__ bool next(int i, Unit& u) const {
        if (!StaticOrder::next(i, u)) return false;
        const int v = u.pn;
        if (v < 52) u.aux = 0; else if (v == 52) u.aux = 1; else { u.aux = 2; u.pn = u.pm; u.pm = v - 53; }
        return true;
    }
    __device__ __forceinline__ void bases(const Gemm& g, const Unit& u, size_t tstep, const char*& a, const char*& b) const {
        if (u.aux == 2) { a = (const char*)g.Bt + (size_t)(53 + u.pm) * tstep; b = (const char*)g.A + (size_t)u.pn * tstep; }
        else { a = (const char*)g.A + (size_t)u.pm * tstep; b = (const char*)g.Bt + (size_t)u.pn * tstep; }
    }
};
struct EpiMerge {
    static constexpr bool PERM = true, AFTER_DRAIN = false;
    bf16_t* MG; const bf16_t* Zg; int ldm; int ldz; int gstride; int pad;
    __device__ __forceinline__ void operator()(const f32x4 (&acc)[2][2][4][2], const Unit& u, int wr, int wc, int fr, int fq) const {
        const int row0 = u.pm * BM + wr * 64 + fr, col0 = u.pn * BM + wc * 32 + 8 * fq; const bool first = (u.aux == 0); const bf16_t* zg = Zg + (size_t)u.aux * gstride;
#pragma unroll
        for (int ai = 0; ai < 2; ++ai)
#pragma unroll
            for (int m = 0; m < 4; ++m) { const size_t r = (size_t)(row0 + ai * HALF + m * 16);
#pragma unroll
                for (int bj = 0; bj < 2; ++bj) { const int c = col0 + bj * HALF;
                    const u32x4 gz = *(const u32x4*)(zg + r * ldz + c);
                    u32x4 old = (u32x4){0u, 0u, 0u, 0u}; if (!first) old = *(const u32x4*)(MG + r * ldm + c);
                    float o[8];
#pragma unroll
                    for (int j = 0; j < 4; ++j) { const unsigned gw = gz[j], ow = old[j];
                        const float g0 = __uint_as_float(gw << 16), g1 = __uint_as_float(gw & 0xffff0000u), o0 = __uint_as_float(ow << 16), o1 = __uint_as_float(ow & 0xffff0000u);
                        const float a0 = acc[ai][bj][m][j >> 1][(j & 1) * 2], a1 = acc[ai][bj][m][j >> 1][(j & 1) * 2 + 1];
                        o[2 * j] = o0 + fast_sigmoid(g0) * a0; o[2 * j + 1] = o1 + fast_sigmoid(g1) * a1; }
                    u32x4 w; w.x = cvt_pk_bf16(o[0], o[1]); w.y = cvt_pk_bf16(o[2], o[3]); w.z = cvt_pk_bf16(o[4], o[5]); w.w = cvt_pk_bf16(o[6], o[7]);
                    *(u32x4*)(MG + r * ldm + c) = w; } }
    }
};
struct MergeOrder : StaticOrder {
    size_t astride, bstride;
    __device__ __forceinline__ bool next(int i, Unit& u) const { if (!StaticOrder::next(i / 3, u)) return false; u.aux = i % 3; return true; }
    __device__ __forceinline__ void bases(const Gemm& g, const Unit& u, size_t tstep, const char*& a, const char*& b) const {
        a = (const char*)(g.A + (size_t)u.aux * astride) + (size_t)u.pm * tstep; b = (const char*)(g.Bt + (size_t)u.aux * bstride) + (size_t)u.pn * tstep; }
};
template <class Epi, class Sched, bool ALIGN_EPI = false, bool SP2 = false>
__device__ __forceinline__ void gemm_phase(PG8_LAS unsigned char* lds, const Gemm g, const Sched& S, const Epi& E) {
    int tid_ = threadIdx.x; asm volatile("" : "+v"(tid_));
    const int tid = tid_, wid = __builtin_amdgcn_readfirstlane(tid >> 6), lane = tid & 63, wr = wid >> 2, wc = wid & 3, fr = lane & 15, fq = lane >> 4;
    const int K = g.K, nt = K / BK;
    unsigned voffA[2], voffB[2];
#pragma unroll
    for (int i = 0; i < 2; ++i) { int R, C; stage_rc(tid * 16 + i * 8192, R, C); const int Rb = Epi::PERM ? ((R & ~31) + perm32(R & 31)) : R;
        voffA[i] = (unsigned)(R * K + C) * 2u; voffB[i] = (unsigned)(Rb * K + C) * 2u; }
    const size_t kstep = (size_t)(BK * 2);
    const size_t hstep = (size_t)HALF * K * 2;
    const size_t tstep = 2 * hstep;
    const unsigned ldsw = (unsigned)wid * 1024u;
    const int aoff = lds_byte(wr * 64 + fr, fq * 8), boff = lds_byte(wc * 32 + fr, fq * 8);
#define PG8_SA(b, h) (((b) * 2 + (h)) * HTB)
#define PG8_SB(b, h) ((4 + (b) * 2 + (h)) * HTB)
#define PG8_STAGE(bufoff, gbase, voff) do { _Pragma("unroll") for (int _i = 0; _i < 2; ++_i) \
        __builtin_amdgcn_global_load_lds((const unsigned*)((const char*)(gbase) + (voff)[_i]), (PG8_LAS unsigned*)(lds + (bufoff) + ldsw + _i * 8192), 16, 0, 0); } while (0)
#define PG8_LDA(dst, b, h) do { _Pragma("unroll") for (int m = 0; m < 4; ++m) _Pragma("unroll") for (int k = 0; k < 2; ++k) dst[m][k] = *(const PG8_LAS bf16x8*)(lds + PG8_SA(b, h) + aoff + m * 2048 + k * 1024); } while (0)
#define PG8_LDB(dst, b, h) do { _Pragma("unroll") for (int n = 0; n < 2; ++n) _Pragma("unroll") for (int k = 0; k < 2; ++k) dst[n][k] = *(const PG8_LAS bf16x8*)(lds + PG8_SB(b, h) + boff + n * 2048 + k * 1024); } while (0)
#define PG8_MMA(ai, bj, At, Bt) do { __builtin_amdgcn_s_setprio(1); _Pragma("unroll") for (int m = 0; m < 4; ++m) _Pragma("unroll") for (int n = 0; n < 2; ++n) _Pragma("unroll") for (int k = 0; k < 2; ++k) \
        acc[ai][bj][m][n] = __builtin_amdgcn_mfma_f32_16x16x32_bf16(Bt[n][k], At[m][k], acc[ai][bj][m][n], 0, 0, 0); __builtin_amdgcn_s_setprio(0); } while (0)
#define PG8_WAIT_V(n) asm volatile("s_waitcnt vmcnt(" #n ")" ::: "memory")
#define PG8_WAIT_L(n) asm volatile("s_waitcnt lgkmcnt(" #n ")" ::: "memory")
#define PG8_BAR __builtin_amdgcn_s_barrier()
#define PG8_SCHED __builtin_amdgcn_sched_barrier(0)
    Unit cur, nxt; int ui = 0;
    if (!S.next(0, cur)) return;
    f32x4 acc[2][2][4][2];
#pragma unroll
    for (int a = 0; a < 2; ++a)
#pragma unroll
        for (int b = 0; b < 2; ++b)
#pragma unroll
            for (int m = 0; m < 4; ++m)
#pragma unroll
                for (int n = 0; n < 2; ++n) acc[a][b][m][n] = (f32x4){0.f, 0.f, 0.f, 0.f};
    bf16x8 At[4][2], B0[2][2], B1[2][2];
    const char* cA; const char* cB; S.bases(g, cur, tstep, cA, cB);
    S.a_ready(cur);
    if constexpr (SP2) {
        PG8_STAGE(PG8_SB(0, 0), cB, voffB); PG8_STAGE(PG8_SB(0, 1), cB + hstep, voffB); PG8_STAGE(PG8_SA(0, 0), cA, voffA); PG8_STAGE(PG8_SA(0, 1), cA + hstep, voffA);
        if (wr == 1) PG8_BAR;
        PG8_WAIT_V(2); PG8_BAR;
        PG8_STAGE(PG8_SB(1, 0), cB + kstep, voffB); PG8_STAGE(PG8_SA(1, 0), cA + kstep, voffA); PG8_STAGE(PG8_SB(1, 1), cB + hstep + kstep, voffB);
        PG8_WAIT_V(6); PG8_BAR;
    } else {
        PG8_STAGE(PG8_SB(0, 0), cB, voffB); PG8_STAGE(PG8_SA(0, 0), cA, voffA); PG8_STAGE(PG8_SB(0, 1), cB + hstep, voffB); PG8_STAGE(PG8_SA(0, 1), cA + hstep, voffA);
        if (wr == 1) PG8_BAR;
        PG8_WAIT_V(4); PG8_BAR;
        PG8_STAGE(PG8_SB(1, 0), cB + kstep, voffB); PG8_STAGE(PG8_SA(1, 0), cA + kstep, voffA); PG8_STAGE(PG8_SB(1, 1), cB + hstep + kstep, voffB);
        PG8_WAIT_V(6); PG8_BAR;
    }
    for (;;) {
        const bool has_next = S.next(ui + 1, nxt);
        const char* nA = cA; const char* nB = cB; if (has_next) S.bases(g, nxt, tstep, nA, nB);
        for (int t = 0; t < nt; t += 2) {
            const bool last = (t == nt - 2);
            const char* a1 = cA + (size_t)(t + 1) * kstep;
            const char* a2 = last ? nA : cA + (size_t)(t + 2) * kstep; const char* b2 = last ? nB : cB + (size_t)(t + 2) * kstep;
            const char* a3 = a2 + kstep; const char* b3 = b2 + kstep;
            if (last && has_next) S.a_ready(nxt);
            if constexpr (SP2) {
            PG8_LDB(B0, 0, 0); PG8_LDB(B1, 0, 1); PG8_SCHED; PG8_LDA(At, 0, 0); PG8_STAGE(PG8_SA(1, 1), a1 + hstep, voffA);
            PG8_WAIT_V(8); PG8_WAIT_L(0); PG8_BAR; PG8_MMA(0, 0, At, B0); PG8_MMA(0, 1, At, B1); PG8_BAR; PG8_SCHED;
            PG8_LDA(At, 0, 1); PG8_STAGE(PG8_SB(0, 0), b2, voffB); PG8_STAGE(PG8_SB(0, 1), b2 + hstep, voffB); PG8_STAGE(PG8_SA(0, 0), a2, voffA);
            PG8_WAIT_V(8); PG8_WAIT_L(0); PG8_BAR; PG8_MMA(1, 0, At, B0); PG8_MMA(1, 1, At, B1); PG8_BAR; PG8_SCHED;
            PG8_LDB(B0, 1, 0); PG8_LDB(B1, 1, 1); PG8_SCHED; PG8_LDA(At, 1, 0); PG8_STAGE(PG8_SA(0, 1), a2 + hstep, voffA);
            PG8_WAIT_V(8); PG8_WAIT_L(0); PG8_BAR; PG8_MMA(0, 0, At, B0); PG8_MMA(0, 1, At, B1); PG8_BAR; PG8_SCHED;
            PG8_LDA(At, 1, 1); PG8_STAGE(PG8_SB(1, 0), b3, voffB); PG8_STAGE(PG8_SB(1, 1), b3 + hstep, voffB); PG8_STAGE(PG8_SA(1, 0), a3, voffA);
            PG8_WAIT_V(8); PG8_WAIT_L(0); PG8_BAR; PG8_MMA(1, 0, At, B0); PG8_MMA(1, 1, At, B1); PG8_BAR; PG8_SCHED;
            } else {
            PG8_LDB(B0, 0, 0); PG8_SCHED; PG8_LDA(At, 0, 0); PG8_STAGE(PG8_SA(1, 1), a1 + hstep, voffA);
            PG8_WAIT_L(8); PG8_BAR; PG8_WAIT_L(0); PG8_MMA(0, 0, At, B0); PG8_BAR; PG8_SCHED;
            PG8_LDB(B1, 0, 1); PG8_STAGE(PG8_SB(0, 0), b2, voffB);
            PG8_BAR; PG8_WAIT_L(0); PG8_MMA(0, 1, At, B1); PG8_BAR;
            PG8_LDA(At, 0, 1); PG8_STAGE(PG8_SA(0, 0), a2, voffA);
            PG8_BAR; PG8_WAIT_L(0); PG8_MMA(1, 0, At, B0); PG8_BAR; PG8_SCHED;
            PG8_STAGE(PG8_SB(0, 1), b2 + hstep, voffB);
            PG8_WAIT_V(6); PG8_BAR; PG8_MMA(1, 1, At, B1); PG8_BAR;
            PG8_LDB(B0, 1, 0); PG8_SCHED; PG8_LDA(At, 1, 0); PG8_STAGE(PG8_SA(0, 1), a2 + hstep, voffA);
            PG8_WAIT_L(8); PG8_BAR; PG8_WAIT_L(0); PG8_MMA(0, 0, At, B0); PG8_BAR; PG8_SCHED;
            PG8_LDB(B1, 1, 1); PG8_STAGE(PG8_SB(1, 0), b3, voffB);
            PG8_BAR; PG8_WAIT_L(0); PG8_MMA(0, 1, At, B1); PG8_BAR;
            PG8_LDA(At, 1, 1); PG8_STAGE(PG8_SA(1, 0), a3, voffA);
            PG8_BAR; PG8_WAIT_L(0); PG8_MMA(1, 0, At, B0); PG8_BAR; PG8_SCHED;
            PG8_STAGE(PG8_SB(1, 1), b3 + hstep, voffB);
            PG8_WAIT_V(6); PG8_BAR; PG8_MMA(1, 1, At, B1); PG8_BAR;
            }
        }
        if constexpr (ALIGN_EPI) { if (wr == 0) PG8_BAR; }
        if constexpr (!Epi::AFTER_DRAIN) { E(acc, cur, wr, wc, fr, fq); S.done(cur); }
        if (!has_next) break;
#pragma unroll
        for (int a = 0; a < 2; ++a)
#pragma unroll
            for (int b = 0; b < 2; ++b)
#pragma unroll
                for (int m = 0; m < 4; ++m)
#pragma unroll
                    for (int n = 0; n < 2; ++n) acc[a][b][m][n] = (f32x4){0.f, 0.f, 0.f, 0.f};
        cur = nxt; cA = nA; cB = nB; ++ui;
        if constexpr (ALIGN_EPI) { if (wr == 1) PG8_BAR; }
    }
    PG8_WAIT_V(0);
    if constexpr (!ALIGN_EPI) { if (wr == 0) PG8_BAR; }
    PG8_BAR;
    if constexpr (Epi::AFTER_DRAIN) { E.fused(acc, cur, wr, wc, fr, fq, lds, wid, lane); S.done(cur); }
#undef PG8_SA
#undef PG8_SB
#undef PG8_STAGE
#undef PG8_LDA
#undef PG8_LDB
#undef PG8_MMA
#undef PG8_WAIT_V
#undef PG8_WAIT_L
#undef PG8_BAR
#undef PG8_SCHED
}
}
#define XB_TMO      128
#define XB_XCNT(j)  (256  + 64 * (j))
#define XB_XSUB(j)  (1280 + 64 * (j))
#define XB_XGEN(j)  (2304 + 64 * (j))
#define XB_TOP      3328
#define XB_TOPGEN   3392
#define XCD_BAR_WORDS 3456
#define XB_SPIN_CAP (1u << 18)

__device__ __forceinline__ unsigned xb_ld(unsigned* p)              { return __hip_atomic_load(p, __ATOMIC_RELAXED, __HIP_MEMORY_SCOPE_AGENT); }
__device__ __forceinline__ unsigned xb_add(unsigned* p, unsigned v) { return __hip_atomic_fetch_add(p, v, __ATOMIC_RELAXED, __HIP_MEMORY_SCOPE_AGENT); }
__device__ __forceinline__ unsigned xb_xcc_id() { return (unsigned)__builtin_amdgcn_s_getreg((3 << 11) | 20) & 0xFu; }
#define XB_SPIN(cond, bar) do { unsigned _sp = 0; while (cond) { __builtin_amdgcn_s_sleep(1); \
    if ((++_sp & 255u) == 0u) { if (xb_ld(&(bar)[XB_TMO])) break; if (_sp > XB_SPIN_CAP) { atomicAdd(&(bar)[XB_TMO], 1u); break; } } } } while (0)

struct XcdBarrier {
    unsigned* bar; unsigned x;
    volatile LAS unsigned* st;
};

__device__ __forceinline__ XcdBarrier xcd_barrier_post(unsigned* bar, volatile LAS unsigned* st) {
    XcdBarrier b; b.bar = bar; b.x = xb_xcc_id(); b.st = st;
    if (threadIdx.x == 0) (void)xb_add(&bar[XB_XCNT(b.x)], 1u);
    return b;
}
__device__ __forceinline__ void xcd_barrier_complete(unsigned* bar, unsigned x, unsigned& nloc, unsigned& nx) {
    const unsigned G = gridDim.x * gridDim.y * gridDim.z;
    unsigned sum, cnt, mine, sp = 0u;
    for (;;) {
        sum = 0u; cnt = 0u; mine = 0u;
#pragma unroll
        for (unsigned j = 0; j < 16; ++j) { const unsigned c = xb_ld(&bar[XB_XCNT(j)]); sum += c; cnt += (c > 0u) ? 1u : 0u; mine = (j == x) ? c : mine; }
        if (sum == G) break;
        __builtin_amdgcn_s_sleep(1);
        if ((++sp & 255u) == 0u) { if (xb_ld(&bar[XB_TMO])) break; if (sp > XB_SPIN_CAP) { atomicAdd(&bar[XB_TMO], 1u); break; } }
    }
    nloc = mine > 0u ? mine : 1u; nx = cnt > 0u ? cnt : 1u;
}

__device__ __forceinline__ void xcd_barrier(const XcdBarrier& b) {
    asm volatile("s_waitcnt vmcnt(0)" ::: "memory");
    __syncthreads();
    if (threadIdx.x == 0) {
        unsigned* bar = b.bar;
        __builtin_amdgcn_s_waitcnt(0);
        unsigned nloc = b.st[0], nx = b.st[1];
        if (nloc == 0u) { xcd_barrier_complete(bar, b.x, nloc, nx); b.st[0] = nloc; b.st[1] = nx; }
        const unsigned old = xb_add(&bar[XB_XSUB(b.x)], 1u);
        const unsigned gen = old / nloc;
        if (old + 1u == (gen + 1u) * nloc) {
            __builtin_amdgcn_fence(__ATOMIC_RELEASE, "agent");
            asm volatile("s_waitcnt vmcnt(0)" ::: "memory");
            const unsigned og = xb_add(&bar[XB_TOP], 1u);
            const unsigned tg = og / nx;
            if (og + 1u == (tg + 1u) * nx) xb_add(&bar[XB_TOPGEN], 1u);
            else XB_SPIN(xb_ld(&bar[XB_TOPGEN]) == tg, bar);
            __builtin_amdgcn_fence(__ATOMIC_ACQUIRE, "agent");
            xb_add(&bar[XB_XGEN(b.x)], 1u);
            asm volatile("s_waitcnt vmcnt(0)" ::: "memory");
        } else {
            XB_SPIN(xb_ld(&bar[XB_XGEN(b.x)]) == gen, bar);
            __builtin_amdgcn_fence(__ATOMIC_ACQUIRE, "agent");
            asm volatile("s_waitcnt vmcnt(0)" ::: "memory");
        }
    }
    __syncthreads();
}
constexpr size_t MiB = 1u << 20;
constexpr size_t SZ_WGU = (size_t)NGU * DM * 2, SZ_WD = (size_t)DM * DFF * 2, SZ_WIN = (size_t)NZP * DM * 2, SZ_WUP = (size_t)DM * 1024 * 2, SZ_WOUT = (size_t)DM * DM * 2, SZ_LRUW = (size_t)8 * 256 * 128 * 2;
constexpr size_t LW_GU1 = 0, LW_D1 = LW_GU1 + SZ_WGU, LW_IN = LW_D1 + SZ_WD, LW_UPA = LW_IN + SZ_WIN, LW_UPB = LW_UPA + SZ_WUP, LW_UPC = LW_UPB + SZ_WUP, LW_OUT = LW_UPC + SZ_WUP,
                 LW_GU2 = LW_OUT + SZ_WOUT, LW_D2 = LW_GU2 + SZ_WGU, LW_LRU = LW_D2 + SZ_WD, LW_END = LW_LRU + SZ_LRUW;
constexpr size_t LW_STRIDE = (LW_END + MiB - 1) / MiB * MiB;
constexpr size_t SZ_Y = (size_t)T_SEQ * 1024 * 2;
constexpr size_t WS_CTL = 0, CTL_BYTES = 2 * MiB, WS_W = CTL_BYTES, WS_X = WS_W + NLAYER * LW_STRIDE, WS_HN = WS_X + (size_t)T_SEQ * DM * 4, WS_HID = WS_HN + (size_t)T_SEQ * DM * 2,
                 WS_Z = WS_HID + (size_t)T_SEQ * DFF * 2, WS_ZT = WS_Z + (size_t)T_SEQ * NZ * 2, WS_G = WS_ZT + (size_t)NZT * T_SEQ * 2, WS_YA = WS_G + 1 * MiB, WS_YB = WS_YA + SZ_Y, WS_YC = WS_YB + SZ_Y,
                 WS_MG = WS_YC + SZ_Y, WS_SCR = WS_MG + (size_t)T_SEQ * DM * 2;
constexpr size_t SC_XC = 0, SC_LA = SC_XC + (size_t)T_SEQ * 1024 * 4, SC_LU = SC_LA + (size_t)T_SEQ * 1024 * 4, SC_MLA = SC_LU + (size_t)T_SEQ * 1024 * 4, SC_MLM = SC_MLA + 1 * MiB, SC_MLF = SC_MLM + 1 * MiB,
                 SC_KM = SC_MLF + 1 * MiB, SC_CARRY = SC_KM + 1 * MiB, SC_AKT = SC_CARRY + 1 * MiB, SC_LST = SC_AKT + (size_t)1024 * T_SEQ * 2, SC_CST = SC_LST + (size_t)64 * 4 * 65536 * 4, SC_NL = SC_CST + (size_t)64 * 4 * 65536 * 2,
                 SC_NST = SC_NL + 1 * MiB, SC_BG = SC_NST + 1 * MiB, SC_MST = SC_BG + 1 * MiB, SC_SEL = SC_MST + 1 * MiB, SC_PLSE = SC_SEL + 1 * MiB, SC_PO = SC_PLSE + 1 * MiB, SC_SSQ = SC_PO + (size_t)T_SEQ * 8 * 3 * 128 * 2, SC_END = SC_SSQ + 1 * MiB;
constexpr size_t WS_END = WS_SCR + SC_END;
constexpr int CW_BAR = 1024, MAX_LAUNCH = 96, CW_Q = 512;
constexpr int LDS_STAGE = 131072, LDS_MISC = LDS_STAGE, LDS_BYTES = 147456;

#include <hip/hip_runtime.h>
__device__ __forceinline__ unsigned pk_bf16(float lo, float hi) { unsigned r; asm volatile("v_cvt_pk_bf16_f32 %0, %1, %2" : "=v"(r) : "v"(lo), "v"(hi)); return r; }
struct MegaArgs { const float* in[26]; float* out; unsigned char* ws; int s_lo, s_hi, p_lo, p_hi, do_pro, do_fin, li, pad; };
__device__ __forceinline__ float wave_sum(float v) {
#pragma unroll
    for (int o = 1; o < 64; o <<= 1) v += __shfl_xor(v, o);
    return v;
}
constexpr int CT_GU = (NGU / 64) * (DM / 64), CT_D = (DM / 64) * (DFF / 64), CT_IN = (NZP / 64) * (DM / 64), CT_UP = (DM / 64) * (1024 / 64), CT_OUT = (DM / 64) * (DM / 64), CT_LRU = 8 * 4 * 2;
constexpr int CT_LAYER = 2 * CT_GU + 2 * CT_D + CT_IN + 3 * CT_UP + CT_OUT + CT_LRU;
typedef float f32x4w __attribute__((ext_vector_type(4)));
typedef unsigned u32x4w __attribute__((ext_vector_type(4)));
struct ConvTile { const float* sp; const float* gs; bf16* dp; int K, Nsrc; float sc, gm; };
template <class KA> __device__ __forceinline__ ConvTile conv_desc(KA a, int gidx, int lane) {
    const int l = gidx / CT_LAYER; int r = gidx - l * CT_LAYER; unsigned char* lw = a->ws + WS_W + (size_t)l * LW_STRIDE;
    const float* s0; const float* s1 = nullptr; const float* gs = nullptr; bf16* dst; int K, Nsrc, mode = 0, ntn;
    if (r < CT_GU) { gs = a->in[1] + (size_t)l * DM; s0 = a->in[2] + (size_t)l * DM * DFF; s1 = a->in[3] + (size_t)l * DM * DFF; dst = (bf16*)(lw + LW_GU1); K = DM; Nsrc = DFF; mode = 1; ntn = NGU / 64; }
    else if ((r -= CT_GU) < CT_D) { s0 = a->in[4] + (size_t)l * DFF * DM; dst = (bf16*)(lw + LW_D1); K = DFF; Nsrc = DM; ntn = DM / 64; }
    else if ((r -= CT_D) < CT_IN) { gs = a->in[5] + (size_t)l * DM; s0 = a->in[6] + (size_t)l * DM * 15368; dst = (bf16*)(lw + LW_IN); K = DM; Nsrc = 15368; mode = 2; ntn = NZP / 64; }
    else if ((r -= CT_IN) < CT_LRU) { const int blk = r >> 3; r &= 7; s0 = a->in[12] + ((size_t)l * 8 + blk) * 128 * 128; s1 = a->in[14] + ((size_t)l * 8 + blk) * 128 * 128; dst = (bf16*)(lw + LW_LRU) + (size_t)blk * 256 * 128; K = 128; Nsrc = 128; mode = 3; ntn = 4; }
    else if ((r -= CT_LRU) < 3 * CT_UP) { const int b = r / CT_UP; r -= b * CT_UP; s0 = (b == 0 ? a->in[17] : (b == 1 ? a->in[18] : a->in[19])) + (size_t)l * 1024 * DM; dst = (bf16*)(lw + LW_UPA + (size_t)b * SZ_WUP); K = 1024; Nsrc = DM; ntn = DM / 64; }
    else if ((r -= 3 * CT_UP) < CT_OUT) { s0 = a->in[20] + (size_t)l * DM * DM; dst = (bf16*)(lw + LW_OUT); K = DM; Nsrc = DM; ntn = DM / 64; }
    else if ((r -= CT_OUT) < CT_GU) { gs = a->in[21] + (size_t)l * DM; s0 = a->in[22] + (size_t)l * DM * DFF; s1 = a->in[23] + (size_t)l * DM * DFF; dst = (bf16*)(lw + LW_GU2); K = DM; Nsrc = DFF; mode = 1; ntn = NGU / 64; }
    else { r -= CT_GU; s0 = a->in[24] + (size_t)l * DFF * DM; dst = (bf16*)(lw + LW_D2); K = DFF; Nsrc = DM; ntn = DM / 64; }
    const int n0 = (r % ntn) * 64, k0 = (r / ntn) * 64, n = n0 + (lane & 15) * 4; const float* src = s0; int col = n; float sc = 1.f;
    if (mode == 1) { const int b = (n >> 7) & 1; col = ((n >> 8) << 7) | (n & 127); src = b ? s1 : s0; }
    else if (mode == 2) { int nl = n; if (n < NZ) { const int p_ = n & 255; nl = (n & ~255) + 64 * ((p_ >> 5) & 3) + 32 * (p_ >> 7) + (p_ & 31); }
        col = win_src_col(nl); if (nl >= Z_AK && nl < Z_AO) sc = 0.0625f; }
    else if (mode == 3) { src = (n & 128) ? s1 : s0; col = n & 127; }
    if (col < 0) { sc = 0.f; col = 0; }
    ConvTile t; t.sp = src + (size_t)(k0 + (lane >> 4)) * Nsrc + col; t.gs = (gs ? gs : a->in[1]) + k0 % DM + (lane >> 4); t.gm = gs ? 1.f : 0.f; t.dp = dst + (size_t)n0 * K + k0; t.K = K; t.Nsrc = Nsrc; t.sc = sc; return t;
}
__device__ __forceinline__ void conv_load(const ConvTile& t, f32x4w (&v)[16], float (&g)[16]) {
#pragma unroll
    for (int i = 0; i < 16; ++i) g[i] = t.gs[4 * i];
#pragma unroll
    for (int i = 0; i < 16; ++i) g[i] = (g[i] * t.gm + (1.f - t.gm)) * t.sc;
#pragma unroll
    for (int i = 0; i < 16; ++i) v[i] = __builtin_nontemporal_load((const f32x4w*)(t.sp + (size_t)(4 * i) * t.Nsrc));
}
__device__ __forceinline__ void conv_finish(const ConvTile& t, const f32x4w (&v)[16], const float (&gg)[16], LAS unsigned short* tl, int lane) {
    const int nl = (lane & 15) * 4;
#pragma unroll
    for (int i = 0; i < 16; ++i) { const float g = gg[i];
        LAS unsigned* w = (LAS unsigned*)(tl + (4 * i + (lane >> 4)) * 66 + nl); w[0] = pk_bf16(v[i][0] * g, v[i][1] * g); w[1] = pk_bf16(v[i][2] * g, v[i][3] * g); }
    asm volatile("s_waitcnt lgkmcnt(0)" ::: "memory");
    const int kc = (lane & 7) * 8;
#pragma unroll
    for (int q = 0; q < 8; ++q) { const int r = 8 * q + (lane >> 3); unsigned w[4];
#pragma unroll
        for (int e = 0; e < 4; ++e) w[e] = (unsigned)tl[(kc + 2 * e) * 66 + r] | ((unsigned)tl[(kc + 2 * e + 1) * 66 + r] << 16);
        __builtin_nontemporal_store((u32x4w){w[0], w[1], w[2], w[3]}, (u32x4w*)(t.dp + (size_t)r * t.K + kc)); }
    asm volatile("s_waitcnt lgkmcnt(0)" ::: "memory");
}
template <class KA> __device__ __forceinline__ void convert_range(KA a, LAS unsigned char* lds, int t_lo, int t_hi, int rank, int nrank) {
    int tid_ = threadIdx.x; asm volatile("" : "+v"(tid_));
    const int lane = tid_ & 63, wave = __builtin_amdgcn_readfirstlane(tid_ >> 6); LAS unsigned short* tl = (LAS unsigned short*)(lds + wave * 16384);
    const int stride = nrank * 8; int it = t_lo + rank * 8 + wave;
    if (it >= t_hi) return;
    f32x4w va[16], vb[16]; float ga[16], gb[16];
    ConvTile ta = conv_desc(a, it, lane), tb = ta; conv_load(ta, va, ga);
    for (;;) {
        const bool nb = (it + stride) < t_hi; if (nb) { tb = conv_desc(a, it + stride, lane); conv_load(tb, vb, gb); }
        conv_finish(ta, va, ga, tl, lane);
        if (!nb) break;
        const bool na = (it + 2 * stride) < t_hi; if (na) { ta = conv_desc(a, it + 2 * stride, lane); conv_load(ta, va, ga); }
        conv_finish(tb, vb, gb, tl, lane);
        if (!na) break;
        it += 2 * stride;
    }
}
constexpr int CVT_PRO = 8704, CVT_GU = 9600, CVT_Z = 7400, CVT_TOTAL = NLAYER * CT_LAYER;
__host__ __device__ constexpr int cvt_slot_lo(int q) { return CVT_PRO + (q / 3) * (2 * CVT_GU + CVT_Z) + (q % 3 == 0 ? 0 : (q % 3 == 1 ? CVT_GU : CVT_GU + CVT_Z)); }
__host__ __device__ constexpr int cvt_slot_hi(int q) { return cvt_slot_lo(q) + (q % 3 == 1 ? CVT_Z : CVT_GU); }
__host__ __device__ constexpr int cvt_need_before(int q) {
    return (q / 3) * CT_LAYER + (q % 3 == 0 ? CT_GU + CT_D + CT_IN : (q % 3 == 1 ? CT_GU + CT_D + CT_IN + CT_LRU + 3 * CT_UP + CT_OUT + CT_GU : CT_LAYER + ((q / 3) + 1 < NLAYER ? CT_GU : 0))); }
__host__ __device__ constexpr bool cvt_schedule_ok() { if (CVT_PRO < CT_GU) return false; for (int q = 0; q < 3 * NLAYER; ++q) { const int hi = cvt_slot_hi(q) < CVT_TOTAL ? cvt_slot_hi(q) : CVT_TOTAL; if (hi < cvt_need_before(q)) return false; } return cvt_slot_hi(3 * NLAYER - 1) >= CVT_TOTAL; }
static_assert(cvt_schedule_ok(), "conversion schedule: a weight matrix would be read before it is converted");
__device__ __forceinline__ void phase_xinit(const float* x, float* X, bf16* XB, float* SSQ) {
    int tid_ = threadIdx.x; asm volatile("" : "+v"(tid_));
    const int lane = tid_ & 63, gw = blockIdx.x * 8 + (tid_ >> 6), nw = gridDim.x * 8;
    for (int row = gw; row < T_SEQ; row += nw) {
        const float4* xr = (const float4*)(x + (size_t)row * DM) + lane;
        float4 v[8]; float ss = 0.f;
#pragma unroll
        for (int j = 0; j < 8; ++j) { v[j] = xr[64 * j]; ss += v[j].x * v[j].x + v[j].y * v[j].y + v[j].z * v[j].z + v[j].w * v[j].w; }
        ss = wave_sum(ss);
#pragma unroll
        for (int j = 0; j < 8; ++j) { ((float4*)(X + (size_t)row * DM))[lane + 64 * j] = v[j];
            ((uint2*)(XB + (size_t)row * DM))[lane + 64 * j] = make_uint2(pk_bf16(v[j].x, v[j].y), pk_bf16(v[j].z, v[j].w)); }
        if (lane < 32) SSQ[(size_t)row * 32 + lane] = (lane == 0) ? ss : 0.f;
    }
}
__device__ __forceinline__ void phase_norm(const float* src, const float* g, bf16* obf, float* of32, float* xcopy) {
    int tid_ = threadIdx.x; asm volatile("" : "+v"(tid_));
    const int lane = tid_ & 63, gw = blockIdx.x * 8 + (tid_ >> 6), nw = gridDim.x * 8;
    const float4* gr = (const float4*)g + lane;
    for (int row = gw; row < T_SEQ; row += nw) {
        const float4* xr = (const float4*)(src + (size_t)row * DM) + lane;
        float4 v[8]; float ss = 0.f;
#pragma unroll
        for (int j = 0; j < 8; ++j) { v[j] = xr[64 * j]; ss += v[j].x * v[j].x + v[j].y * v[j].y + v[j].z * v[j].z + v[j].w * v[j].w; }
        const float rstd = rsqrtf(wave_sum(ss) * (1.f / DM) + RMS_EPS);
        if (xcopy) {
#pragma unroll
            for (int j = 0; j < 8; ++j) ((float4*)(xcopy + (size_t)row * DM))[lane + 64 * j] = v[j]; }
#pragma unroll
        for (int j = 0; j < 8; ++j) { const float4 gg = gr[64 * j]; const float a = v[j].x * rstd * gg.x, b = v[j].y * rstd * gg.y, c = v[j].z * rstd * gg.z, d = v[j].w * rstd * gg.w;
            if (of32) ((float4*)(of32 + (size_t)row * DM))[lane + 64 * j] = make_float4(a, b, c, d);
            else ((uint2*)(obf + (size_t)row * DM))[lane + 64 * j] = make_uint2((unsigned)f2bf(a) | ((unsigned)f2bf(b) << 16), (unsigned)f2bf(c) | ((unsigned)f2bf(d) << 16)); }
    }
}
typedef short bf16x8 __attribute__((ext_vector_type(8)));
typedef short bf16x4 __attribute__((ext_vector_type(4)));
typedef float f32x16 __attribute__((ext_vector_type(16)));
typedef float f32x4v __attribute__((ext_vector_type(4)));
typedef unsigned u32x4v __attribute__((ext_vector_type(4)));
#define MFMA32(a, b, c) __builtin_amdgcn_mfma_f32_32x32x16_bf16((a), (b), (c), 0, 0, 0)
__device__ __forceinline__ bf16x8 pack8(const float* v) { typedef unsigned u32x4_ __attribute__((ext_vector_type(4))); u32x4_ w; w.x = pk_bf16(v[0], v[1]); w.y = pk_bf16(v[2], v[3]); w.z = pk_bf16(v[4], v[5]); w.w = pk_bf16(v[6], v[7]); return __builtin_bit_cast(bf16x8, w); }
__device__ __forceinline__ float gelu_tanh_f(float x) { const float u = 0.7978845608028654f * (x + 0.044715f * x * x * x); const float th = 1.f - 2.f / (1.f + __expf(2.f * u)); return 0.5f * x * (1.f + th); }
__device__ __forceinline__ int kperm(int r) { return (r & 0x13) | ((r & 4) << 1) | ((r & 8) >> 1); }
__device__ __forceinline__ float neg_expm1_small(float x, float a_half) {
    const float p = -x * (1.f + x * (0.5f + x * (0.16666667f + x * (0.041666668f + x * (0.0083333338f + x * 0.0013888889f)))));
    return (x > -0.25f) ? p : (1.f - a_half * a_half);
}
#define LRU_BAR() do { asm volatile("s_waitcnt vmcnt(0) lgkmcnt(0)" ::: "memory"); __builtin_amdgcn_s_barrier(); asm volatile("" ::: "memory"); } while (0)
template <int PASS> __device__ __forceinline__ void lru_pass(const bf16* Z, const bf16* LW, const float* cw_g, const float* cb_g, const float* b_a, const float* b_x, const float* lam,
                                                              float2* CARRY, bf16* YC, LAS unsigned char* lds) {
    int tid_ = threadIdx.x; asm volatile("" : "+v"(tid_));
    const int tid = tid_, lane = tid & 63, wave = __builtin_amdgcn_readfirstlane(tid >> 6), r = lane & 31, hh = lane >> 5, jt = wave & 3, th = wave >> 2;
    LAS unsigned short* RAW = (LAS unsigned short*)lds; LAS unsigned char* XC = lds + 36864; LAS unsigned short* GT = (LAS unsigned short*)(lds + 69632);
    LAS float* xcomp = (LAS float*)(lds + LDS_MISC + 1024);
    for (int u = blockIdx.x; u < 512; u += gridDim.x) {
        const int R = u >> 3, blk = u & 7, tok0 = R * 128, dd = 32 * jt + r, d = blk * 128 + dd;
        LRU_BAR();
        { int t_ = tid; asm volatile("" : "+v"(t_));
#pragma unroll
          for (int i = 0; i < 5; ++i) { const int idx = t_ + 512 * i; if (idx < 131 * 16) { const int row = idx >> 4, c = idx & 15, t = tok0 - 3 + row; u32x4v v = (u32x4v){0u, 0u, 0u, 0u};
              if (t >= 0) v = *(const u32x4v*)(Z + (size_t)t * NZ + Z_CX + blk * 128 + c * 8); *(LAS u32x4v*)(RAW + row * 128 + c * 8) = v; } }
          if (PASS == 2) {
#pragma unroll
              for (int i = 0; i < 4; ++i) { const int idx = t_ + 512 * i, row = idx >> 4, c = idx & 15; *(LAS u32x4v*)(GT + row * 128 + c * 8) = *(const u32x4v*)(Z + (size_t)(tok0 + row) * NZ + Z_CG + blk * 128 + c * 8); } } }
        const bf16* wt = LW + (size_t)blk * 256 * 128;
        bf16x8 ba[8], bx[8];
#pragma unroll
        for (int s = 0; s < 8; ++s) { ba[s] = *(const bf16x8*)(wt + (size_t)dd * 128 + 16 * s + 8 * hh); bx[s] = *(const bf16x8*)(wt + (size_t)(128 + dd) * 128 + 16 * s + 8 * hh); }
        const float bav = b_a[d], bxv = b_x[d], sp8 = 8.f * log1pf(expf(-lam[d]));
        const float w0 = cw_g[d], w1 = cw_g[1024 + d], w2 = cw_g[2048 + d], w3 = cw_g[3072 + d], wb = cb_g[d];
        float hc = 0.f;
        if (PASS == 2) { for (int q0 = 0; q0 < R; q0 += 8) { float2 cc[8];
#pragma unroll
                for (int j = 0; j < 8; ++j) cc[j] = (q0 + j < R) ? CARRY[(size_t)(q0 + j) * 1024 + d] : make_float2(1.f, 0.f);
#pragma unroll
                for (int j = 0; j < 8; ++j) hc = hc * cc[j].x + cc[j].y; } }
        LRU_BAR();
        { const int c8 = tid & 15; const float* cwp = cw_g + blk * 128 + c8 * 8; float cw[4][8], cbv[8];
#pragma unroll
          for (int jj = 0; jj < 4; ++jj) { const float4 q0 = *(const float4*)(cwp + jj * 1024), q1 = *(const float4*)(cwp + jj * 1024 + 4); cw[jj][0] = q0.x; cw[jj][1] = q0.y; cw[jj][2] = q0.z; cw[jj][3] = q0.w; cw[jj][4] = q1.x; cw[jj][5] = q1.y; cw[jj][6] = q1.z; cw[jj][7] = q1.w; }
          { const float4 q0 = *(const float4*)(cb_g + blk * 128 + c8 * 8), q1 = *(const float4*)(cb_g + blk * 128 + c8 * 8 + 4); cbv[0] = q0.x; cbv[1] = q0.y; cbv[2] = q0.z; cbv[3] = q0.w; cbv[4] = q1.x; cbv[5] = q1.y; cbv[6] = q1.z; cbv[7] = q1.w; }
#pragma unroll
          for (int i = 0; i < 4; ++i) { const int t = (tid >> 4) + 32 * i; float xv[8];
#pragma unroll
              for (int e = 0; e < 8; ++e) xv[e] = cbv[e];
#pragma unroll
              for (int jj = 0; jj < 4; ++jj) { const u32x4v raw = *(const LAS u32x4v*)(RAW + (t + jj) * 128 + c8 * 8);
                  xv[0] += cw[jj][0] * lo_bf(raw[0]); xv[1] += cw[jj][1] * hi_bf(raw[0]); xv[2] += cw[jj][2] * lo_bf(raw[1]); xv[3] += cw[jj][3] * hi_bf(raw[1]);
                  xv[4] += cw[jj][4] * lo_bf(raw[2]); xv[5] += cw[jj][5] * hi_bf(raw[2]); xv[6] += cw[jj][6] * lo_bf(raw[3]); xv[7] += cw[jj][7] * hi_bf(raw[3]); }
              *(LAS bf16x8*)(XC + t * 256 + ((c8 ^ (t & 15)) << 4)) = pack8(xv); } }
        LRU_BAR();
        float av[2][16], uv[2][16]; float Aw = 1.f, Hw = 0.f;
        float Ag[2][4], Hg[2][4], Ap[2][4], Hp[2][4];
#pragma unroll
        for (int tt = 0; tt < 2; ++tt) {
            const int tl0 = 64 * th + 32 * tt;
            f32x16 accA, accX;
#pragma unroll
            for (int i = 0; i < 16; ++i) { accA[i] = 0.f; accX[i] = 0.f; }
#pragma unroll
            for (int s = 0; s < 8; ++s) { const bf16x8 af = *(const LAS bf16x8*)(XC + (tl0 + r) * 256 + (((2 * s + hh) ^ (r & 15)) << 4)); accA = MFMA32(af, ba[s], accA); accX = MFMA32(af, bx[s], accX); }
#pragma unroll
            for (int gq = 0; gq < 4; ++gq) { const int t0 = tl0 + 8 * gq + 4 * hh; float cxr[7];
#pragma unroll
                for (int q = 0; q < 7; ++q) cxr[q] = bf2f(RAW[(t0 + q) * 128 + dd]);
#pragma unroll
                for (int e = 0; e < 4; ++e) { const int i = 4 * gq + e;
                    const float xc = wb + w0 * cxr[e] + w1 * cxr[e + 1] + w2 * cxr[e + 2] + w3 * cxr[e + 3];
                    const float rr = __builtin_amdgcn_rcpf(1.f + __expf(-(accA[i] + bav))), ig = __builtin_amdgcn_rcpf(1.f + __expf(-(accX[i] + bxv)));
                    const float la = -sp8 * rr, a_ = __expf(la); av[tt][i] = a_; uv[tt][i] = __builtin_amdgcn_sqrtf(neg_expm1_small(2.f * la, a_)) * (ig * xc); } }
#pragma unroll
            for (int gq = 0; gq < 4; ++gq) { float A = av[tt][4 * gq], H = uv[tt][4 * gq];
#pragma unroll
                for (int e = 1; e < 4; ++e) { H = H * av[tt][4 * gq + e] + uv[tt][4 * gq + e]; A *= av[tt][4 * gq + e]; }
                Ag[tt][gq] = A; Hg[tt][gq] = H; Ap[tt][gq] = __shfl_xor(A, 32); Hp[tt][gq] = __shfl_xor(H, 32); }
#pragma unroll
            for (int p = 0; p < 8; ++p) { const bool own = ((p & 1) == hh); const float A = own ? Ag[tt][p >> 1] : Ap[tt][p >> 1], H = own ? Hg[tt][p >> 1] : Hp[tt][p >> 1]; Hw = Hw * A + H; Aw *= A; }
        }
        if (hh == 0) { xcomp[(wave * 32 + r) * 2] = Aw; xcomp[(wave * 32 + r) * 2 + 1] = Hw; }
        LRU_BAR();
        if (PASS == 1) {
            if (th == 0 && hh == 0) { const float A1 = xcomp[((wave + 4) * 32 + r) * 2], H1 = xcomp[((wave + 4) * 32 + r) * 2 + 1]; CARRY[(size_t)R * 1024 + d] = make_float2(Aw * A1, Hw * A1 + H1); }
        } else {
            if (th == 1) { const float A0 = xcomp[((wave - 4) * 32 + r) * 2], H0 = xcomp[((wave - 4) * 32 + r) * 2 + 1]; hc = hc * A0 + H0; }
#pragma unroll
            for (int tt = 0; tt < 2; ++tt) { const int tl0 = 64 * th + 32 * tt; float hin[4];
#pragma unroll
                for (int p = 0; p < 8; ++p) { const bool own = ((p & 1) == hh); if (own) hin[p >> 1] = hc; const float A = own ? Ag[tt][p >> 1] : Ap[tt][p >> 1], H = own ? Hg[tt][p >> 1] : Hp[tt][p >> 1]; hc = hc * A + H; }
#pragma unroll
                for (int gq = 0; gq < 4; ++gq) { float h = hin[gq]; const int t0 = tl0 + 8 * gq + 4 * hh;
#pragma unroll
                    for (int e = 0; e < 4; ++e) { h = h * av[tt][4 * gq + e] + uv[tt][4 * gq + e];
                        YC[(size_t)(tok0 + t0 + e) * 1024 + d] = f2bf(h * gelu_tanh_f(bf2f(GT[(t0 + e) * 128 + dd]))); } } }
        }
    }
    LRU_BAR();
}
__device__ __forceinline__ float wave_incl_sum(float v, int lane) {
#pragma unroll
    for (int o = 1; o < 64; o <<= 1) { const float t = __shfl_up(v, o); if (lane >= o) v += t; }
    return v;
}
__device__ __forceinline__ float wave_incl_max(float v, int lane) {
#pragma unroll
    for (int o = 1; o < 64; o <<= 1) { const float t = __shfl_up(v, o); if (lane >= o) v = fmaxf(v, t); }
    return v;
}
__device__ __forceinline__ float wave_max(float v) {
#pragma unroll
    for (int o = 1; o < 64; o <<= 1) v = fmaxf(v, __shfl_xor(v, o));
    return v;
}
constexpr int ML_L = 128, ML_NC = T_SEQ / ML_L;
struct ChunkGates { float a0, a1, b0, b1, Bc; };
__device__ __forceinline__ ChunkGates chunk_gates(const float* G, float bi, float bfv, int tok0, int h, int lane) {
    const size_t t = (size_t)tok0 + 2 * lane;
    const float ip0 = G[t * 8 + h] + bi, fp0 = G[t * 8 + 4 + h] + bfv, ip1 = G[(t + 1) * 8 + h] + bi, fp1 = G[(t + 1) * 8 + 4 + h] + bfv;
    const float lf0 = fminf(fp0, 0.f) - log1pf(expf(-fabsf(fp0))), lf1 = fminf(fp1, 0.f) - log1pf(expf(-fabsf(fp1)));
    const float s1 = lf0 + lf1, inc = wave_incl_sum(s1, lane), excl = inc - s1;
    ChunkGates g; g.b0 = excl + lf0; g.b1 = inc; g.Bc = __builtin_bit_cast(float, __builtin_amdgcn_readlane(__builtin_bit_cast(int, inc), 63)); g.a0 = ip0 - g.b0; g.a1 = ip1 - g.b1; return g;
}
__device__ __forceinline__ void ml_ktrans(const bf16* Z, bf16* AKT, LAS unsigned char* lds) {
    int tid_ = threadIdx.x; asm volatile("" : "+v"(tid_));
    const int lane = tid_ & 63, wave = __builtin_amdgcn_readfirstlane(tid_ >> 6), gw = blockIdx.x * 8 + wave, nw = gridDim.x * 8;
    LAS unsigned short* tl = (LAS unsigned short*)(lds + wave * 16384);
    for (int u = gw; u < 2048; u += nw) { const int tok0 = (u >> 4) * 64, ch0 = (u & 15) * 64;
#pragma unroll
        for (int i = 0; i < 8; ++i) { const int tk = 8 * i + (lane >> 3), cc = (lane & 7) * 8;
            *(LAS u32x4v*)(tl + tk * 72 + cc) = *(const u32x4v*)(Z + (size_t)(tok0 + tk) * NZ + Z_AK + ch0 + cc); }
        asm volatile("s_waitcnt lgkmcnt(0)" ::: "memory");
#pragma unroll
        for (int i = 0; i < 8; ++i) { const int ch = 8 * i + (lane >> 3), tc = (lane & 7) * 8; unsigned w[4];
#pragma unroll
            for (int e = 0; e < 4; ++e) w[e] = (unsigned)tl[(tc + 2 * e) * 72 + ch] | ((unsigned)tl[(tc + 2 * e + 1) * 72 + ch] << 16);
            *(uint4*)(AKT + (size_t)(ch0 + ch) * T_SEQ + tok0 + tc) = make_uint4(w[0], w[1], w[2], w[3]); }
        asm volatile("s_waitcnt lgkmcnt(0)" ::: "memory");
    }
}
template <int CHUNKS> __device__ __forceinline__ void ml_stage(LAS unsigned char* dst, const bf16* src, size_t row_stride, int tid) {
    asm volatile("" : "+v"(tid));
    u32x4v v[8];
#pragma unroll
    for (int i = 0; i < 8; ++i) { const int idx = tid + 512 * i, row = idx / CHUNKS, c = idx % CHUNKS; v[i] = *(const u32x4v*)(src + (size_t)row * row_stride + c * 8); }
#pragma unroll
    for (int i = 0; i < 8; ++i) { const int idx = tid + 512 * i, row = idx / CHUNKS, c = idx % CHUNKS; *(LAS u32x4v*)(dst + row * (CHUNKS * 16) + ((c ^ (row & 15)) << 4)) = v[i]; }
}
#define ML_BAR() do { asm volatile("s_waitcnt vmcnt(0) lgkmcnt(0)" ::: "memory"); __builtin_amdgcn_s_barrier(); asm volatile("" ::: "memory"); } while (0)
__device__ __forceinline__ void ml_local(const bf16* ZT, const bf16* AKT, const float* G, const float* b_i, const float* b_f, float* __restrict__ LST, float* __restrict__ NL, float2* __restrict__ BG, LAS unsigned char* lds) {
    int tid_ = threadIdx.x; asm volatile("" : "+v"(tid_));
    const int tid = tid_, lane = tid & 63, wave = __builtin_amdgcn_readfirstlane(tid >> 6), r = lane & 31, hh = lane >> 5, it = wave;
    LAS float* wl = (LAS float*)(lds + LDS_MISC + 12288);
    for (int u = blockIdx.x; u < ML_NC * 4; u += gridDim.x) { const int c = u >> 2, h = u & 3, tok0 = c * ML_L;
        ML_BAR();
        ml_stage<16>(lds, ZT + (size_t)(ZT_AV + h * 256) * T_SEQ + tok0, T_SEQ, tid);
        ml_stage<16>(lds + 65536, AKT + (size_t)(h * 256) * T_SEQ + tok0, T_SEQ, tid);
        if (wave == 0) { const ChunkGates cg = chunk_gates(G, b_i[h], b_f[h], tok0, h, lane);
            const float g0 = cg.Bc + cg.a0, g1 = cg.Bc + cg.a1, Gc = wave_max(fmaxf(g0, g1));
            wl[2 * lane] = __expf(g0 - Gc); wl[2 * lane + 1] = __expf(g1 - Gc);
            if (lane == 0) BG[h * ML_NC + c] = make_float2(cg.Bc, Gc); }
        ML_BAR();
        f32x16 acc[8];
#pragma unroll
        for (int jt = 0; jt < 8; ++jt)
#pragma unroll
            for (int i = 0; i < 16; ++i) acc[jt][i] = 0.f;
        const int vrow = 32 * it + r, x = r & 15;
#pragma unroll 2
        for (int s = 0; s < 8; ++s) {
            const u32x4v vr = *(const LAS u32x4v*)(lds + vrow * 256 + (((2 * s + hh) ^ x) << 4));
            const f32x4v w0 = *(const LAS f32x4v*)(wl + 16 * s + 8 * hh), w1 = *(const LAS f32x4v*)(wl + 16 * s + 8 * hh + 4);
            float vv[8] = {lo_bf(vr[0]) * w0[0], hi_bf(vr[0]) * w0[1], lo_bf(vr[1]) * w0[2], hi_bf(vr[1]) * w0[3], lo_bf(vr[2]) * w1[0], hi_bf(vr[2]) * w1[1], lo_bf(vr[3]) * w1[2], hi_bf(vr[3]) * w1[3]};
            const bf16x8 af = pack8(vv);
#pragma unroll
            for (int jt = 0; jt < 8; ++jt) { const bf16x8 bfr = *(const LAS bf16x8*)(lds + 65536 + (32 * jt + r) * 256 + (((2 * s + hh) ^ x) << 4)); acc[jt] = MFMA32(af, bfr, acc[jt]); }
        }
        float* lo = LST + ((size_t)(c * 4 + h) * 256 + 32 * it + 4 * hh) * 256 + r;
#pragma unroll
        for (int jt = 0; jt < 8; ++jt)
#pragma unroll
            for (int i = 0; i < 16; ++i) lo[(size_t)((i & 3) + 8 * (i >> 2)) * 256 + 32 * jt] = acc[jt][i];
        { float ns = 0.f;
#pragma unroll
            for (int q = 0; q < 8; ++q) { const u32x4v kv = *(const LAS u32x4v*)(lds + 65536 + vrow * 256 + (((8 * hh + q) ^ x) << 4)); const f32x4v w0 = *(const LAS f32x4v*)(wl + 64 * hh + 8 * q), w1 = *(const LAS f32x4v*)(wl + 64 * hh + 8 * q + 4);
                ns += lo_bf(kv[0]) * w0[0] + hi_bf(kv[0]) * w0[1] + lo_bf(kv[1]) * w0[2] + hi_bf(kv[1]) * w0[3] + lo_bf(kv[2]) * w1[0] + hi_bf(kv[2]) * w1[1] + lo_bf(kv[3]) * w1[2] + hi_bf(kv[3]) * w1[3]; }
            ns += __shfl_xor(ns, 32);
            if (hh == 0) NL[(size_t)(c * 4 + h) * 256 + 32 * it + r] = ns; }
    }
    ML_BAR();
}
__device__ __forceinline__ void ml_scan(const float* __restrict__ LST, const float* __restrict__ NL, const float2* __restrict__ BG, bf16* __restrict__ CST, float* __restrict__ NST, float* __restrict__ MST) {
    int tid_ = threadIdx.x; asm volatile("" : "+v"(tid_));
    const int lane = tid_ & 63, wave = __builtin_amdgcn_readfirstlane(tid_ >> 6), gw = blockIdx.x * 8 + wave, nw = gridDim.x * 8;
    for (int u = gw; u < 2048; u += nw) {
        const int h = u >> 9; const size_t e = ((size_t)u * 64 + lane) * 2;
        const size_t eh = e - (size_t)h * 65536;
        float c0 = 0.f, c1 = 0.f, m = 0.f;
        const bool do_n = (u & 511) < 4;  const int nk = (u & 511) * 64 + lane;
        float nv = 0.f;
        for (int cb = 0; cb < ML_NC; cb += 8) {
            float2 lv[8], bg[8]; float nl[8];
#pragma unroll
            for (int j = 0; j < 8; ++j) { lv[j] = *(const float2*)(LST + (size_t)((cb + j) * 4 + h) * 65536 + eh); bg[j] = BG[h * ML_NC + cb + j]; nl[j] = do_n ? NL[(size_t)((cb + j) * 4 + h) * 256 + nk] : 0.f; }
#pragma unroll
            for (int j = 0; j < 8; ++j) { const int c = cb + j;
                *(unsigned*)(CST + (size_t)(c * 4 + h) * 65536 + eh) = pk_bf16(c0, c1);
                if (eh == 0) MST[h * ML_NC + c] = m;
                const float mn = fmaxf(bg[j].x + m, bg[j].y), dec = __expf(bg[j].x + m - mn), inj = __expf(bg[j].y - mn);
                c0 = dec * c0 + inj * lv[j].x; c1 = dec * c1 + inj * lv[j].y;
                if (do_n) { NST[(size_t)(c * 4 + h) * 256 + nk] = nv; nv = dec * nv + inj * nl[j]; }
                m = mn; }
        }
    }
}
__device__ __forceinline__ void ml_out(const bf16* Z, const bf16* ZT, const float* G, const float* b_i, const float* b_f, const bf16* CST, const float* NST, const float* MST, const float* gain, bf16* YA, LAS unsigned char* lds) {
    int tid_ = threadIdx.x; asm volatile("" : "+v"(tid_));
    const int tid = tid_, lane = tid & 63, wave = __builtin_amdgcn_readfirstlane(tid >> 6), r = lane & 31, hh = lane >> 5, qt = wave >> 1, dvh = wave & 1;
    LAS float* al = (LAS float*)(lds + LDS_MISC + 12288);
    LAS float* xch = (LAS float*)(lds + LDS_MISC + 1024);
    LAS unsigned char* TA = lds; LAS unsigned char* TB = lds + 65536;
    const int x = r & 15, kr = kperm(r), kx = kr & 15;
    for (int u = blockIdx.x; u < ML_NC * 4; u += gridDim.x) { const int c = u >> 2, h = u & 3, tok0 = c * ML_L;
        ML_BAR();
        ml_stage<32>(TA, Z + (size_t)tok0 * NZ + Z_AQ + h * 256, NZ, tid);
        ml_stage<16>(TB, CST + (size_t)(c * 4 + h) * 65536, 256, tid);
        if (wave == 0) { const ChunkGates cg = chunk_gates(G, b_i[h], b_f[h], tok0, h, lane);
            const float pm1 = fmaxf(cg.a0, cg.a1), inc = wave_incl_max(pm1, lane); float ex = __shfl_up(inc, 1); if (lane == 0) ex = -INFINITY;
            al[2 * lane] = cg.a0; al[2 * lane + 1] = cg.a1; al[128 + 2 * lane] = fmaxf(ex, cg.a0); al[128 + 2 * lane + 1] = inc; al[256 + 2 * lane] = cg.b0; al[256 + 2 * lane + 1] = cg.b1; }
        ML_BAR();
        const float mc = MST[h * ML_NC + c];
        const int tq = 32 * qt + r; const size_t tglob = (size_t)tok0 + tq;
        const float Mt = fmaxf(mc, al[128 + tq]), wi = __expf(mc - Mt), emt = __expf(-(al[256 + tq] + Mt));
        f32x16 acc[4];
#pragma unroll
        for (int dt = 0; dt < 4; ++dt)
#pragma unroll
            for (int i = 0; i < 16; ++i) acc[dt][i] = 0.f;
        const float* nrow = NST + (size_t)(c * 4 + h) * 256 + 8 * hh;
        float qn = 0.f;
#pragma unroll
        for (int half = 0; half < 2; ++half) {
            if (half == 1) { ML_BAR(); ml_stage<16>(TB, CST + (size_t)(c * 4 + h) * 65536 + 128, 256, tid); ML_BAR(); }
#pragma unroll 2
            for (int s8 = 0; s8 < 8; ++s8) { const int s = 8 * half + s8;
                const u32x4v qr = *(const LAS u32x4v*)(TA + tq * 512 + (((2 * s + hh) ^ x) << 4)); const bf16x8 qf = __builtin_bit_cast(bf16x8, qr);
                const float4 n0 = *(const float4*)(nrow + 16 * s), n1 = *(const float4*)(nrow + 16 * s + 4);
                qn += lo_bf(qr[0]) * n0.x + hi_bf(qr[0]) * n0.y + lo_bf(qr[1]) * n0.z + hi_bf(qr[1]) * n0.w + lo_bf(qr[2]) * n1.x + hi_bf(qr[2]) * n1.y + lo_bf(qr[3]) * n1.z + hi_bf(qr[3]) * n1.w;
#pragma unroll
                for (int dt = 0; dt < 4; ++dt) { const bf16x8 cf = *(const LAS bf16x8*)(TB + (128 * dvh + 32 * dt + r) * 256 + (((2 * s8 + hh) ^ x) << 4)); acc[dt] = MFMA32(cf, qf, acc[dt]); }
            }
        }
        qn += __shfl_xor(qn, 32);
#pragma unroll
        for (int dt = 0; dt < 4; ++dt)
#pragma unroll
            for (int i = 0; i < 16; ++i) acc[dt][i] *= wi;
        ML_BAR(); ml_stage<32>(TB, Z + (size_t)tok0 * NZ + Z_AK + h * 256, NZ, tid); ML_BAR();
        bf16x8 pf[4][2]; float dsum = 0.f;
#pragma unroll
        for (int kt = 0; kt < 4; ++kt) { if (kt <= qt) {
            f32x16 X;
#pragma unroll
            for (int i = 0; i < 16; ++i) X[i] = 0.f;
#pragma unroll 2
            for (int s = 0; s < 16; ++s) { const bf16x8 kf = *(const LAS bf16x8*)(TB + (32 * kt + kr) * 512 + (((2 * s + hh) ^ kx) << 4)), qf = *(const LAS bf16x8*)(TA + tq * 512 + (((2 * s + hh) ^ x) << 4)); X = MFMA32(kf, qf, X); }
            float P[16];
#pragma unroll
            for (int g8 = 0; g8 < 2; ++g8) { const int s0 = 32 * kt + 16 * g8 + 8 * hh; const f32x4v a0 = *(const LAS f32x4v*)(al + s0), a1 = *(const LAS f32x4v*)(al + s0 + 4);
#pragma unroll
                for (int e = 0; e < 8; ++e) { const float av = (e < 4) ? a0[e & 3] : a1[e & 3]; const float p = (s0 + e <= tq) ? X[8 * g8 + e] * __expf(av - Mt) : 0.f; P[8 * g8 + e] = p; dsum += p; } }
            pf[kt][0] = pack8(P); pf[kt][1] = pack8(P + 8); } }
        dsum += __shfl_xor(dsum, 32);
        ML_BAR(); ml_stage<16>(TB, ZT + (size_t)(ZT_AV + h * 256) * T_SEQ + tok0, T_SEQ, tid); ML_BAR();
#pragma unroll
        for (int kt = 0; kt < 4; ++kt) { if (kt <= qt) {
#pragma unroll
            for (int s2 = 0; s2 < 2; ++s2)
#pragma unroll
                for (int dt = 0; dt < 4; ++dt) { const bf16x8 vf = *(const LAS bf16x8*)(TB + (128 * dvh + 32 * dt + r) * 256 + (((4 * kt + 2 * s2 + hh) ^ x) << 4)); acc[dt] = MFMA32(vf, pf[kt][s2], acc[dt]); } } }
        const float den = dsum + wi * qn, inv = 1.f / fmaxf(fabsf(den), emt);
        float ss = 0.f;
#pragma unroll
        for (int dt = 0; dt < 4; ++dt)
#pragma unroll
            for (int i = 0; i < 16; ++i) { acc[dt][i] *= inv; ss += acc[dt][i] * acc[dt][i]; }
        ss += __shfl_xor(ss, 32);
        if (hh == 0) xch[wave * 32 + r] = ss;
        ML_BAR();
        const float rs = rsqrtf((ss + xch[(wave ^ 1) * 32 + r]) * (1.f / 256.f) + RMS_EPS);
#pragma unroll
        for (int dt = 0; dt < 4; ++dt)
#pragma unroll
            for (int gq = 0; gq < 4; ++gq) { const int dv0 = 128 * dvh + 32 * dt + 8 * gq + 4 * hh;
                const uint2 ow = *(const uint2*)(Z + tglob * NZ + Z_AO + h * 256 + dv0); const float4 gg = *(const float4*)(gain + h * 256 + dv0);
                const float y0 = sigmoidf_(lo_bf(ow.x)) * acc[dt][4 * gq] * rs * gg.x, y1 = sigmoidf_(hi_bf(ow.x)) * acc[dt][4 * gq + 1] * rs * gg.y,
                            y2 = sigmoidf_(lo_bf(ow.y)) * acc[dt][4 * gq + 2] * rs * gg.z, y3 = sigmoidf_(hi_bf(ow.y)) * acc[dt][4 * gq + 3] * rs * gg.w;
                *(uint2*)(YA + tglob * 1024 + h * 256 + dv0) = make_uint2(pk_bf16(y0, y1), pk_bf16(y2, y3)); }
    }
    ML_BAR();
}
constexpr float MOBA_SCALE = 0.08838834764831845f;
__device__ __forceinline__ void moba_kmean(const bf16* Z, float* KMP) {
    int tid_ = threadIdx.x; asm volatile("" : "+v"(tid_));
    const int lane = tid_ & 63, wave = __builtin_amdgcn_readfirstlane(tid_ >> 6), gw = blockIdx.x * 8 + wave, nw = gridDim.x * 8;
    for (int u = gw; u < 512; u += nw) { const int h = u >> 6, n = (u >> 1) & 31, half = u & 1; float s[8];
#pragma unroll
        for (int e = 0; e < 8; ++e) s[e] = 0.f;
        const bf16* kp = Z + (size_t)(n * 256 + half * 128 + (lane >> 4)) * NZ + Z_BK + h * 128 + (lane & 15) * 8;
#pragma unroll 8
        for (int j = 0; j < 32; ++j) { const uint4 w = *(const uint4*)(kp + (size_t)(4 * j) * NZ);
            s[0] += lo_bf(w.x); s[1] += hi_bf(w.x); s[2] += lo_bf(w.y); s[3] += hi_bf(w.y); s[4] += lo_bf(w.z); s[5] += hi_bf(w.z); s[6] += lo_bf(w.w); s[7] += hi_bf(w.w); }
#pragma unroll
        for (int e = 0; e < 8; ++e) { s[e] += __shfl_xor(s[e], 16); s[e] += __shfl_xor(s[e], 32); }
        if (lane < 16) { float* o = KMP + (size_t)u * 128 + lane * 8; *(float4*)o = make_float4(s[0], s[1], s[2], s[3]); *(float4*)(o + 4) = make_float4(s[4], s[5], s[6], s[7]); } }
}
__device__ __forceinline__ void top3_insert(float g, int n, float& v1, float& v2, float& v3, int& i1, int& i2, int& i3) {
    const bool b1 = (g > v1) || (g == v1 && n < i1), b2 = (g > v2) || (g == v2 && n < i2), b3 = (g > v3) || (g == v3 && n < i3);
    const float nv3 = b2 ? v2 : (b3 ? g : v3), nv2 = b1 ? v1 : (b2 ? g : v2), nv1 = b1 ? g : v1;
    const int ni3 = b2 ? i2 : (b3 ? n : i3), ni2 = b1 ? i1 : (b2 ? n : i2), ni1 = b1 ? n : i1;
    v1 = nv1; v2 = nv2; v3 = nv3; i1 = ni1; i2 = ni2; i3 = ni3;
}
__device__ __forceinline__ void moba_select(const bf16* Z, const float* KM, unsigned* SEL, float* PLSE, LAS unsigned char* lds) {
    int tid_ = threadIdx.x; asm volatile("" : "+v"(tid_));
    const int lane = tid_ & 63, wave = __builtin_amdgcn_readfirstlane(tid_ >> 6), r = lane & 31, hh = lane >> 5, gw = blockIdx.x * 8 + wave, nw = gridDim.x * 8;
    for (int u = gw; u < 2048; u += nw) { const int h = u & 7, t0 = (u >> 3) * 32, qb = t0 >> 8; const size_t t = (size_t)t0 + r;
        f32x16 X;
#pragma unroll
        for (int i = 0; i < 16; ++i) X[i] = 0.f;
        if (qb > 0) {
            const bf16* qp = Z + t * NZ + Z_BQ + h * 128 + 8 * hh;
            const float* kq = KM + ((size_t)(h * 32 + r) * 2) * 128 + 8 * hh;
#pragma unroll 2
            for (int s = 0; s < 8; ++s) { const bf16x8 qf = *(const bf16x8*)(qp + 16 * s);
                const float4 a0 = *(const float4*)(kq + 16 * s), a1 = *(const float4*)(kq + 16 * s + 4), b0 = *(const float4*)(kq + 128 + 16 * s), b1 = *(const float4*)(kq + 128 + 16 * s + 4);
                float km[8] = {(a0.x + b0.x) * (1.f / 256.f), (a0.y + b0.y) * (1.f / 256.f), (a0.z + b0.z) * (1.f / 256.f), (a0.w + b0.w) * (1.f / 256.f), (a1.x + b1.x) * (1.f / 256.f), (a1.y + b1.y) * (1.f / 256.f), (a1.z + b1.z) * (1.f / 256.f), (a1.w + b1.w) * (1.f / 256.f)};
                float hi[8], lo[8];
#pragma unroll
                for (int e = 0; e < 8; ++e) { hi[e] = __uint_as_float(__float_as_uint(km[e]) & 0xffff0000u); lo[e] = km[e] - hi[e]; }
                X = MFMA32(pack8(hi), qf, X); X = MFMA32(pack8(lo), qf, X); }
        }
        float v1 = -INFINITY, v2 = -INFINITY, v3 = -INFINITY; int i1 = 255, i2 = 255, i3 = 255;
#pragma unroll
        for (int i = 0; i < 16; ++i) { const int n = (i & 3) + 8 * (i >> 2) + 4 * hh; top3_insert((n < qb) ? X[i] : -INFINITY, (n < qb) ? n : 255, v1, v2, v3, i1, i2, i3); }
        const float p1 = __shfl_xor(v1, 32), p2 = __shfl_xor(v2, 32), p3 = __shfl_xor(v3, 32); const int j1 = __shfl_xor(i1, 32), j2 = __shfl_xor(i2, 32), j3 = __shfl_xor(i3, 32);
        top3_insert(p1, j1, v1, v2, v3, i1, i2, i3); top3_insert(p2, j2, v1, v2, v3, i1, i2, i3); top3_insert(p3, j3, v1, v2, v3, i1, i2, i3);
        if (hh == 0) { SEL[(size_t)h * T_SEQ + t] = (unsigned)i1 | ((unsigned)i2 << 8) | ((unsigned)i3 << 16);
            float* pl = PLSE + (t * 8 + h) * 3;
            if (i1 == 255) pl[0] = -INFINITY;
            if (i2 == 255) pl[1] = -INFINITY;
            if (i3 == 255) pl[2] = -INFINITY; }
    }
}
__device__ __forceinline__ void moba_stage(const bf16* Z, const bf16* ZT, int h, int kb, LAS unsigned char* lds, int tid) {
    asm volatile("" : "+v"(tid));
    u32x4v kv[8], vv[8];
#pragma unroll
    for (int i = 0; i < 8; ++i) { const int idx = tid + 512 * i, row = idx >> 4, c = idx & 15; kv[i] = *(const u32x4v*)(Z + (size_t)(kb * 256 + row) * NZ + Z_BK + h * 128 + c * 8); }
#pragma unroll
    for (int i = 0; i < 8; ++i) { const int idx = tid + 512 * i, row = idx >> 5, c = idx & 31; vv[i] = *(const u32x4v*)(ZT + (size_t)(ZT_BV + h * 128 + row) * T_SEQ + kb * 256 + c * 8); }
#pragma unroll
    for (int i = 0; i < 8; ++i) { const int idx = tid + 512 * i, row = idx >> 4, c = idx & 15; *(LAS u32x4v*)(lds + row * 256 + ((c ^ (row & 15)) << 4)) = kv[i]; }
#pragma unroll
    for (int i = 0; i < 8; ++i) { const int idx = tid + 512 * i, row = idx >> 5, c = idx & 31; *(LAS u32x4v*)(lds + 65536 + row * 512 + ((c ^ (row & 15)) << 4)) = vv[i]; }
}
__device__ __forceinline__ void moba_tile(const bf16* Z, LAS unsigned char* lds, int h, int nkt, int diag, size_t tq, int qloc, int r, int hh, f32x16 (&acc)[4], float& m_out, float& l_out) {
    bf16x8 qf[8];
    const bf16* qp = Z + tq * NZ + Z_BQ + h * 128 + 8 * hh;
#pragma unroll
    for (int s = 0; s < 8; ++s) qf[s] = *(const bf16x8*)(qp + 16 * s);
#pragma unroll
    for (int dt = 0; dt < 4; ++dt)
#pragma unroll
        for (int i = 0; i < 16; ++i) acc[dt][i] = 0.f;
    float m = -1e30f, l = 0.f;
    const int kr = kperm(r), kx = kr & 15, vx = r & 15;
    for (int kt = 0; kt < nkt; ++kt) {
        f32x16 X;
#pragma unroll
        for (int i = 0; i < 16; ++i) X[i] = 0.f;
        LAS unsigned char* kb_ = lds + (32 * kt + kr) * 256;
#pragma unroll
        for (int s = 0; s < 8; ++s) { const bf16x8 kf = *(const LAS bf16x8*)(kb_ + (((2 * s + hh) ^ kx) << 4)); X = MFMA32(kf, qf[s], X); }
        float mx = -1e30f;
#pragma unroll
        for (int i = 0; i < 16; ++i) { float x = X[i] * MOBA_SCALE; if (kt == diag && (32 * kt + (i & 7) + 8 * hh + 16 * (i >> 3)) > qloc) x = -1e30f; X[i] = x; mx = fmaxf(mx, x); }
        mx = fmaxf(mx, __shfl_xor(mx, 32));
        const float mn = fmaxf(m, mx), alpha = __expf(m - mn);
        l *= alpha;
#pragma unroll
        for (int dt = 0; dt < 4; ++dt)
#pragma unroll
            for (int i = 0; i < 16; ++i) acc[dt][i] *= alpha;
        float P[16];
#pragma unroll
        for (int i = 0; i < 16; ++i) { const float p = (X[i] > -1e29f) ? __expf(X[i] - mn) : 0.f; P[i] = p; l += p; }
        m = mn;
#pragma unroll
        for (int s2 = 0; s2 < 2; ++s2) { const bf16x8 pf = pack8(P + 8 * s2);
#pragma unroll
            for (int dt = 0; dt < 4; ++dt) { const bf16x8 vf = *(const LAS bf16x8*)(lds + 65536 + (32 * dt + r) * 512 + (((4 * kt + 2 * s2 + hh) ^ vx) << 4)); acc[dt] = MFMA32(vf, pf, acc[dt]); } }
    }
    l += __shfl_xor(l, 32);
    m_out = m; l_out = l;
}
constexpr int MOBA_SEGS = 9, MOBA_ITEMS_PER_HEAD = 98, MOBA_ITEMS = 8 * MOBA_ITEMS_PER_HEAD;
__device__ __forceinline__ void moba_gather(const bf16* Z, const bf16* ZT, const unsigned* SEL, bf16* PO, float* PLSE, unsigned* qctr, LAS unsigned char* lds) {
    int tid_ = threadIdx.x; asm volatile("" : "+v"(tid_));
    const int tid = tid_, lane = tid & 63, wave = __builtin_amdgcn_readfirstlane(tid >> 6), r = lane & 31, hh = lane >> 5;
    LAS unsigned* cntp = (LAS unsigned*)(lds + LDS_MISC + 2048); LAS unsigned* lst = (LAS unsigned*)(lds + LDS_MISC + 4096);
    LAS unsigned* itp = (LAS unsigned*)(lds + LDS_MISC + 2048 + 64);
    for (;;) {
        __syncthreads();
        if (tid == 0) *itp = __hip_atomic_fetch_add(qctr, 1u, __ATOMIC_RELAXED, __HIP_MEMORY_SCOPE_AGENT);
        asm volatile("s_waitcnt vmcnt(0) lgkmcnt(0)" ::: "memory"); __syncthreads();
        const int it = (int)*itp; if (it >= MOBA_ITEMS) break;
        const int h = it & 7; int k = it >> 3, seg = 0, sa = 1, sb = 2;
        if (k < 76) { for (;;) { const int cnt = (sa < sb - 1) ? sa : sb - 1; if (k < cnt) break; k -= cnt; ++seg; sa = sb; sb = (seg < 3) ? sb + 1 : (seg < 5 ? sb + 2 : (seg < 7 ? sb + 4 : sb + 8)); } }
        else { k -= 76; for (;;) { const int cnt = (sb - 1 > sa) ? sb - 1 - sa : 0; if (k < cnt) break; k -= cnt; ++seg; sa = sb; sb = (seg < 3) ? sb + 1 : (seg < 5 ? sb + 2 : (seg < 7 ? sb + 4 : sb + 8)); } k += sa; }
        const int n = k, qa = (sa > n + 1) ? sa : n + 1;
        __syncthreads();
        moba_stage(Z, ZT, h, n, lds, tid);
        for (int base = qa * 256; base < sb * 256; base += 1024) {
            if (tid == 0) *cntp = 0u;
            asm volatile("s_waitcnt lgkmcnt(0)" ::: "memory"); __syncthreads();
#pragma unroll
            for (int sub = 0; sub < 2; ++sub) { const int t = base + sub * 512 + tid; int slot = -1;
                if (t < sb * 256) { const unsigned sel = SEL[(size_t)h * T_SEQ + t]; slot = ((sel & 0xffu) == (unsigned)n) ? 0 : ((((sel >> 8) & 0xffu) == (unsigned)n) ? 1 : ((((sel >> 16) & 0xffu) == (unsigned)n) ? 2 : -1)); }
                const unsigned long long bal = __ballot(slot >= 0); const int nb = __popcll(bal);
                unsigned wbase = 0u; if (lane == 0 && nb) wbase = __hip_atomic_fetch_add(cntp, (unsigned)nb, __ATOMIC_RELAXED, __HIP_MEMORY_SCOPE_WORKGROUP);
                wbase = __builtin_amdgcn_readfirstlane(wbase);
                if (slot >= 0) lst[wbase + __popcll(bal & ((1ull << lane) - 1ull))] = (unsigned)t | ((unsigned)slot << 16); }
            asm volatile("s_waitcnt lgkmcnt(0)" ::: "memory"); __syncthreads();
            const int count = (int)*cntp;
            for (int tb = wave * 32; tb < count; tb += 256) {
                const bool live = (tb + r) < count; const unsigned ent = lst[live ? tb + r : tb];
                const size_t tq = ent & 0xffffu; const int slot = (int)(ent >> 16);
                f32x16 acc[4]; float m, l;
                moba_tile(Z, lds, h, 8, -1, tq, 0, r, hh, acc, m, l);
                const float inv = 1.f / l;
                if (live) { bf16* po = PO + (((size_t)tq * 8 + h) * 3 + slot) * 128;
#pragma unroll
                    for (int dt = 0; dt < 4; ++dt)
#pragma unroll
                        for (int gq = 0; gq < 4; ++gq) *(uint2*)(po + 32 * dt + 8 * gq + 4 * hh) = make_uint2(pk_bf16(acc[dt][4 * gq] * inv, acc[dt][4 * gq + 1] * inv), pk_bf16(acc[dt][4 * gq + 2] * inv, acc[dt][4 * gq + 3] * inv));
                    if (hh == 0) PLSE[((size_t)tq * 8 + h) * 3 + slot] = m + __logf(l); }
            }
            __syncthreads();
        }
    }
    __syncthreads();
}
__device__ __forceinline__ void moba_own(const bf16* Z, const bf16* ZT, const bf16* PO, const float* PLSE, bf16* YB, LAS unsigned char* lds) {
    int tid_ = threadIdx.x; asm volatile("" : "+v"(tid_));
    const int tid = tid_, lane = tid & 63, wave = __builtin_amdgcn_readfirstlane(tid >> 6), r = lane & 31, hh = lane >> 5;
    for (int it = blockIdx.x; it < 256; it += gridDim.x) { const int h = it >> 5, qb = it & 31, kd = wave;
        __syncthreads();
        moba_stage(Z, ZT, h, qb, lds, tid);
        asm volatile("s_waitcnt lgkmcnt(0)" ::: "memory"); __syncthreads();
        const size_t tq = (size_t)qb * 256 + 32 * kd + r; const int qloc = 32 * kd + r;
        f32x16 acc[4]; float m, l;
        moba_tile(Z, lds, h, kd + 1, kd, tq, qloc, r, hh, acc, m, l);
        const float* pl = PLSE + (tq * 8 + h) * 3; const float e0 = pl[0], e1 = pl[1], e2 = pl[2];
        const float M = fmaxf(fmaxf(m, e0), fmaxf(e1, e2));
        const float wo = __expf(m - M), w0 = __expf(e0 - M), w1 = __expf(e1 - M), w2 = __expf(e2 - M), inv = 1.f / (l * wo + w0 + w1 + w2);
        const bf16* po = PO + ((tq * 8 + h) * 3) * 128;
#pragma unroll
        for (int dt = 0; dt < 4; ++dt)
#pragma unroll
            for (int gq = 0; gq < 4; ++gq) { const int d0 = 32 * dt + 8 * gq + 4 * hh;
                float o0 = acc[dt][4 * gq] * wo, o1 = acc[dt][4 * gq + 1] * wo, o2 = acc[dt][4 * gq + 2] * wo, o3 = acc[dt][4 * gq + 3] * wo;
                if (w0 > 0.f) { const uint2 p = *(const uint2*)(po + d0); o0 += w0 * lo_bf(p.x); o1 += w0 * hi_bf(p.x); o2 += w0 * lo_bf(p.y); o3 += w0 * hi_bf(p.y); }
                if (w1 > 0.f) { const uint2 p = *(const uint2*)(po + 128 + d0); o0 += w1 * lo_bf(p.x); o1 += w1 * hi_bf(p.x); o2 += w1 * lo_bf(p.y); o3 += w1 * hi_bf(p.y); }
                if (w2 > 0.f) { const uint2 p = *(const uint2*)(po + 256 + d0); o0 += w2 * lo_bf(p.x); o1 += w2 * hi_bf(p.x); o2 += w2 * lo_bf(p.y); o3 += w2 * hi_bf(p.y); }
                *(uint2*)(YB + tq * 1024 + h * 128 + d0) = make_uint2(pk_bf16(o0 * inv, o1 * inv), pk_bf16(o2 * inv, o3 * inv)); }
    }
    __syncthreads();
}

typedef const __attribute__((address_space(4))) MegaArgs* KArgs;
#define KP() ({ KArgs kp_ = kp0; asm volatile("" : "+s"(kp_)); kp_; })
__global__ void __launch_bounds__(512, 2) mega(MegaArgs a) {
    extern __shared__ __attribute__((aligned(16))) unsigned char lds_raw[];
    LAS unsigned char* lds = (LAS unsigned char*)lds_raw;
    volatile LAS unsigned* MISC = (volatile LAS unsigned*)(lds + LDS_MISC);
    for (int u = threadIdx.x; u < (LDS_BYTES - LDS_MISC) / 4; u += 512) ((LAS unsigned*)(lds + LDS_MISC))[u] = 0u;
    __syncthreads();
    const KArgs kp0 = (KArgs)__builtin_amdgcn_kernarg_segment_ptr();
    XcdBarrier bar = xcd_barrier_post((unsigned*)(a.ws + WS_CTL) + CW_BAR + a.li * XCD_BAR_WORDS, MISC + 8);
    const int G_ = (int)gridDim.x, c_ = (int)blockIdx.x;
#define PH(k) (kp0->p_lo <= (k) && (k) < kp0->p_hi)
    if (a.do_pro) { convert_range(kp0, lds, 0, CVT_PRO, c_, G_);
        phase_xinit(a.in[0], (float*)(a.ws + WS_X), (bf16*)(a.ws + WS_HN), (float*)(a.ws + WS_SCR + SC_SSQ)); xcd_barrier(bar); }
    const int s_lo = a.s_lo, s_hi = a.s_hi;
    for (int s = s_lo; s < s_hi; ++s) {
        const int l = s >> 1, half = s & 1;
        if (PH(1)) { KArgs kp = KP(); unsigned char* ws = kp->ws; unsigned char* lw = ws + WS_W + (size_t)l * LW_STRIDE;
            pg8::Gemm g{(const bf16*)(ws + WS_HN), (const bf16*)(lw + (half ? LW_GU2 : LW_GU1)), T_SEQ, NGU, DM}; pg8::StaticOrder S; S.init(T_SEQ, NGU, G_, c_);
            PG8_LAS float* tab = (PG8_LAS float*)(lds + LDS_MISC + 1024); int panel = -1; { pg8::Unit u0; if (S.next(0, u0)) { panel = u0.pm; pg8::rstd_table((const float*)(ws + WS_SCR + SC_SSQ), tab, panel, (int)threadIdx.x); } }
            pg8::EpiSwiGLU E{(bf16*)(ws + WS_HID), (const float*)(ws + WS_SCR + SC_SSQ), tab, DFF, panel}; pg8::gemm_phase<pg8::EpiSwiGLU, pg8::StaticOrder, true, true>(lds, g, S, E);
            { const int rem = ((T_SEQ / 256) * (NGU / 256)) % G_, q = 3 * l + (half ? 2 : 0), hi = cvt_slot_hi(q) < CVT_TOTAL ? cvt_slot_hi(q) : CVT_TOTAL;
              if (rem && c_ >= rem && cvt_slot_lo(q) < hi) { KArgs kq = KP(); convert_range(kq, lds, cvt_slot_lo(q), hi, c_ - rem, G_ - rem); } }
            xcd_barrier(bar); }
        if (PH(2)) { KArgs kp = KP(); unsigned char* ws = kp->ws; unsigned char* lw = ws + WS_W + (size_t)l * LW_STRIDE;
            pg8::Gemm g{(const bf16*)(ws + WS_HID), (const bf16*)(lw + (half ? LW_D2 : LW_D1)), T_SEQ, DM, DFF}; pg8::StaticOrder S; S.init(T_SEQ, DM, G_, c_);
            pg8::EpiResAdd E{(float*)(ws + WS_X), (bf16*)(ws + WS_HN), (float*)(ws + WS_SCR + SC_SSQ), DM, kp->pad ? 0.f : 0.5f}; pg8::gemm_phase<pg8::EpiResAdd, pg8::StaticOrder, true, true>(lds, g, S, E); xcd_barrier(bar); }
        if (half == 0) {
            if (PH(4)) { KArgs kp = KP(); unsigned char* ws = kp->ws; unsigned char* lw = ws + WS_W + (size_t)l * LW_STRIDE;
                pg8::Gemm g{(const bf16*)(ws + WS_HN), (const bf16*)(lw + LW_IN), T_SEQ, NZP, DM}; pg8::ZOrder S; S.init(T_SEQ, NZP, G_, c_);
                PG8_LAS float* tab = (PG8_LAS float*)(lds + LDS_MISC + 1024); int panel = -1; { pg8::Unit u0; if (S.next(0, u0)) { panel = (u0.aux == 2) ? u0.pn : u0.pm; pg8::rstd_table((const float*)(ws + WS_SCR + SC_SSQ), tab, panel, (int)threadIdx.x); } }
                pg8::EpiZ E{(bf16*)(ws + WS_Z), (float*)(ws + WS_G), (bf16*)(ws + WS_ZT), (const float*)(ws + WS_SCR + SC_SSQ), tab, NZ, T_SEQ, panel, 0}; pg8::gemm_phase<pg8::EpiZ, pg8::ZOrder, true, true>(lds, g, S, E);
                { const int rem = ((T_SEQ / 256) * (NZP / 256)) % G_, q = 3 * l + 1, hi = cvt_slot_hi(q) < CVT_TOTAL ? cvt_slot_hi(q) : CVT_TOTAL;
                  if (rem && c_ >= rem && cvt_slot_lo(q) < hi) { KArgs kq = KP(); convert_range(kq, lds, cvt_slot_lo(q), hi, c_ - rem, G_ - rem); } }
                xcd_barrier(bar); }
            if (PH(5)) {
#if MIX_MOBA
                { KArgs kp = KP(); unsigned char* ws = kp->ws; moba_kmean((const bf16*)(ws + WS_Z), (float*)(ws + WS_SCR + SC_KM)); }
#endif
#if MIX_ML
                { KArgs kp = KP(); unsigned char* ws = kp->ws; ml_ktrans((const bf16*)(ws + WS_Z), (bf16*)(ws + WS_SCR + SC_AKT), lds); }
#endif
#if MIX_LRU
                { KArgs kp = KP(); unsigned char* ws = kp->ws; unsigned char* lw = ws + WS_W + (size_t)l * LW_STRIDE;
                  lru_pass<1>((const bf16*)(ws + WS_Z), (const bf16*)(lw + LW_LRU), kp->in[10] + (size_t)l * 4096, kp->in[11] + (size_t)l * 1024, kp->in[13] + (size_t)l * 1024, kp->in[15] + (size_t)l * 1024, kp->in[16] + (size_t)l * 1024,
                              (float2*)(ws + WS_SCR + SC_CARRY), (bf16*)(ws + WS_YC), lds); }
#endif
                xcd_barrier(bar); }
            if (PH(6)) {
#if MIX_MOBA
                { KArgs kp = KP(); unsigned char* ws = kp->ws; unsigned char* sc = ws + WS_SCR; moba_select((const bf16*)(ws + WS_Z), (const float*)(sc + SC_KM), (unsigned*)(sc + SC_SEL), (float*)(sc + SC_PLSE), lds); }
#endif
#if MIX_ML
                { KArgs kp = KP(); unsigned char* ws = kp->ws; unsigned char* sc = ws + WS_SCR;
                  ml_local((const bf16*)(ws + WS_ZT), (const bf16*)(sc + SC_AKT), (const float*)(ws + WS_G), kp->in[7] + l * 4, kp->in[8] + l * 4, (float*)(sc + SC_LST), (float*)(sc + SC_NL), (float2*)(sc + SC_BG), lds); }
#endif
#if MIX_LRU
                { KArgs kp = KP(); unsigned char* ws = kp->ws; unsigned char* lw = ws + WS_W + (size_t)l * LW_STRIDE;
                  lru_pass<2>((const bf16*)(ws + WS_Z), (const bf16*)(lw + LW_LRU), kp->in[10] + (size_t)l * 4096, kp->in[11] + (size_t)l * 1024, kp->in[13] + (size_t)l * 1024, kp->in[15] + (size_t)l * 1024, kp->in[16] + (size_t)l * 1024,
                              (float2*)(ws + WS_SCR + SC_CARRY), (bf16*)(ws + WS_YC), lds); }
#endif
                xcd_barrier(bar); }
            if (PH(7)) {
#if MIX_MOBA
                { KArgs kp = KP(); unsigned char* ws = kp->ws; unsigned char* sc = ws + WS_SCR; moba_gather((const bf16*)(ws + WS_Z), (const bf16*)(ws + WS_ZT), (const unsigned*)(sc + SC_SEL), (bf16*)(sc + SC_PO), (float*)(sc + SC_PLSE), (unsigned*)(ws + WS_CTL) + CW_Q + l, lds); }
#endif
#if MIX_ML
                { KArgs kp = KP(); unsigned char* sc = kp->ws + WS_SCR;
                  ml_scan((const float*)(sc + SC_LST), (const float*)(sc + SC_NL), (const float2*)(sc + SC_BG), (bf16*)(sc + SC_CST), (float*)(sc + SC_NST), (float*)(sc + SC_MST)); }
#endif
                xcd_barrier(bar); }
            if (PH(8)) {
#if MIX_MOBA
                { KArgs kp = KP(); unsigned char* ws = kp->ws; unsigned char* sc = ws + WS_SCR; moba_own((const bf16*)(ws + WS_Z), (const bf16*)(ws + WS_ZT), (const bf16*)(sc + SC_PO), (const float*)(sc + SC_PLSE), (bf16*)(ws + WS_YB), lds); }
#endif
#if MIX_ML
                { KArgs kp = KP(); unsigned char* ws = kp->ws; unsigned char* sc = ws + WS_SCR;
                  ml_out((const bf16*)(ws + WS_Z), (const bf16*)(ws + WS_ZT), (const float*)(ws + WS_G), kp->in[7] + l * 4, kp->in[8] + l * 4, (const bf16*)(sc + SC_CST), (const float*)(sc + SC_NST), (const float*)(sc + SC_MST),
                         kp->in[9] + (size_t)l * 1024, (bf16*)(ws + WS_YA), lds); }
#endif
                xcd_barrier(bar); }
            if (PH(9)) { KArgs kp = KP(); unsigned char* ws = kp->ws; unsigned char* lw = ws + WS_W + (size_t)l * LW_STRIDE;
                pg8::Gemm g{(const bf16*)(ws + WS_YA), (const bf16*)(lw + LW_UPA), T_SEQ, DM, 1024}; pg8::MergeOrder S; S.init(T_SEQ, DM, G_, c_); S.astride = SZ_Y / 2; S.bstride = SZ_WUP / 2;
                pg8::EpiMerge E{(bf16*)(ws + WS_MG), (const bf16*)(ws + WS_Z) + Z_GA, DM, NZ, 2048, 0}; pg8::gemm_phase<pg8::EpiMerge, pg8::MergeOrder, true, true>(lds, g, S, E); xcd_barrier(bar); }
            if (PH(10)) { KArgs kp = KP(); unsigned char* ws = kp->ws; unsigned char* lw = ws + WS_W + (size_t)l * LW_STRIDE;
                pg8::Gemm g{(const bf16*)(ws + WS_MG), (const bf16*)(lw + LW_OUT), T_SEQ, DM, DM}; pg8::StaticOrder S; S.init(T_SEQ, DM, G_, c_);
                pg8::EpiResAdd E{(float*)(ws + WS_X), (bf16*)(ws + WS_HN), (float*)(ws + WS_SCR + SC_SSQ), DM, kp->pad ? 0.f : 1.0f}; pg8::gemm_phase<pg8::EpiResAdd, pg8::StaticOrder, true, true>(lds, g, S, E); xcd_barrier(bar); }
        }
    }
    if (a.do_fin) phase_norm((const float*)(a.ws + WS_X), a.in[25], nullptr, a.out, nullptr);
#undef PH
}
extern "C" void kernel_launch(void* const* d_in, const int* in_sizes, int n_in, void* d_out, int out_size, void* d_ws, size_t ws_size, hipStream_t stream) {
    if (n_in != 26 || out_size != T_SEQ * DM || ws_size < WS_END) { fprintf(stderr, "kernel_launch: unexpected problem (n_in %d out %d ws %zu need %zu)\n", n_in, out_size, ws_size, (size_t)WS_END); return; }
    static int grid = 0;
    if (!grid) { int dev = 0, cus = 0, per_cu = 0; (void)hipGetDevice(&dev); (void)hipDeviceGetAttribute(&cus, hipDeviceAttributeMultiprocessorCount, dev);
        (void)hipFuncSetAttribute((const void*)mega, hipFuncAttributeMaxDynamicSharedMemorySize, LDS_BYTES);
        if (hipOccupancyMaxActiveBlocksPerMultiprocessor(&per_cu, (const void*)mega, 512, LDS_BYTES) != hipSuccess || per_cu < 1) fprintf(stderr, "kernel_launch: occupancy query reports %d blocks per CU\n", per_cu);
        (void)hipGetLastError();
        grid = 256; if (cus != 256) fprintf(stderr, "kernel_launch: built for 256 CUs (one workgroup per CU), device reports %d\n", cus); }
    unsigned char* ws = (unsigned char*)d_ws;
    (void)hipMemsetAsync(ws + WS_CTL, 0, CTL_BYTES, stream);
    MegaArgs a; memset(&a, 0, sizeof a); for (int i = 0; i < 26; ++i) a.in[i] = (const float*)d_in[i]; a.out = (float*)d_out; a.ws = ws;
    a.s_lo = 0; a.s_hi = 2 * NLAYER; a.p_lo = 0; a.p_hi = 11; a.do_pro = 1; a.do_fin = 1; a.li = 0; a.pad = 0;
    hipLaunchKernelGGL(mega, dim3(grid), dim3(512), LDS_BYTES, stream, a);
}
```

```cpp
#include <hip/hip_runtime.h>
#include <cstdio>
#include <cstdint>
#include <cstring>
#define LAS __attribute__((address_space(3)))
typedef unsigned short bf16;
constexpr int T_SEQ = 8192, DM = 2048, DFF = 5504, NLAYER = 4;
constexpr int NGU = 2 * DFF;
constexpr int NZ = 13312;
constexpr int NZP = 15616;
constexpr int NZT = 2048;
constexpr int Z_AQ = 0, Z_AK = 1024, Z_AO = 2048, Z_BQ = 3072, Z_BK = 4096, Z_CX = 5120, Z_CG = 6144, Z_GA = 7168, Z_GB = 9216, Z_GC = 11264;
constexpr int ZT_AV = 0, ZT_BV = 1024;
constexpr float RMS_EPS = 1e-6f;
__device__ __forceinline__ float bf2f(unsigned short b) { return __uint_as_float(((unsigned)b) << 16); }
__device__ __forceinline__ unsigned short f2bf(float f) { unsigned u = __float_as_uint(f); return (unsigned short)((u + 0x7fffu + ((u >> 16) & 1u)) >> 16); }
__device__ __forceinline__ float sigmoidf_(float x) { return 1.f / (1.f + __expf(-x)); }
__device__ __forceinline__ float lo_bf(unsigned w) { return __uint_as_float(w << 16); }
__device__ __forceinline__ float hi_bf(unsigned w) { return __uint_as_float(w & 0xffff0000u); }
__device__ __forceinline__ int win_src_col(int n) {
    if (n < 2048) return n;
    if (n < 3072) return 3072 + (n - 2048);
    if (n < 5120) return n + 1032;
    if (n < 13312) return n + 2056;
    if (n < 13320) return 4096 + (n - 13312);
    if (n < 13568) return -1;
    if (n < 14592) return 2048 + (n - 13568);
    return 6152 + (n - 14592);
}
#define MIX_LRU 1
#define MIX_ML 1
#define MIX_MOBA 1
namespace pg8 {
#define PG8_LAS __attribute__((address_space(3)))
typedef unsigned short bf16_t;
typedef short bf16x8 __attribute__((ext_vector_type(8)));
typedef float f32x4 __attribute__((ext_vector_type(4)));
typedef unsigned u32x4 __attribute__((ext_vector_type(4)));
constexpr int BM = 256, BK = 64, HALF = 128, HTB = HALF * BK * 2  , STAGE_BYTES = 8 * HTB, NXCD = 8, WGM = 8;

__host__ __device__ __forceinline__ int lds_byte(int r, int c) { const int st = (r >> 4) * 2 + (c >> 5), rr = r & 15, cc = c & 31, ob = rr * 64 + cc * 2; return st * 1024 + (ob ^ (((ob >> 9) & 1) << 5)); }
__host__ __device__ __forceinline__ void stage_rc(int b, int& R, int& C) { const int st = b / 1024, sb = b % 1024, swz = sb ^ (((sb >> 9) & 1) << 5); R = (st >> 1) * 16 + swz / 64; C = (st & 1) * 32 + (swz % 64) / 2; }
__host__ __device__ __forceinline__ int perm32(int rho) { const int n = rho >> 4, i = rho & 15; return 8 * (i >> 2) + 4 * n + (i & 3); }

struct Unit { int pm, pn, aux; };
struct Gemm { const bf16_t* A; const bf16_t* Bt; int M, N, K; };

struct StaticOrder {
    int nM, nN, nwg, G, c;
    __host__ __device__ void init(int M, int N, int G_, int c_) { nM = M / BM; nN = N / BM; nwg = nM * nN; G = G_; c = c_; }
    __host__ __device__ __forceinline__ bool next(int i, Unit& u) const {
        const long L = (long)i * G + c; if (L >= nwg) return false;
        int wgid = (int)L; { const int q = nwg / NXCD, r = nwg % NXCD, xcd = wgid % NXCD, off = wgid / NXCD; wgid = (xcd < r ? xcd * (q + 1) : r * (q + 1) + (xcd - r) * q) + off; }
        const int nig = WGM * nN, gid = wgid / nig, fm = gid * WGM, gsz = (nM - fm) < WGM ? (nM - fm) : WGM;
        u.pm = fm + ((wgid % nig) % gsz); u.pn = (wgid % nig) / gsz; u.aux = 0; return true;
    }
    __device__ __forceinline__ void bases(const Gemm& g, const Unit& u, size_t tstep, const char*& a, const char*& b) const { a = (const char*)g.A + (size_t)u.pm * tstep; b = (const char*)g.Bt + (size_t)u.pn * tstep; }
    __device__ __forceinline__ void a_ready(const Unit&) const {}
    __device__ __forceinline__ void done(const Unit&) const {}
};
__device__ __forceinline__ unsigned cvt_pk_bf16(float lo, float hi) { unsigned r; asm volatile("v_cvt_pk_bf16_f32 %0, %1, %2" : "=v"(r) : "v"(lo), "v"(hi)); return r; }
typedef float f32x2 __attribute__((ext_vector_type(2)));
typedef unsigned u32x2 __attribute__((ext_vector_type(2)));
__device__ __forceinline__ float fast_sigmoid(float x) { return __builtin_amdgcn_rcpf(1.f + __expf(-x)); }
__device__ __forceinline__ void row_rstd8(const PG8_LAS float* tab, int rloc, float (&rs)[2][4]) {
#pragma unroll
    for (int ai = 0; ai < 2; ++ai)
#pragma unroll
        for (int m = 0; m < 4; ++m) rs[ai][m] = tab[rloc + ai * HALF + m * 16];
}
__device__ __forceinline__ void rstd_table(const float* SSQ, PG8_LAS float* tab, int panel, int tid) {
    asm volatile("" : "+v"(tid));
    const float* p = SSQ + ((size_t)panel * BM + (tid >> 1)) * 32 + (tid & 1) * 16; float t = 0.f;
#pragma unroll
    for (int q = 0; q < 4; ++q) { const f32x4 a = *(const f32x4*)(p + 4 * q); t += (a[0] + a[1]) + (a[2] + a[3]); }
    t += __shfl_xor(t, 1);
    if ((tid & 1) == 0) tab[tid >> 1] = __builtin_amdgcn_rsqf(t * (1.f / 2048.f) + 1e-6f);
    asm volatile("s_waitcnt lgkmcnt(0)" ::: "memory"); __builtin_amdgcn_s_barrier(); asm volatile("" ::: "memory");
}
struct EpiSwiGLU {
    static constexpr bool PERM = true, AFTER_DRAIN = false;
    bf16_t* O; const float* SSQ; const PG8_LAS float* tab; int ldc; int panel;
    __device__ __forceinline__ void operator()(const f32x4 (&acc)[2][2][4][2], const Unit& u, int wr, int wc, int fr, int fq) const {
        const int row0 = u.pm * BM + wr * 64 + fr, col0 = u.pn * HALF + wc * 32 + 8 * fq;
        float rs[2][4]; row_rstd8(tab, wr * 64 + fr, rs);
#pragma unroll
        for (int ai = 0; ai < 2; ++ai)
#pragma unroll
            for (int m = 0; m < 4; ++m) { bf16_t* rowp = O + (size_t)(row0 + ai * HALF + m * 16) * ldc + col0;
                const f32x2 r2 = (f32x2){rs[ai][m], rs[ai][m]}; f32x2 h2[4];
#pragma unroll
                for (int n = 0; n < 2; ++n)
#pragma unroll
                    for (int q = 0; q < 2; ++q) { const f32x2 g = (f32x2){acc[ai][0][m][n][2 * q], acc[ai][0][m][n][2 * q + 1]} * r2, up = (f32x2){acc[ai][1][m][n][2 * q], acc[ai][1][m][n][2 * q + 1]} * r2;
                        const f32x2 t = g * (-1.4426950408889634f); f32x2 d; d.x = __builtin_amdgcn_exp2f(t.x); d.y = __builtin_amdgcn_exp2f(t.y); d = d + 1.0f;
                        f32x2 rc; rc.x = __builtin_amdgcn_rcpf(d.x); rc.y = __builtin_amdgcn_rcpf(d.y); h2[n * 2 + q] = (g * up) * rc; }
                u32x4 w; w.x = cvt_pk_bf16(h2[0].x, h2[0].y); w.y = cvt_pk_bf16(h2[1].x, h2[1].y); w.z = cvt_pk_bf16(h2[2].x, h2[2].y); w.w = cvt_pk_bf16(h2[3].x, h2[3].y);
                *(u32x4*)rowp = w; }
    }
};
struct EpiResAdd {
    static constexpr bool PERM = false, AFTER_DRAIN = false;
    float* X; bf16_t* XB; float* SSQ; int ldc; float alpha;
    __device__ __forceinline__ void operator()(const f32x4 (&acc)[2][2][4][2], const Unit& u, int wr, int wc, int fr, int fq) const {
        const int row0 = u.pm * BM + wr * 64 + fr, col0 = u.pn * BM + wc * 32 + 4 * fq;
        u32x2 xv[3][4];
#define RA_LOAD(rg, b) do { const bf16_t* rp_ = XB + (size_t)(row0 + ((rg) >> 2) * HALF + ((rg) & 3) * 16) * ldc + col0; \
            xv[b][0] = *(const u32x2*)(rp_); xv[b][1] = *(const u32x2*)(rp_ + 16); xv[b][2] = *(const u32x2*)(rp_ + HALF); xv[b][3] = *(const u32x2*)(rp_ + HALF + 16); } while (0)
        RA_LOAD(0, 0); RA_LOAD(1, 1);
#pragma unroll
        for (int rg = 0; rg < 8; ++rg) { const int ai = rg >> 2, m = rg & 3;
            if (rg + 2 < 8) RA_LOAD(rg + 2, (rg + 2) % 3);
            const size_t row = (size_t)(row0 + ai * HALF + m * 16); bf16_t* rowb = XB + row * ldc + col0; float ss = 0.f;
#pragma unroll
            for (int bj = 0; bj < 2; ++bj)
#pragma unroll
                for (int n = 0; n < 2; ++n) { const u32x2 o = xv[rg % 3][bj * 2 + n]; const f32x4 p = acc[ai][bj][m][n] * alpha;
                    u32x2 w; w.x = cvt_pk_bf16(__uint_as_float(o.x << 16) + p[0], __uint_as_float(o.x & 0xffff0000u) + p[1]); w.y = cvt_pk_bf16(__uint_as_float(o.y << 16) + p[2], __uint_as_float(o.y & 0xffff0000u) + p[3]);
                    *(u32x2*)(rowb + bj * HALF + n * 16) = w;
                    const float r0 = __uint_as_float(w.x << 16), r1 = __uint_as_float(w.x & 0xffff0000u), r2 = __uint_as_float(w.y << 16), r3 = __uint_as_float(w.y & 0xffff0000u);
                    ss += (r0 * r0 + r1 * r1) + (r2 * r2 + r3 * r3); }
            ss += __shfl_xor(ss, 16); ss += __shfl_xor(ss, 32);
            if (fq == 0) SSQ[row * 32 + u.pn * 4 + wc] = ss; }
#undef RA_LOAD
    }
};
struct EpiZ {
    static constexpr bool PERM = true, AFTER_DRAIN = false;
    bf16_t* Z; float* G; bf16_t* ZT; const float* SSQ; const PG8_LAS float* tab; int ldz; int ldt; int panel; int pad;
    __device__ __forceinline__ void operator()(const f32x4 (&acc)[2][2][4][2], const Unit& u, int wr, int wc, int fr, int fq) const {
        const int row0 = u.pm * BM + wr * 64 + fr;
        if (u.aux == 0) {
            float rs[2][4]; row_rstd8(tab, wr * 64 + fr, rs);
            const int col0 = u.pn * BM + wc * 64 + 8 * fq;
#pragma unroll
            for (int ai = 0; ai < 2; ++ai)
#pragma unroll
                for (int m = 0; m < 4; ++m) { bf16_t* rowp = Z + (size_t)(row0 + ai * HALF + m * 16) * ldz + col0; const float r = rs[ai][m];
#pragma unroll
                    for (int bj = 0; bj < 2; ++bj) { const f32x4 v0 = acc[ai][bj][m][0] * r, v1 = acc[ai][bj][m][1] * r;
                        u32x4 w; w.x = cvt_pk_bf16(v0[0], v0[1]); w.y = cvt_pk_bf16(v0[2], v0[3]); w.z = cvt_pk_bf16(v1[0], v1[1]); w.w = cvt_pk_bf16(v1[2], v1[3]);
                        *(u32x4*)(rowp + bj * 32) = w; } }
        } else if (u.aux == 1) {
            float rs[2][4]; row_rstd8(tab, wr * 64 + fr, rs);
            if (wc == 0 && fq == 0) {
#pragma unroll
                for (int ai = 0; ai < 2; ++ai)
#pragma unroll
                    for (int m = 0; m < 4; ++m) { float* gp = G + (size_t)(row0 + ai * HALF + m * 16) * 8;
                        *(f32x4*)gp = acc[ai][0][m][0] * rs[ai][m]; *(f32x4*)(gp + 4) = acc[ai][0][m][1] * rs[ai][m]; } }
        } else {
            const int tb = u.pn * BM + wc * 32 + 8 * fq; float rt[16];
#pragma unroll
            for (int j = 0; j < 16; ++j) rt[j] = tab[wc * 32 + 8 * fq + 128 * (j >> 3) + (j & 7)];
            const int col0 = tb;
#pragma unroll
            for (int ai = 0; ai < 2; ++ai)
#pragma unroll
                for (int m = 0; m < 4; ++m) { bf16_t* rowp = ZT + (size_t)(row0 + ai * HALF + m * 16) * ldt + col0;
#pragma unroll
                    for (int bj = 0; bj < 2; ++bj) { const f32x4 v0 = acc[ai][bj][m][0], v1 = acc[ai][bj][m][1];
                        u32x4 w; w.x = cvt_pk_bf16(v0[0] * rt[8 * bj], v0[1] * rt[8 * bj + 1]); w.y = cvt_pk_bf16(v0[2] * rt[8 * bj + 2], v0[3] * rt[8 * bj + 3]);
                        w.z = cvt_pk_bf16(v1[0] * rt[8 * bj + 4], v1[1] * rt[8 * bj + 5]); w.w = cvt_pk_bf16(v1[2] * rt[8 * bj + 6], v1[3] * rt[8 * bj + 7]);
                        *(u32x4*)(rowp + bj * HALF) = w; } }
        }
    }
};
struct ZOrder : StaticOrder {
    __device__ __forceinline__ bool next(int i, Unit& u) const {
        if (!StaticOrder::next(i, u)) return false;
        const int v = u.pn;
        if (v < 52) u.aux = 0; else if (v == 52) u.aux = 1; else { u.aux = 2; u.pn = u.pm; u.pm = v - 53; }
        return true;
    }
    __device__ __forceinline__ void bases(const Gemm& g, const Unit& u, size_t tstep, const char*& a, const char*& b) const {
        if (u.aux == 2) { a = (const char*)g.Bt + (size_t)(53 + u.pm) * tstep; b = (const char*)g.A + (size_t)u.pn * tstep; }
        else { a = (const char*)g.A + (size_t)u.pm * tstep; b = (const char*)g.Bt + (size_t)u.pn * tstep; }
    }
};
struct EpiMerge {
    static constexpr bool PERM = true, AFTER_DRAIN = false;
    bf16_t* MG; const bf16_t* Zg; int ldm; int ldz; int gstride; int pad;
    __device__ __forceinline__ void operator()(const f32x4 (&acc)[2][2][4][2], const Unit& u, int wr, int wc, int fr, int fq) const {
        const int row0 = u.pm * BM + wr * 64 + fr, col0 = u.pn * BM + wc * 32 + 8 * fq; const bool first = (u.aux == 0); const bf16_t* zg = Zg + (size_t)u.aux * gstride;
#pragma unroll
        for (int ai = 0; ai < 2; ++ai)
#pragma unroll
            for (int m = 0; m < 4; ++m) { const size_t r = (size_t)(row0 + ai * HALF + m * 16);
#pragma unroll
                for (int bj = 0; bj < 2; ++bj) { const int c = col0 + bj * HALF;
                    const u32x4 gz = *(const u32x4*)(zg + r * ldz + c);
                    u32x4 old = (u32x4){0u, 0u, 0u, 0u}; if (!first) old = *(const u32x4*)(MG + r * ldm + c);
                    float o[8];
#pragma unroll
                    for (int j = 0; j < 4; ++j) { const unsigned gw = gz[j], ow = old[j];
                        const float g0 = __uint_as_float(gw << 16), g1 = __uint_as_float(gw & 0xffff0000u), o0 = __uint_as_float(ow << 16), o1 = __uint_as_float(ow & 0xffff0000u);
                        const float a0 = acc[ai][bj][m][j >> 1][(j & 1) * 2], a1 = acc[ai][bj][m][j >> 1][(j & 1) * 2 + 1];
                        o[2 * j] = o0 + fast_sigmoid(g0) * a0; o[2 * j + 1] = o1 + fast_sigmoid(g1) * a1; }
                    u32x4 w; w.x = cvt_pk_bf16(o[0], o[1]); w.y = cvt_pk_bf16(o[2], o[3]); w.z = cvt_pk_bf16(o[4], o[5]); w.w = cvt_pk_bf16(o[6], o[7]);
                    *(u32x4*)(MG + r * ldm + c) = w; } }
    }
};
struct MergeOrder : StaticOrder {
    size_t astride, bstride;
    __device__ __forceinline__ bool next(int i, Unit& u) const { if (!StaticOrder::next(i / 3, u)) return false; u.aux = i % 3; return true; }
    __device__ __forceinline__ void bases(const Gemm& g, const Unit& u, size_t tstep, const char*& a, const char*& b) const {
        a = (const char*)(g.A + (size_t)u.aux * astride) + (size_t)u.pm * tstep; b = (const char*)(g.Bt + (size_t)u.aux * bstride) + (size_t)u.pn * tstep; }
};
template <class Epi, class Sched, bool ALIGN_EPI = false, bool SP2 = false>
__device__ __forceinline__ void gemm_phase(PG8_LAS unsigned char* lds, const Gemm g, const Sched& S, const Epi& E) {
    int tid_ = threadIdx.x; asm volatile("" : "+v"(tid_));
    const int tid = tid_, wid = __builtin_amdgcn_readfirstlane(tid >> 6), lane = tid & 63, wr = wid >> 2, wc = wid & 3, fr = lane & 15, fq = lane >> 4;
    const int K = g.K, nt = K / BK;
    unsigned voffA[2], voffB[2];
#pragma unroll
    for (int i = 0; i < 2; ++i) { int R, C; stage_rc(tid * 16 + i * 8192, R, C); const int Rb = Epi::PERM ? ((R & ~31) + perm32(R & 31)) : R;
        voffA[i] = (unsigned)(R * K + C) * 2u; voffB[i] = (unsigned)(Rb * K + C) * 2u; }
    const size_t kstep = (size_t)(BK * 2);
    const size_t hstep = (size_t)HALF * K * 2;
    const size_t tstep = 2 * hstep;
    const unsigned ldsw = (unsigned)wid * 1024u;
    const int aoff = lds_byte(wr * 64 + fr, fq * 8), boff = lds_byte(wc * 32 + fr, fq * 8);
#define PG8_SA(b, h) (((b) * 2 + (h)) * HTB)
#define PG8_SB(b, h) ((4 + (b) * 2 + (h)) * HTB)
#define PG8_STAGE(bufoff, gbase, voff) do { _Pragma("unroll") for (int _i = 0; _i < 2; ++_i) \
        __builtin_amdgcn_global_load_lds((const unsigned*)((const char*)(gbase) + (voff)[_i]), (PG8_LAS unsigned*)(lds + (bufoff) + ldsw + _i * 8192), 16, 0, 0); } while (0)
#define PG8_LDA(dst, b, h) do { _Pragma("unroll") for (int m = 0; m < 4; ++m) _Pragma("unroll") for (int k = 0; k < 2; ++k) dst[m][k] = *(const PG8_LAS bf16x8*)(lds + PG8_SA(b, h) + aoff + m * 2048 + k * 1024); } while (0)
#define PG8_LDB(dst, b, h) do { _Pragma("unroll") for (int n = 0; n < 2; ++n) _Pragma("unroll") for (int k = 0; k < 2; ++k) dst[n][k] = *(const PG8_LAS bf16x8*)(lds + PG8_SB(b, h) + boff + n * 2048 + k * 1024); } while (0)
#define PG8_MMA(ai, bj, At, Bt) do { __builtin_amdgcn_s_setprio(1); _Pragma("unroll") for (int m = 0; m < 4; ++m) _Pragma("unroll") for (int n = 0; n < 2; ++n) _Pragma("unroll") for (int k = 0; k < 2; ++k) \
        acc[ai][bj][m][n] = __builtin_amdgcn_mfma_f32_16x16x32_bf16(Bt[n][k], At[m][k], acc[ai][bj][m][n], 0, 0, 0); __builtin_amdgcn_s_setprio(0); } while (0)
#define PG8_WAIT_V(n) asm volatile("s_waitcnt vmcnt(" #n ")" ::: "memory")
#define PG8_WAIT_L(n) asm volatile("s_waitcnt lgkmcnt(" #n ")" ::: "memory")
#define PG8_BAR __builtin_amdgcn_s_barrier()
#define PG8_SCHED __builtin_amdgcn_sched_barrier(0)
    Unit cur, nxt; int ui = 0;
    if (!S.next(0, cur)) return;
    f32x4 acc[2][2][4][2];
#pragma unroll
    for (int a = 0; a < 2; ++a)
#pragma unroll
        for (int b = 0; b < 2; ++b)
#pragma unroll
            for (int m = 0; m < 4; ++m)
#pragma unroll
                for (int n = 0; n < 2; ++n) acc[a][b][m][n] = (f32x4){0.f, 0.f, 0.f, 0.f};
    bf16x8 At[4][2], B0[2][2], B1[2][2];
    const char* cA; const char* cB; S.bases(g, cur, tstep, cA, cB);
    S.a_ready(cur);
    if constexpr (SP2) {
        PG8_STAGE(PG8_SB(0, 0), cB, voffB); PG8_STAGE(PG8_SB(0, 1), cB + hstep, voffB); PG8_STAGE(PG8_SA(0, 0), cA, voffA); PG8_STAGE(PG8_SA(0, 1), cA + hstep, voffA);
        if (wr == 1) PG8_BAR;
        PG8_WAIT_V(2); PG8_BAR;
        PG8_STAGE(PG8_SB(1, 0), cB + kstep, voffB); PG8_STAGE(PG8_SA(1, 0), cA + kstep, voffA); PG8_STAGE(PG8_SB(1, 1), cB + hstep + kstep, voffB);
        PG8_WAIT_V(6); PG8_BAR;
    } else {
        PG8_STAGE(PG8_SB(0, 0), cB, voffB); PG8_STAGE(PG8_SA(0, 0), cA, voffA); PG8_STAGE(PG8_SB(0, 1), cB + hstep, voffB); PG8_STAGE(PG8_SA(0, 1), cA + hstep, voffA);
        if (wr == 1) PG8_BAR;
        PG8_WAIT_V(4); PG8_BAR;
        PG8_STAGE(PG8_SB(1, 0), cB + kstep, voffB); PG8_STAGE(PG8_SA(1, 0), cA + kstep, voffA); PG8_STAGE(PG8_SB(1, 1), cB + hstep + kstep, voffB);
        PG8_WAIT_V(6); PG8_BAR;
    }
    for (;;) {
        const bool has_next = S.next(ui + 1, nxt);
        const char* nA = cA; const char* nB = cB; if (has_next) S.bases(g, nxt, tstep, nA, nB);
        for (int t = 0; t < nt; t += 2) {
            const bool last = (t == nt - 2);
            const char* a1 = cA + (size_t)(t + 1) * kstep;
            const char* a2 = last ? nA : cA + (size_t)(t + 2) * kstep; const char* b2 = last ? nB : cB + (size_t)(t + 2) * kstep;
            const char* a3 = a2 + kstep; const char* b3 = b2 + kstep;
            if (last && has_next) S.a_ready(nxt);
            if constexpr (SP2) {
            PG8_LDB(B0, 0, 0); PG8_LDB(B1, 0, 1); PG8_SCHED; PG8_LDA(At, 0, 0); PG8_STAGE(PG8_SA(1, 1), a1 + hstep, voffA);
            PG8_WAIT_V(8); PG8_WAIT_L(0); PG8_BAR; PG8_MMA(0, 0, At, B0); PG8_MMA(0, 1, At, B1); PG8_BAR; PG8_SCHED;
            PG8_LDA(At, 0, 1); PG8_STAGE(PG8_SB(0, 0), b2, voffB); PG8_STAGE(PG8_SB(0, 1), b2 + hstep, voffB); PG8_STAGE(PG8_SA(0, 0), a2, voffA);
            PG8_WAIT_V(8); PG8_WAIT_L(0); PG8_BAR; PG8_MMA(1, 0, At, B0); PG8_MMA(1, 1, At, B1); PG8_BAR; PG8_SCHED;
            PG8_LDB(B0, 1, 0); PG8_LDB(B1, 1, 1); PG8_SCHED; PG8_LDA(At, 1, 0); PG8_STAGE(PG8_SA(0, 1), a2 + hstep, voffA);
            PG8_WAIT_V(8); PG8_WAIT_L(0); PG8_BAR; PG8_MMA(0, 0, At, B0); PG8_MMA(0, 1, At, B1); PG8_BAR; PG8_SCHED;
            PG8_LDA(At, 1, 1); PG8_STAGE(PG8_SB(1, 0), b3, voffB); PG8_STAGE(PG8_SB(1, 1), b3 + hstep, voffB); PG8_STAGE(PG8_SA(1, 0), a3, voffA);
            PG8_WAIT_V(8); PG8_WAIT_L(0); PG8_BAR; PG8_MMA(1, 0, At, B0); PG8_MMA(1, 1, At, B1); PG8_BAR; PG8_SCHED;
            } else {
            PG8_LDB(B0, 0, 0); PG8_SCHED; PG8_LDA(At, 0, 0); PG8_STAGE(PG8_SA(1, 1), a1 + hstep, voffA);
            PG8_WAIT_L(8); PG8_BAR; PG8_WAIT_L(0); PG8_MMA(0, 0, At, B0); PG8_BAR; PG8_SCHED;
            PG8_LDB(B1, 0, 1); PG8_STAGE(PG8_SB(0, 0), b2, voffB);
            PG8_BAR; PG8_WAIT_L(0); PG8_MMA(0, 1, At, B1); PG8_BAR;
            PG8_LDA(At, 0, 1); PG8_STAGE(PG8_SA(0, 0), a2, voffA);
            PG8_BAR; PG8_WAIT_L(0); PG8_MMA(1, 0, At, B0); PG8_BAR; PG8_SCHED;
            PG8_STAGE(PG8_SB(0, 1), b2 + hstep, voffB);
            PG8_WAIT_V(6); PG8_BAR; PG8_MMA(1, 1, At, B1); PG8_BAR;
            PG8_LDB(B0, 1, 0); PG8_SCHED; PG8_LDA(At, 1, 0); PG8_STAGE(PG8_SA(0, 1), a2 + hstep, voffA);
            PG8_WAIT_L(8); PG8_BAR; PG8_WAIT_L(0); PG8_MMA(0, 0, At, B0); PG8_BAR; PG8_SCHED;
            PG8_LDB(B1, 1, 1); PG8_STAGE(PG8_SB(1, 0), b3, voffB);
            PG8_BAR; PG8_WAIT_L(0); PG8_MMA(0, 1, At, B1); PG8_BAR;
            PG8_LDA(At, 1, 1); PG8_STAGE(PG8_SA(1, 0), a3, voffA);
            PG8_BAR; PG8_WAIT_L(0); PG8_MMA(1, 0, At, B0); PG8_BAR; PG8_SCHED;
            PG8_STAGE(PG8_SB(1, 1), b3 + hstep, voffB);
            PG8_WAIT_V(6); PG8_BAR; PG8_MMA(1, 1, At, B1); PG8_BAR;
            }
        }
        if constexpr (ALIGN_EPI) { if (wr == 0) PG8_BAR; }
        if constexpr (!Epi::AFTER_DRAIN) { E(acc, cur, wr, wc, fr, fq); S.done(cur); }
        if (!has_next) break;
#pragma unroll
        for (int a = 0; a < 2; ++a)
#pragma unroll
            for (int b = 0; b < 2; ++b)
#pragma unroll
                for (int m = 0; m < 4; ++m)
#pragma unroll
                    for (int n = 0; n < 2; ++n) acc[a][b][m][n] = (f32x4){0.f, 0.f, 0.f, 0.f};
        cur = nxt; cA = nA; cB = nB; ++ui;
        if constexpr (ALIGN_EPI) { if (wr == 1) PG8_BAR; }
    }
    PG8_WAIT_V(0);
    if constexpr (!ALIGN_EPI) { if (wr == 0) PG8_BAR; }
    PG8_BAR;
    if constexpr (Epi::AFTER_DRAIN) { E.fused(acc, cur, wr, wc, fr, fq, lds, wid, lane); S.done(cur); }
#undef PG8_SA
#undef PG8_SB
#undef PG8_STAGE
#undef PG8_LDA
#undef PG8_LDB
#undef PG8_MMA
#undef PG8_WAIT_V
#undef PG8_WAIT_L
#undef PG8_BAR
#undef PG8_SCHED
}
}
#define XB_TMO      128
#define XB_XCNT(j)  (256  + 64 * (j))
#define XB_XSUB(j)  (1280 + 64 * (j))
#define XB_XGEN(j)  (2304 + 64 * (j))
#define XB_TOP      3328
#define XB_TOPGEN   3392
#define XCD_BAR_WORDS 3456
#define XB_SPIN_CAP (1u << 18)

__device__ __forceinline__ unsigned xb_ld(unsigned* p)              { return __hip_atomic_load(p, __ATOMIC_RELAXED, __HIP_MEMORY_SCOPE_AGENT); }
__device__ __forceinline__ unsigned xb_add(unsigned* p, unsigned v) { return __hip_atomic_fetch_add(p, v, __ATOMIC_RELAXED, __HIP_MEMORY_SCOPE_AGENT); }
__device__ __forceinline__ unsigned xb_xcc_id() { return (unsigned)__builtin_amdgcn_s_getreg((3 << 11) | 20) & 0xFu; }
#define XB_SPIN(cond, bar) do { unsigned _sp = 0; while (cond) { __builtin_amdgcn_s_sleep(1); \
    if ((++_sp & 255u) == 0u) { if (xb_ld(&(bar)[XB_TMO])) break; if (_sp > XB_SPIN_CAP) { atomicAdd(&(bar)[XB_TMO], 1u); break; } } } } while (0)

struct XcdBarrier {
    unsigned* bar; unsigned x;
    volatile LAS unsigned* st;
};

__device__ __forceinline__ XcdBarrier xcd_barrier_post(unsigned* bar, volatile LAS unsigned* st) {
    XcdBarrier b; b.bar = bar; b.x = xb_xcc_id(); b.st = st;
    if (threadIdx.x == 0) (void)xb_add(&bar[XB_XCNT(b.x)], 1u);
    return b;
}
__device__ __forceinline__ void xcd_barrier_complete(unsigned* bar, unsigned x, unsigned& nloc, unsigned& nx) {
    const unsigned G = gridDim.x * gridDim.y * gridDim.z;
    unsigned sum, cnt, mine, sp = 0u;
    for (;;) {
        sum = 0u; cnt = 0u; mine = 0u;
#pragma unroll
        for (unsigned j = 0; j < 16; ++j) { const unsigned c = xb_ld(&bar[XB_XCNT(j)]); sum += c; cnt += (c > 0u) ? 1u : 0u; mine = (j == x) ? c : mine; }
        if (sum == G) break;
        __builtin_amdgcn_s_sleep(1);
        if ((++sp & 255u) == 0u) { if (xb_ld(&bar[XB_TMO])) break; if (sp > XB_SPIN_CAP) { atomicAdd(&bar[XB_TMO], 1u); break; } }
    }
    nloc = mine > 0u ? mine : 1u; nx = cnt > 0u ? cnt : 1u;
}

__device__ __forceinline__ void xcd_barrier(const XcdBarrier& b) {
    asm volatile("s_waitcnt vmcnt(0)" ::: "memory");
    __syncthreads();
    if (threadIdx.x == 0) {
        unsigned* bar = b.bar;
        __builtin_amdgcn_s_waitcnt(0);
        unsigned nloc = b.st[0], nx = b.st[1];
        if (nloc == 0u) { xcd_barrier_complete(bar, b.x, nloc, nx); b.st[0] = nloc; b.st[1] = nx; }
        const unsigned old = xb_add(&bar[XB_XSUB(b.x)], 1u);
        const unsigned gen = old / nloc;
        if (old + 1u == (gen + 1u) * nloc) {
            __builtin_amdgcn_fence(__ATOMIC_RELEASE, "agent");
            asm volatile("s_waitcnt vmcnt(0)" ::: "memory");
            const unsigned og = xb_add(&bar[XB_TOP], 1u);
            const unsigned tg = og / nx;
            if (og + 1u == (tg + 1u) * nx) xb_add(&bar[XB_TOPGEN], 1u);
            else XB_SPIN(xb_ld(&bar[XB_TOPGEN]) == tg, bar);
            __builtin_amdgcn_fence(__ATOMIC_ACQUIRE, "agent");
            xb_add(&bar[XB_XGEN(b.x)], 1u);
            asm volatile("s_waitcnt vmcnt(0)" ::: "memory");
        } else {
            XB_SPIN(xb_ld(&bar[XB_XGEN(b.x)]) == gen, bar);
            __builtin_amdgcn_fence(__ATOMIC_ACQUIRE, "agent");
            asm volatile("s_waitcnt vmcnt(0)" ::: "memory");
        }
    }
    __syncthreads();
}
constexpr size_t MiB = 1u << 20;
constexpr size_t SZ_WGU = (size_t)NGU * DM * 2, SZ_WD = (size_t)DM * DFF * 2, SZ_WIN = (size_t)NZP * DM * 2, SZ_WUP = (size_t)DM * 1024 * 2, SZ_WOUT = (size_t)DM * DM * 2, SZ_LRUW = (size_t)8 * 256 * 128 * 2;
constexpr size_t LW_GU1 = 0, LW_D1 = LW_GU1 + SZ_WGU, LW_IN = LW_D1 + SZ_WD, LW_UPA = LW_IN + SZ_WIN, LW_UPB = LW_UPA + SZ_WUP, LW_UPC = LW_UPB + SZ_WUP, LW_OUT = LW_UPC + SZ_WUP,
                 LW_GU2 = LW_OUT + SZ_WOUT, LW_D2 = LW_GU2 + SZ_WGU, LW_LRU = LW_D2 + SZ_WD, LW_END = LW_LRU + SZ_LRUW;
constexpr size_t LW_STRIDE = (LW_END + MiB - 1) / MiB * MiB;
constexpr size_t SZ_Y = (size_t)T_SEQ * 1024 * 2;
constexpr size_t WS_CTL = 0, CTL_BYTES = 2 * MiB, WS_W = CTL_BYTES, WS_X = WS_W + NLAYER * LW_STRIDE, WS_HN = WS_X + (size_t)T_SEQ * DM * 4, WS_HID = WS_HN + (size_t)T_SEQ * DM * 2,
                 WS_Z = WS_HID + (size_t)T_SEQ * DFF * 2, WS_ZT = WS_Z + (size_t)T_SEQ * NZ * 2, WS_G = WS_ZT + (size_t)NZT * T_SEQ * 2, WS_YA = WS_G + 1 * MiB, WS_YB = WS_YA + SZ_Y, WS_YC = WS_YB + SZ_Y,
                 WS_MG = WS_YC + SZ_Y, WS_SCR = WS_MG + (size_t)T_SEQ * DM * 2;
constexpr size_t SC_XC = 0, SC_LA = SC_XC + (size_t)T_SEQ * 1024 * 4, SC_LU = SC_LA + (size_t)T_SEQ * 1024 * 4, SC_MLA = SC_LU + (size_t)T_SEQ * 1024 * 4, SC_MLM = SC_MLA + 1 * MiB, SC_MLF = SC_MLM + 1 * MiB,
                 SC_KM = SC_MLF + 1 * MiB, SC_CARRY = SC_KM + 1 * MiB, SC_AKT = SC_CARRY + 1 * MiB, SC_LST = SC_AKT + (size_t)1024 * T_SEQ * 2, SC_CST = SC_LST + (size_t)64 * 4 * 65536 * 4, SC_NL = SC_CST + (size_t)64 * 4 * 65536 * 2,
                 SC_NST = SC_NL + 1 * MiB, SC_BG = SC_NST + 1 * MiB, SC_MST = SC_BG + 1 * MiB, SC_SEL = SC_MST + 1 * MiB, SC_PLSE = SC_SEL + 1 * MiB, SC_PO = SC_PLSE + 1 * MiB, SC_SSQ = SC_PO + (size_t)T_SEQ * 8 * 3 * 128 * 2, SC_END = SC_SSQ + 1 * MiB;
constexpr size_t WS_END = WS_SCR + SC_END;
constexpr int CW_BAR = 1024, MAX_LAUNCH = 96, CW_Q = 512;
constexpr int LDS_STAGE = 131072, LDS_MISC = LDS_STAGE, LDS_BYTES = 147456;

#include <hip/hip_runtime.h>
__device__ __forceinline__ unsigned pk_bf16(float lo, float hi) { unsigned r; asm volatile("v_cvt_pk_bf16_f32 %0, %1, %2" : "=v"(r) : "v"(lo), "v"(hi)); return r; }
struct PItem { int l, hf, p_lo, p_hi; };
constexpr int MAX_ITEMS = 48;
struct MegaArgs { const float* in[26]; float* out; unsigned char* ws; int n_items, do_pro, do_fin, li; PItem items[MAX_ITEMS]; };
__device__ __forceinline__ float wave_sum(float v) {
#pragma unroll
    for (int o = 1; o < 64; o <<= 1) v += __shfl_xor(v, o);
    return v;
}
constexpr int CT_GU = (NGU / 64) * (DM / 64), CT_D = (DM / 64) * (DFF / 64), CT_IN = (NZP / 64) * (DM / 64), CT_UP = (DM / 64) * (1024 / 64), CT_OUT = (DM / 64) * (DM / 64), CT_LRU = 8 * 4 * 2;
constexpr int CT_LAYER = 2 * CT_GU + 2 * CT_D + CT_IN + 3 * CT_UP + CT_OUT + CT_LRU;
typedef float f32x4w __attribute__((ext_vector_type(4)));
typedef unsigned u32x4w __attribute__((ext_vector_type(4)));
struct ConvTile { const float* sp; const float* gs; bf16* dp; int K, Nsrc; float sc, gm; };
template <class KA> __device__ __forceinline__ ConvTile conv_desc(KA a, int gidx, int lane) {
    const int l = gidx / CT_LAYER; int r = gidx - l * CT_LAYER; unsigned char* lw = a->ws + WS_W + (size_t)l * LW_STRIDE;
    const float* s0; const float* s1 = nullptr; const float* gs = nullptr; bf16* dst; int K, Nsrc, mode = 0, ntn;
    if (r < CT_GU) { gs = a->in[1] + (size_t)l * DM; s0 = a->in[2] + (size_t)l * DM * DFF; s1 = a->in[3] + (size_t)l * DM * DFF; dst = (bf16*)(lw + LW_GU1); K = DM; Nsrc = DFF; mode = 1; ntn = NGU / 64; }
    else if ((r -= CT_GU) < CT_D) { s0 = a->in[4] + (size_t)l * DFF * DM; dst = (bf16*)(lw + LW_D1); K = DFF; Nsrc = DM; ntn = DM / 64; }
    else if ((r -= CT_D) < CT_IN) { gs = a->in[5] + (size_t)l * DM; s0 = a->in[6] + (size_t)l * DM * 15368; dst = (bf16*)(lw + LW_IN); K = DM; Nsrc = 15368; mode = 2; ntn = NZP / 64; }
    else if ((r -= CT_IN) < CT_LRU) { const int blk = r >> 3; r &= 7; s0 = a->in[12] + ((size_t)l * 8 + blk) * 128 * 128; s1 = a->in[14] + ((size_t)l * 8 + blk) * 128 * 128; dst = (bf16*)(lw + LW_LRU) + (size_t)blk * 256 * 128; K = 128; Nsrc = 128; mode = 3; ntn = 4; }
    else if ((r -= CT_LRU) < 3 * CT_UP) { const int b = r / CT_UP; r -= b * CT_UP; s0 = (b == 0 ? a->in[17] : (b == 1 ? a->in[18] : a->in[19])) + (size_t)l * 1024 * DM; dst = (bf16*)(lw + LW_UPA + (size_t)b * SZ_WUP); K = 1024; Nsrc = DM; ntn = DM / 64; }
    else if ((r -= 3 * CT_UP) < CT_OUT) { s0 = a->in[20] + (size_t)l * DM * DM; dst = (bf16*)(lw + LW_OUT); K = DM; Nsrc = DM; ntn = DM / 64; }
    else if ((r -= CT_OUT) < CT_GU) { gs = a->in[21] + (size_t)l * DM; s0 = a->in[22] + (size_t)l * DM * DFF; s1 = a->in[23] + (size_t)l * DM * DFF; dst = (bf16*)(lw + LW_GU2); K = DM; Nsrc = DFF; mode = 1; ntn = NGU / 64; }
    else { r -= CT_GU; s0 = a->in[24] + (size_t)l * DFF * DM; dst = (bf16*)(lw + LW_D2); K = DFF; Nsrc = DM; ntn = DM / 64; }
    int nti, kti; if (mode == 1 || mode == 2) { const int grp = r >> 7, w = r & 127; kti = w >> 2; nti = grp * 4 + (w & 3); } else { nti = r % ntn; kti = r / ntn; }
    const int n0 = nti * 64, k0 = kti * 64, n = n0 + (lane & 15) * 4; const float* src = s0; int col = n; float sc = 1.f;
    if (mode == 1) { const int b = (n >> 7) & 1; col = ((n >> 8) << 7) | (n & 127); src = b ? s1 : s0; }
    else if (mode == 2) { int nl = n; if (n < NZ) { const int p_ = n & 255; nl = (n & ~255) + 64 * ((p_ >> 5) & 3) + 32 * (p_ >> 7) + (p_ & 31); }
        col = win_src_col(nl); if (nl >= Z_AK && nl < Z_AO) sc = 0.0625f; }
    else if (mode == 3) { src = (n & 128) ? s1 : s0; col = n & 127; }
    if (col < 0) { sc = 0.f; col = 0; }
    ConvTile t; t.sp = src + (size_t)(k0 + (lane >> 4)) * Nsrc + col; t.gs = (gs ? gs : a->in[1]) + k0 % DM + (lane >> 4); t.gm = gs ? 1.f : 0.f; t.dp = dst + (size_t)n0 * K + k0; t.K = K; t.Nsrc = Nsrc; t.sc = sc; return t;
}
__device__ __forceinline__ void conv_load(const ConvTile& t, f32x4w (&v)[16], float (&g)[16]) {
#pragma unroll
    for (int i = 0; i < 16; ++i) g[i] = t.gs[4 * i];
#pragma unroll
    for (int i = 0; i < 16; ++i) g[i] = (g[i] * t.gm + (1.f - t.gm)) * t.sc;
#pragma unroll
    for (int i = 0; i < 16; ++i) v[i] = __builtin_nontemporal_load((const f32x4w*)(t.sp + (size_t)(4 * i) * t.Nsrc));
}
__device__ __forceinline__ void conv_finish(const ConvTile& t, const f32x4w (&v)[16], const float (&gg)[16], LAS unsigned short* tl, int lane) {
    const int nl = (lane & 15) * 4;
#pragma unroll
    for (int i = 0; i < 16; ++i) { const float g = gg[i];
        LAS unsigned* w = (LAS unsigned*)(tl + (4 * i + (lane >> 4)) * 66 + nl); w[0] = pk_bf16(v[i][0] * g, v[i][1] * g); w[1] = pk_bf16(v[i][2] * g, v[i][3] * g); }
    asm volatile("s_waitcnt lgkmcnt(0)" ::: "memory");
    const int kc = (lane & 7) * 8;
#pragma unroll
    for (int q = 0; q < 8; ++q) { const int r = 8 * q + (lane >> 3); unsigned w[4];
#pragma unroll
        for (int e = 0; e < 4; ++e) w[e] = (unsigned)tl[(kc + 2 * e) * 66 + r] | ((unsigned)tl[(kc + 2 * e + 1) * 66 + r] << 16);
        __builtin_nontemporal_store((u32x4w){w[0], w[1], w[2], w[3]}, (u32x4w*)(t.dp + (size_t)r * t.K + kc)); }
    asm volatile("s_waitcnt lgkmcnt(0)" ::: "memory");
}
template <class KA> __device__ __forceinline__ void convert_range(KA a, LAS unsigned char* lds, int t_lo, int t_hi, int rank, int nrank) {
    int tid_ = threadIdx.x; asm volatile("" : "+v"(tid_));
    const int lane = tid_ & 63, wave = __builtin_amdgcn_readfirstlane(tid_ >> 6); LAS unsigned short* tl = (LAS unsigned short*)(lds + wave * 16384);
    const int stride = nrank * 8; int it = t_lo + rank * 8 + wave;
    if (it >= t_hi) return;
    f32x4w va[16], vb[16]; float ga[16], gb[16];
    ConvTile ta = conv_desc(a, it, lane), tb = ta; conv_load(ta, va, ga);
    for (;;) {
        const bool nb = (it + stride) < t_hi; if (nb) { tb = conv_desc(a, it + stride, lane); conv_load(tb, vb, gb); }
        conv_finish(ta, va, ga, tl, lane);
        if (!nb) break;
        const bool na = (it + 2 * stride) < t_hi; if (na) { ta = conv_desc(a, it + 2 * stride, lane); conv_load(ta, va, ga); }
        conv_finish(tb, vb, gb, tl, lane);
        if (!na) break;
        it += 2 * stride;
    }
}
constexpr int CVT_PRO = 8704, CVT_GU = 9600, CVT_Z = 7400, CVT_TOTAL = NLAYER * CT_LAYER;
__host__ __device__ constexpr int cvt_slot_lo(int q) { return CVT_PRO + (q / 3) * (2 * CVT_GU + CVT_Z) + (q % 3 == 0 ? 0 : (q % 3 == 1 ? CVT_GU : CVT_GU + CVT_Z)); }
__host__ __device__ constexpr int cvt_slot_hi(int q) { return cvt_slot_lo(q) + (q % 3 == 1 ? CVT_Z : CVT_GU); }
__host__ __device__ constexpr int cvt_need_before(int q) {
    return (q / 3) * CT_LAYER + (q % 3 == 0 ? CT_GU + CT_D + CT_IN : (q % 3 == 1 ? CT_GU + CT_D + CT_IN + CT_LRU + 3 * CT_UP + CT_OUT + CT_GU : CT_LAYER + ((q / 3) + 1 < NLAYER ? CT_GU : 0))); }
__host__ __device__ constexpr bool cvt_schedule_ok() { if (CVT_PRO < CT_GU) return false; for (int q = 0; q < 3 * NLAYER; ++q) { const int hi = cvt_slot_hi(q) < CVT_TOTAL ? cvt_slot_hi(q) : CVT_TOTAL; if (hi < cvt_need_before(q)) return false; } return cvt_slot_hi(3 * NLAYER - 1) >= CVT_TOTAL; }
static_assert(cvt_schedule_ok(), "conversion schedule: a weight matrix would be read before it is converted");
__device__ __forceinline__ void phase_xinit(const float* x, float* X, bf16* XB, float* SSQ) {
    int tid_ = threadIdx.x; asm volatile("" : "+v"(tid_));
    const int lane = tid_ & 63, gw = blockIdx.x * 8 + (tid_ >> 6), nw = gridDim.x * 8;
    for (int row = gw; row < T_SEQ; row += nw) {
        const float4* xr = (const float4*)(x + (size_t)row * DM) + lane;
        float4 v[8]; float ss = 0.f;
#pragma unroll
        for (int j = 0; j < 8; ++j) v[j] = xr[64 * j];
#pragma unroll
        for (int j = 0; j < 8; ++j) { const unsigned w0 = pk_bf16(v[j].x, v[j].y), w1 = pk_bf16(v[j].z, v[j].w); ((uint2*)(XB + (size_t)row * DM))[lane + 64 * j] = make_uint2(w0, w1);
            const float r0 = lo_bf(w0), r1 = hi_bf(w0), r2 = lo_bf(w1), r3 = hi_bf(w1); ss += (r0 * r0 + r1 * r1) + (r2 * r2 + r3 * r3); }
        ss = wave_sum(ss);
        if (lane < 32) SSQ[(size_t)row * 32 + lane] = (lane == 0) ? ss : 0.f;
    }
}
__device__ __forceinline__ void phase_final(const bf16* XB, const float* g, float* out) {
    int tid_ = threadIdx.x; asm volatile("" : "+v"(tid_));
    const int lane = tid_ & 63, gw = blockIdx.x * 8 + (tid_ >> 6), nw = gridDim.x * 8;
    for (int row = gw; row < T_SEQ; row += nw) {
        const uint4* xr = (const uint4*)(XB + (size_t)row * DM) + lane;
        uint4 w[4]; float ss = 0.f;
#pragma unroll
        for (int j = 0; j < 4; ++j) w[j] = xr[64 * j];
#pragma unroll
        for (int j = 0; j < 4; ++j) { const float a0 = lo_bf(w[j].x), a1 = hi_bf(w[j].x), a2 = lo_bf(w[j].y), a3 = hi_bf(w[j].y), a4 = lo_bf(w[j].z), a5 = hi_bf(w[j].z), a6 = lo_bf(w[j].w), a7 = hi_bf(w[j].w);
            ss += (a0 * a0 + a1 * a1) + (a2 * a2 + a3 * a3) + (a4 * a4 + a5 * a5) + (a6 * a6 + a7 * a7); }
        const float rstd = rsqrtf(wave_sum(ss) * (1.f / DM) + RMS_EPS);
#pragma unroll
        for (int j = 0; j < 4; ++j) { const float4 g0 = *(const float4*)(g + 512 * j + 8 * lane), g1 = *(const float4*)(g + 512 * j + 8 * lane + 4); float* o = out + (size_t)row * DM + 512 * j + 8 * lane;
            *(float4*)o = make_float4(lo_bf(w[j].x) * rstd * g0.x, hi_bf(w[j].x) * rstd * g0.y, lo_bf(w[j].y) * rstd * g0.z, hi_bf(w[j].y) * rstd * g0.w);
            *(float4*)(o + 4) = make_float4(lo_bf(w[j].z) * rstd * g1.x, hi_bf(w[j].z) * rstd * g1.y, lo_bf(w[j].w) * rstd * g1.z, hi_bf(w[j].w) * rstd * g1.w); }
    }
}
__device__ __forceinline__ void phase_norm(const float* src, const float* g, bf16* obf, float* of32, float* xcopy) {
    int tid_ = threadIdx.x; asm volatile("" : "+v"(tid_));
    const int lane = tid_ & 63, gw = blockIdx.x * 8 + (tid_ >> 6), nw = gridDim.x * 8;
    const float4* gr = (const float4*)g + lane;
    for (int row = gw; row < T_SEQ; row += nw) {
        const float4* xr = (const float4*)(src + (size_t)row * DM) + lane;
        float4 v[8]; float ss = 0.f;
#pragma unroll
        for (int j = 0; j < 8; ++j) { v[j] = xr[64 * j]; ss += v[j].x * v[j].x + v[j].y * v[j].y + v[j].z * v[j].z + v[j].w * v[j].w; }
        const float rstd = rsqrtf(wave_sum(ss) * (1.f / DM) + RMS_EPS);
        if (xcopy) {
#pragma unroll
            for (int j = 0; j < 8; ++j) ((float4*)(xcopy + (size_t)row * DM))[lane + 64 * j] = v[j]; }
#pragma unroll
        for (int j = 0; j < 8; ++j) { const float4 gg = gr[64 * j]; const float a = v[j].x * rstd * gg.x, b = v[j].y * rstd * gg.y, c = v[j].z * rstd * gg.z, d = v[j].w * rstd * gg.w;
            if (of32) ((float4*)(of32 + (size_t)row * DM))[lane + 64 * j] = make_float4(a, b, c, d);
            else ((uint2*)(obf + (size_t)row * DM))[lane + 64 * j] = make_uint2((unsigned)f2bf(a) | ((unsigned)f2bf(b) << 16), (unsigned)f2bf(c) | ((unsigned)f2bf(d) << 16)); }
    }
}
typedef short bf16x8 __attribute__((ext_vector_type(8)));
typedef short bf16x4 __attribute__((ext_vector_type(4)));
typedef float f32x16 __attribute__((ext_vector_type(16)));
typedef float f32x4v __attribute__((ext_vector_type(4)));
typedef unsigned u32x4v __attribute__((ext_vector_type(4)));
#define MFMA32(a, b, c) __builtin_amdgcn_mfma_f32_32x32x16_bf16((a), (b), (c), 0, 0, 0)
__device__ __forceinline__ bf16x8 pack8(const float* v) { typedef unsigned u32x4_ __attribute__((ext_vector_type(4))); u32x4_ w; w.x = pk_bf16(v[0], v[1]); w.y = pk_bf16(v[2], v[3]); w.z = pk_bf16(v[4], v[5]); w.w = pk_bf16(v[6], v[7]); return __builtin_bit_cast(bf16x8, w); }
__device__ __forceinline__ float gelu_tanh_f(float x) { const float u = 0.7978845608028654f * (x + 0.044715f * x * x * x); const float th = 1.f - 2.f / (1.f + __expf(2.f * u)); return 0.5f * x * (1.f + th); }
__device__ __forceinline__ int kperm(int r) { return (r & 0x13) | ((r & 4) << 1) | ((r & 8) >> 1); }
__device__ __forceinline__ float neg_expm1_small(float x, float a_half) {
    const float p = -x * (1.f + x * (0.5f + x * (0.16666667f + x * (0.041666668f + x * (0.0083333338f + x * 0.0013888889f)))));
    return (x > -0.25f) ? p : (1.f - a_half * a_half);
}
#define LRU_BAR() do { asm volatile("s_waitcnt vmcnt(0) lgkmcnt(0)" ::: "memory"); __builtin_amdgcn_s_barrier(); asm volatile("" ::: "memory"); } while (0)
template <int PASS> __device__ __forceinline__ void lru_pass(const bf16* Z, const bf16* LW, const float* cw_g, const float* cb_g, const float* b_a, const float* b_x, const float* lam,
                                                              float2* CARRY, bf16* YC, LAS unsigned char* lds) {
    int tid_ = threadIdx.x; asm volatile("" : "+v"(tid_));
    const int tid = tid_, lane = tid & 63, wave = __builtin_amdgcn_readfirstlane(tid >> 6), r = lane & 31, hh = lane >> 5, jt = wave & 3, th = wave >> 2;
    LAS unsigned short* RAW = (LAS unsigned short*)lds; LAS unsigned char* XC = lds + 36864; LAS unsigned short* GT = (LAS unsigned short*)(lds + 69632);
    LAS float* xcomp = (LAS float*)(lds + LDS_MISC + 1024);
    for (int u = blockIdx.x; u < 512; u += gridDim.x) {
        const int R = u >> 3, blk = u & 7, tok0 = R * 128, dd = 32 * jt + r, d = blk * 128 + dd;
        LRU_BAR();
        { int t_ = tid; asm volatile("" : "+v"(t_));
#pragma unroll
          for (int i = 0; i < 5; ++i) { const int idx = t_ + 512 * i; if (idx < 131 * 16) { const int row = idx >> 4, c = idx & 15, t = tok0 - 3 + row; u32x4v v = (u32x4v){0u, 0u, 0u, 0u};
              if (t >= 0) v = *(const u32x4v*)(Z + (size_t)t * NZ + Z_CX + blk * 128 + c * 8); *(LAS u32x4v*)(RAW + row * 128 + c * 8) = v; } }
          if (PASS == 2) {
#pragma unroll
              for (int i = 0; i < 4; ++i) { const int idx = t_ + 512 * i, row = idx >> 4, c = idx & 15; *(LAS u32x4v*)(GT + row * 128 + c * 8) = *(const u32x4v*)(Z + (size_t)(tok0 + row) * NZ + Z_CG + blk * 128 + c * 8); } } }
        const bf16* wt = LW + (size_t)blk * 256 * 128;
        bf16x8 ba[8], bx[8];
#pragma unroll
        for (int s = 0; s < 8; ++s) { ba[s] = *(const bf16x8*)(wt + (size_t)dd * 128 + 16 * s + 8 * hh); bx[s] = *(const bf16x8*)(wt + (size_t)(128 + dd) * 128 + 16 * s + 8 * hh); }
        const float bav = b_a[d], bxv = b_x[d], sp8 = 8.f * log1pf(expf(-lam[d]));
        const float w0 = cw_g[d], w1 = cw_g[1024 + d], w2 = cw_g[2048 + d], w3 = cw_g[3072 + d], wb = cb_g[d];
        float hc = 0.f;
        if (PASS == 2) { for (int q0 = 0; q0 < R; q0 += 8) { float2 cc[8];
#pragma unroll
                for (int j = 0; j < 8; ++j) cc[j] = (q0 + j < R) ? CARRY[(size_t)(q0 + j) * 1024 + d] : make_float2(1.f, 0.f);
#pragma unroll
                for (int j = 0; j < 8; ++j) hc = hc * cc[j].x + cc[j].y; } }
        LRU_BAR();
        { const int c8 = tid & 15; const float* cwp = cw_g + blk * 128 + c8 * 8; float cw[4][8], cbv[8];
#pragma unroll
          for (int jj = 0; jj < 4; ++jj) { const float4 q0 = *(const float4*)(cwp + jj * 1024), q1 = *(const float4*)(cwp + jj * 1024 + 4); cw[jj][0] = q0.x; cw[jj][1] = q0.y; cw[jj][2] = q0.z; cw[jj][3] = q0.w; cw[jj][4] = q1.x; cw[jj][5] = q1.y; cw[jj][6] = q1.z; cw[jj][7] = q1.w; }
          { const float4 q0 = *(const float4*)(cb_g + blk * 128 + c8 * 8), q1 = *(const float4*)(cb_g + blk * 128 + c8 * 8 + 4); cbv[0] = q0.x; cbv[1] = q0.y; cbv[2] = q0.z; cbv[3] = q0.w; cbv[4] = q1.x; cbv[5] = q1.y; cbv[6] = q1.z; cbv[7] = q1.w; }
#pragma unroll
          for (int i = 0; i < 4; ++i) { const int t = (tid >> 4) + 32 * i; float xv[8];
#pragma unroll
              for (int e = 0; e < 8; ++e) xv[e] = cbv[e];
#pragma unroll
              for (int jj = 0; jj < 4; ++jj) { const u32x4v raw = *(const LAS u32x4v*)(RAW + (t + jj) * 128 + c8 * 8);
                  xv[0] += cw[jj][0] * lo_bf(raw[0]); xv[1] += cw[jj][1] * hi_bf(raw[0]); xv[2] += cw[jj][2] * lo_bf(raw[1]); xv[3] += cw[jj][3] * hi_bf(raw[1]);
                  xv[4] += cw[jj][4] * lo_bf(raw[2]); xv[5] += cw[jj][5] * hi_bf(raw[2]); xv[6] += cw[jj][6] * lo_bf(raw[3]); xv[7] += cw[jj][7] * hi_bf(raw[3]); }
              *(LAS bf16x8*)(XC + t * 256 + ((c8 ^ (t & 15)) << 4)) = pack8(xv); } }
        LRU_BAR();
        float av[2][16], uv[2][16]; float Aw = 1.f, Hw = 0.f;
        float Ag[2][4], Hg[2][4], Ap[2][4], Hp[2][4];
#pragma unroll
        for (int tt = 0; tt < 2; ++tt) {
            const int tl0 = 64 * th + 32 * tt;
            f32x16 accA, accX;
#pragma unroll
            for (int i = 0; i < 16; ++i) { accA[i] = 0.f; accX[i] = 0.f; }
#pragma unroll
            for (int s = 0; s < 8; ++s) { const bf16x8 af = *(const LAS bf16x8*)(XC + (tl0 + r) * 256 + (((2 * s + hh) ^ (r & 15)) << 4)); accA = MFMA32(af, ba[s], accA); accX = MFMA32(af, bx[s], accX); }
#pragma unroll
            for (int gq = 0; gq < 4; ++gq) { const int t0 = tl0 + 8 * gq + 4 * hh; float cxr[7];
#pragma unroll
                for (int q = 0; q < 7; ++q) cxr[q] = bf2f(RAW[(t0 + q) * 128 + dd]);
#pragma unroll
                for (int e = 0; e < 4; ++e) { const int i = 4 * gq + e;
                    const float xc = wb + w0 * cxr[e] + w1 * cxr[e + 1] + w2 * cxr[e + 2] + w3 * cxr[e + 3];
                    const float rr = __builtin_amdgcn_rcpf(1.f + __expf(-(accA[i] + bav))), ig = __builtin_amdgcn_rcpf(1.f + __expf(-(accX[i] + bxv)));
                    const float la = -sp8 * rr, a_ = __expf(la); av[tt][i] = a_; uv[tt][i] = __builtin_amdgcn_sqrtf(neg_expm1_small(2.f * la, a_)) * (ig * xc); } }
#pragma unroll
            for (int gq = 0; gq < 4; ++gq) { float A = av[tt][4 * gq], H = uv[tt][4 * gq];
#pragma unroll
                for (int e = 1; e < 4; ++e) { H = H * av[tt][4 * gq + e] + uv[tt][4 * gq + e]; A *= av[tt][4 * gq + e]; }
                Ag[tt][gq] = A; Hg[tt][gq] = H; Ap[tt][gq] = __shfl_xor(A, 32); Hp[tt][gq] = __shfl_xor(H, 32); }
#pragma unroll
            for (int p = 0; p < 8; ++p) { const bool own = ((p & 1) == hh); const float A = own ? Ag[tt][p >> 1] : Ap[tt][p >> 1], H = own ? Hg[tt][p >> 1] : Hp[tt][p >> 1]; Hw = Hw * A + H; Aw *= A; }
        }
        if (hh == 0) { xcomp[(wave * 32 + r) * 2] = Aw; xcomp[(wave * 32 + r) * 2 + 1] = Hw; }
        LRU_BAR();
        if (PASS == 1) {
            if (th == 0 && hh == 0) { const float A1 = xcomp[((wave + 4) * 32 + r) * 2], H1 = xcomp[((wave + 4) * 32 + r) * 2 + 1]; CARRY[(size_t)R * 1024 + d] = make_float2(Aw * A1, Hw * A1 + H1); }
        } else {
            if (th == 1) { const float A0 = xcomp[((wave - 4) * 32 + r) * 2], H0 = xcomp[((wave - 4) * 32 + r) * 2 + 1]; hc = hc * A0 + H0; }
#pragma unroll
            for (int tt = 0; tt < 2; ++tt) { const int tl0 = 64 * th + 32 * tt; float hin[4];
#pragma unroll
                for (int p = 0; p < 8; ++p) { const bool own = ((p & 1) == hh); if (own) hin[p >> 1] = hc; const float A = own ? Ag[tt][p >> 1] : Ap[tt][p >> 1], H = own ? Hg[tt][p >> 1] : Hp[tt][p >> 1]; hc = hc * A + H; }
#pragma unroll
                for (int gq = 0; gq < 4; ++gq) { float h = hin[gq]; const int t0 = tl0 + 8 * gq + 4 * hh;
#pragma unroll
                    for (int e = 0; e < 4; ++e) { h = h * av[tt][4 * gq + e] + uv[tt][4 * gq + e];
                        YC[(size_t)(tok0 + t0 + e) * 1024 + d] = f2bf(h * gelu_tanh_f(bf2f(GT[(t0 + e) * 128 + dd]))); } } }
        }
    }
    LRU_BAR();
}
__device__ __forceinline__ float wave_incl_sum(float v, int lane) {
#pragma unroll
    for (int o = 1; o < 64; o <<= 1) { const float t = __shfl_up(v, o); if (lane >= o) v += t; }
    return v;
}
__device__ __forceinline__ float wave_incl_max(float v, int lane) {
#pragma unroll
    for (int o = 1; o < 64; o <<= 1) { const float t = __shfl_up(v, o); if (lane >= o) v = fmaxf(v, t); }
    return v;
}
__device__ __forceinline__ float wave_max(float v) {
#pragma unroll
    for (int o = 1; o < 64; o <<= 1) v = fmaxf(v, __shfl_xor(v, o));
    return v;
}
constexpr int ML_L = 128, ML_NC = T_SEQ / ML_L;
struct ChunkGates { float a0, a1, b0, b1, Bc; };
__device__ __forceinline__ ChunkGates chunk_gates(const float* G, float bi, float bfv, int tok0, int h, int lane) {
    const size_t t = (size_t)tok0 + 2 * lane;
    const float ip0 = G[t * 8 + h] + bi, fp0 = G[t * 8 + 4 + h] + bfv, ip1 = G[(t + 1) * 8 + h] + bi, fp1 = G[(t + 1) * 8 + 4 + h] + bfv;
    const float lf0 = fminf(fp0, 0.f) - log1pf(expf(-fabsf(fp0))), lf1 = fminf(fp1, 0.f) - log1pf(expf(-fabsf(fp1)));
    const float s1 = lf0 + lf1, inc = wave_incl_sum(s1, lane), excl = inc - s1;
    ChunkGates g; g.b0 = excl + lf0; g.b1 = inc; g.Bc = __builtin_bit_cast(float, __builtin_amdgcn_readlane(__builtin_bit_cast(int, inc), 63)); g.a0 = ip0 - g.b0; g.a1 = ip1 - g.b1; return g;
}
__device__ __forceinline__ void ml_ktrans(const bf16* Z, bf16* AKT, LAS unsigned char* lds) {
    int tid_ = threadIdx.x; asm volatile("" : "+v"(tid_));
    const int lane = tid_ & 63, wave = __builtin_amdgcn_readfirstlane(tid_ >> 6), gw = blockIdx.x * 8 + wave, nw = gridDim.x * 8;
    LAS unsigned short* tl = (LAS unsigned short*)(lds + wave * 16384);
    for (int u = gw; u < 2048; u += nw) { const int tok0 = (u >> 4) * 64, ch0 = (u & 15) * 64;
#pragma unroll
        for (int i = 0; i < 8; ++i) { const int tk = 8 * i + (lane >> 3), cc = (lane & 7) * 8;
            *(LAS u32x4v*)(tl + tk * 72 + cc) = *(const u32x4v*)(Z + (size_t)(tok0 + tk) * NZ + Z_AK + ch0 + cc); }
        asm volatile("s_waitcnt lgkmcnt(0)" ::: "memory");
#pragma unroll
        for (int i = 0; i < 8; ++i) { const int ch = 8 * i + (lane >> 3), tc = (lane & 7) * 8; unsigned w[4];
#pragma unroll
            for (int e = 0; e < 4; ++e) w[e] = (unsigned)tl[(tc + 2 * e) * 72 + ch] | ((unsigned)tl[(tc + 2 * e + 1) * 72 + ch] << 16);
            *(uint4*)(AKT + (size_t)(ch0 + ch) * T_SEQ + tok0 + tc) = make_uint4(w[0], w[1], w[2], w[3]); }
        asm volatile("s_waitcnt lgkmcnt(0)" ::: "memory");
    }
}
template <int CHUNKS> __device__ __forceinline__ void ml_stage(LAS unsigned char* dst, const bf16* src, size_t row_stride, int tid) {
    asm volatile("" : "+v"(tid));
    u32x4v v[8];
#pragma unroll
    for (int i = 0; i < 8; ++i) { const int idx = tid + 512 * i, row = idx / CHUNKS, c = idx % CHUNKS; v[i] = *(const u32x4v*)(src + (size_t)row * row_stride + c * 8); }
#pragma unroll
    for (int i = 0; i < 8; ++i) { const int idx = tid + 512 * i, row = idx / CHUNKS, c = idx % CHUNKS; *(LAS u32x4v*)(dst + row * (CHUNKS * 16) + ((c ^ (row & 15)) << 4)) = v[i]; }
}
#define ML_BAR() do { asm volatile("s_waitcnt vmcnt(0) lgkmcnt(0)" ::: "memory"); __builtin_amdgcn_s_barrier(); asm volatile("" ::: "memory"); } while (0)
__device__ __forceinline__ void ml_local(const bf16* ZT, const bf16* AKT, const float* G, const float* b_i, const float* b_f, float* __restrict__ LST, float* __restrict__ NL, float2* __restrict__ BG, LAS unsigned char* lds) {
    int tid_ = threadIdx.x; asm volatile("" : "+v"(tid_));
    const int tid = tid_, lane = tid & 63, wave = __builtin_amdgcn_readfirstlane(tid >> 6), r = lane & 31, hh = lane >> 5, it = wave;
    LAS float* wl = (LAS float*)(lds + LDS_MISC + 12288);
    for (int u = blockIdx.x; u < ML_NC * 4; u += gridDim.x) { const int c = u >> 2, h = u & 3, tok0 = c * ML_L;
        ML_BAR();
        ml_stage<16>(lds, ZT + (size_t)(ZT_AV + h * 256) * T_SEQ + tok0, T_SEQ, tid);
        ml_stage<16>(lds + 65536, AKT + (size_t)(h * 256) * T_SEQ + tok0, T_SEQ, tid);
        if (wave == 0) { const ChunkGates cg = chunk_gates(G, b_i[h], b_f[h], tok0, h, lane);
            const float g0 = cg.Bc + cg.a0, g1 = cg.Bc + cg.a1, Gc = wave_max(fmaxf(g0, g1));
            wl[2 * lane] = __expf(g0 - Gc); wl[2 * lane + 1] = __expf(g1 - Gc);
            if (lane == 0) BG[h * ML_NC + c] = make_float2(cg.Bc, Gc); }
        ML_BAR();
        f32x16 acc[8];
#pragma unroll
        for (int jt = 0; jt < 8; ++jt)
#pragma unroll
            for (int i = 0; i < 16; ++i) acc[jt][i] = 0.f;
        const int vrow = 32 * it + r, x = r & 15;
#pragma unroll 2
        for (int s = 0; s < 8; ++s) {
            const u32x4v vr = *(const LAS u32x4v*)(lds + vrow * 256 + (((2 * s + hh) ^ x) << 4));
            const f32x4v w0 = *(const LAS f32x4v*)(wl + 16 * s + 8 * hh), w1 = *(const LAS f32x4v*)(wl + 16 * s + 8 * hh + 4);
            float vv[8] = {lo_bf(vr[0]) * w0[0], hi_bf(vr[0]) * w0[1], lo_bf(vr[1]) * w0[2], hi_bf(vr[1]) * w0[3], lo_bf(vr[2]) * w1[0], hi_bf(vr[2]) * w1[1], lo_bf(vr[3]) * w1[2], hi_bf(vr[3]) * w1[3]};
            const bf16x8 af = pack8(vv);
#pragma unroll
            for (int jt = 0; jt < 8; ++jt) { const bf16x8 bfr = *(const LAS bf16x8*)(lds + 65536 + (32 * jt + r) * 256 + (((2 * s + hh) ^ x) << 4)); acc[jt] = MFMA32(af, bfr, acc[jt]); }
        }
        float* lo = LST + ((size_t)(c * 4 + h) * 256 + 32 * it + 4 * hh) * 256 + r;
#pragma unroll
        for (int jt = 0; jt < 8; ++jt)
#pragma unroll
            for (int i = 0; i < 16; ++i) lo[(size_t)((i & 3) + 8 * (i >> 2)) * 256 + 32 * jt] = acc[jt][i];
        { float ns = 0.f;
#pragma unroll
            for (int q = 0; q < 8; ++q) { const u32x4v kv = *(const LAS u32x4v*)(lds + 65536 + vrow * 256 + (((8 * hh + q) ^ x) << 4)); const f32x4v w0 = *(const LAS f32x4v*)(wl + 64 * hh + 8 * q), w1 = *(const LAS f32x4v*)(wl + 64 * hh + 8 * q + 4);
                ns += lo_bf(kv[0]) * w0[0] + hi_bf(kv[0]) * w0[1] + lo_bf(kv[1]) * w0[2] + hi_bf(kv[1]) * w0[3] + lo_bf(kv[2]) * w1[0] + hi_bf(kv[2]) * w1[1] + lo_bf(kv[3]) * w1[2] + hi_bf(kv[3]) * w1[3]; }
            ns += __shfl_xor(ns, 32);
            if (hh == 0) NL[(size_t)(c * 4 + h) * 256 + 32 * it + r] = ns; }
    }
    ML_BAR();
}
__device__ __forceinline__ void ml_scan(const float* __restrict__ LST, const float* __restrict__ NL, const float2* __restrict__ BG, bf16* __restrict__ CST, float* __restrict__ NST, float* __restrict__ MST) {
    int tid_ = threadIdx.x; asm volatile("" : "+v"(tid_));
    const int lane = tid_ & 63, wave = __builtin_amdgcn_readfirstlane(tid_ >> 6), gw = blockIdx.x * 8 + wave, nw = gridDim.x * 8;
    for (int u = gw; u < 2048; u += nw) {
        const int h = u >> 9; const size_t e = ((size_t)u * 64 + lane) * 2;
        const size_t eh = e - (size_t)h * 65536;
        float c0 = 0.f, c1 = 0.f, m = 0.f;
        const bool do_n = (u & 511) < 4;  const int nk = (u & 511) * 64 + lane;
        float nv = 0.f;
        for (int cb = 0; cb < ML_NC; cb += 8) {
            float2 lv[8], bg[8]; float nl[8];
#pragma unroll
            for (int j = 0; j < 8; ++j) { lv[j] = *(const float2*)(LST + (size_t)((cb + j) * 4 + h) * 65536 + eh); bg[j] = BG[h * ML_NC + cb + j]; nl[j] = do_n ? NL[(size_t)((cb + j) * 4 + h) * 256 + nk] : 0.f; }
#pragma unroll
            for (int j = 0; j < 8; ++j) { const int c = cb + j;
                *(unsigned*)(CST + (size_t)(c * 4 + h) * 65536 + eh) = pk_bf16(c0, c1);
                if (eh == 0) MST[h * ML_NC + c] = m;
                const float mn = fmaxf(bg[j].x + m, bg[j].y), dec = __expf(bg[j].x + m - mn), inj = __expf(bg[j].y - mn);
                c0 = dec * c0 + inj * lv[j].x; c1 = dec * c1 + inj * lv[j].y;
                if (do_n) { NST[(size_t)(c * 4 + h) * 256 + nk] = nv; nv = dec * nv + inj * nl[j]; }
                m = mn; }
        }
    }
}
__device__ __forceinline__ void ml_out(const bf16* Z, const bf16* ZT, const float* G, const float* b_i, const float* b_f, const bf16* CST, const float* NST, const float* MST, const float* gain, bf16* YA, LAS unsigned char* lds) {
    int tid_ = threadIdx.x; asm volatile("" : "+v"(tid_));
    const int tid = tid_, lane = tid & 63, wave = __builtin_amdgcn_readfirstlane(tid >> 6), r = lane & 31, hh = lane >> 5, qt = wave >> 1, dvh = wave & 1;
    LAS float* al = (LAS float*)(lds + LDS_MISC + 12288);
    LAS float* xch = (LAS float*)(lds + LDS_MISC + 1024);
    LAS unsigned char* TA = lds; LAS unsigned char* TB = lds + 65536;
    const int x = r & 15, kr = kperm(r), kx = kr & 15;
    for (int u = blockIdx.x; u < ML_NC * 4; u += gridDim.x) { const int c = u >> 2, h = u & 3, tok0 = c * ML_L;
        ML_BAR();
        ml_stage<32>(TA, Z + (size_t)tok0 * NZ + Z_AQ + h * 256, NZ, tid);
        ml_stage<16>(TB, CST + (size_t)(c * 4 + h) * 65536, 256, tid);
        if (wave == 0) { const ChunkGates cg = chunk_gates(G, b_i[h], b_f[h], tok0, h, lane);
            const float pm1 = fmaxf(cg.a0, cg.a1), inc = wave_incl_max(pm1, lane); float ex = __shfl_up(inc, 1); if (lane == 0) ex = -INFINITY;
            al[2 * lane] = cg.a0; al[2 * lane + 1] = cg.a1; al[128 + 2 * lane] = fmaxf(ex, cg.a0); al[128 + 2 * lane + 1] = inc; al[256 + 2 * lane] = cg.b0; al[256 + 2 * lane + 1] = cg.b1; }
        ML_BAR();
        const float mc = MST[h * ML_NC + c];
        const int tq = 32 * qt + r; const size_t tglob = (size_t)tok0 + tq;
        const float Mt = fmaxf(mc, al[128 + tq]), wi = __expf(mc - Mt), emt = __expf(-(al[256 + tq] + Mt));
        f32x16 acc[4];
#pragma unroll
        for (int dt = 0; dt < 4; ++dt)
#pragma unroll
            for (int i = 0; i < 16; ++i) acc[dt][i] = 0.f;
        const float* nrow = NST + (size_t)(c * 4 + h) * 256 + 8 * hh;
        float qn = 0.f;
#pragma unroll
        for (int half = 0; half < 2; ++half) {
            if (half == 1) { ML_BAR(); ml_stage<16>(TB, CST + (size_t)(c * 4 + h) * 65536 + 128, 256, tid); ML_BAR(); }
#pragma unroll 2
            for (int s8 = 0; s8 < 8; ++s8) { const int s = 8 * half + s8;
                const u32x4v qr = *(const LAS u32x4v*)(TA + tq * 512 + (((2 * s + hh) ^ x) << 4)); const bf16x8 qf = __builtin_bit_cast(bf16x8, qr);
                const float4 n0 = *(const float4*)(nrow + 16 * s), n1 = *(const float4*)(nrow + 16 * s + 4);
                qn += lo_bf(qr[0]) * n0.x + hi_bf(qr[0]) * n0.y + lo_bf(qr[1]) * n0.z + hi_bf(qr[1]) * n0.w + lo_bf(qr[2]) * n1.x + hi_bf(qr[2]) * n1.y + lo_bf(qr[3]) * n1.z + hi_bf(qr[3]) * n1.w;
#pragma unroll
                for (int dt = 0; dt < 4; ++dt) { const bf16x8 cf = *(const LAS bf16x8*)(TB + (128 * dvh + 32 * dt + r) * 256 + (((2 * s8 + hh) ^ x) << 4)); acc[dt] = MFMA32(cf, qf, acc[dt]); }
            }
        }
        qn += __shfl_xor(qn, 32);
#pragma unroll
        for (int dt = 0; dt < 4; ++dt)
#pragma unroll
            for (int i = 0; i < 16; ++i) acc[dt][i] *= wi;
        ML_BAR(); ml_stage<32>(TB, Z + (size_t)tok0 * NZ + Z_AK + h * 256, NZ, tid); ML_BAR();
        bf16x8 pf[4][2]; float dsum = 0.f;
#pragma unroll
        for (int kt = 0; kt < 4; ++kt) { if (kt <= qt) {
            f32x16 X;
#pragma unroll
            for (int i = 0; i < 16; ++i) X[i] = 0.f;
#pragma unroll 2
            for (int s = 0; s < 16; ++s) { const bf16x8 kf = *(const LAS bf16x8*)(TB + (32 * kt + kr) * 512 + (((2 * s + hh) ^ kx) << 4)), qf = *(const LAS bf16x8*)(TA + tq * 512 + (((2 * s + hh) ^ x) << 4)); X = MFMA32(kf, qf, X); }
            float P[16];
#pragma unroll
            for (int g8 = 0; g8 < 2; ++g8) { const int s0 = 32 * kt + 16 * g8 + 8 * hh; const f32x4v a0 = *(const LAS f32x4v*)(al + s0), a1 = *(const LAS f32x4v*)(al + s0 + 4);
#pragma unroll
                for (int e = 0; e < 8; ++e) { const float av = (e < 4) ? a0[e & 3] : a1[e & 3]; const float p = (s0 + e <= tq) ? X[8 * g8 + e] * __expf(av - Mt) : 0.f; P[8 * g8 + e] = p; dsum += p; } }
            pf[kt][0] = pack8(P); pf[kt][1] = pack8(P + 8); } }
        dsum += __shfl_xor(dsum, 32);
        ML_BAR(); ml_stage<16>(TB, ZT + (size_t)(ZT_AV + h * 256) * T_SEQ + tok0, T_SEQ, tid); ML_BAR();
#pragma unroll
        for (int kt = 0; kt < 4; ++kt) { if (kt <= qt) {
#pragma unroll
            for (int s2 = 0; s2 < 2; ++s2)
#pragma unroll
                for (int dt = 0; dt < 4; ++dt) { const bf16x8 vf = *(const LAS bf16x8*)(TB + (128 * dvh + 32 * dt + r) * 256 + (((4 * kt + 2 * s2 + hh) ^ x) << 4)); acc[dt] = MFMA32(vf, pf[kt][s2], acc[dt]); } } }
        const float den = dsum + wi * qn, inv = 1.f / fmaxf(fabsf(den), emt);
        float ss = 0.f;
#pragma unroll
        for (int dt = 0; dt < 4; ++dt)
#pragma unroll
            for (int i = 0; i < 16; ++i) { acc[dt][i] *= inv; ss += acc[dt][i] * acc[dt][i]; }
        ss += __shfl_xor(ss, 32);
        if (hh == 0) xch[wave * 32 + r] = ss;
        ML_BAR();
        const float rs = rsqrtf((ss + xch[(wave ^ 1) * 32 + r]) * (1.f / 256.f) + RMS_EPS);
#pragma unroll
        for (int dt = 0; dt < 4; ++dt)
#pragma unroll
            for (int gq = 0; gq < 4; ++gq) { const int dv0 = 128 * dvh + 32 * dt + 8 * gq + 4 * hh;
                const uint2 ow = *(const uint2*)(Z + tglob * NZ + Z_AO + h * 256 + dv0); const float4 gg = *(const float4*)(gain + h * 256 + dv0);
                const float y0 = sigmoidf_(lo_bf(ow.x)) * acc[dt][4 * gq] * rs * gg.x, y1 = sigmoidf_(hi_bf(ow.x)) * acc[dt][4 * gq + 1] * rs * gg.y,
                            y2 = sigmoidf_(lo_bf(ow.y)) * acc[dt][4 * gq + 2] * rs * gg.z, y3 = sigmoidf_(hi_bf(ow.y)) * acc[dt][4 * gq + 3] * rs * gg.w;
                *(uint2*)(YA + tglob * 1024 + h * 256 + dv0) = make_uint2(pk_bf16(y0, y1), pk_bf16(y2, y3)); }
    }
    ML_BAR();
}
constexpr float MOBA_SCALE = 0.08838834764831845f;
__device__ __forceinline__ void moba_kmean(const bf16* Z, float* KMP) {
    int tid_ = threadIdx.x; asm volatile("" : "+v"(tid_));
    const int lane = tid_ & 63, wave = __builtin_amdgcn_readfirstlane(tid_ >> 6), gw = blockIdx.x * 8 + wave, nw = gridDim.x * 8;
    for (int u = gw; u < 512; u += nw) { const int h = u >> 6, n = (u >> 1) & 31, half = u & 1; float s[8];
#pragma unroll
        for (int e = 0; e < 8; ++e) s[e] = 0.f;
        const bf16* kp = Z + (size_t)(n * 256 + half * 128 + (lane >> 4)) * NZ + Z_BK + h * 128 + (lane & 15) * 8;
#pragma unroll 8
        for (int j = 0; j < 32; ++j) { const uint4 w = *(const uint4*)(kp + (size_t)(4 * j) * NZ);
            s[0] += lo_bf(w.x); s[1] += hi_bf(w.x); s[2] += lo_bf(w.y); s[3] += hi_bf(w.y); s[4] += lo_bf(w.z); s[5] += hi_bf(w.z); s[6] += lo_bf(w.w); s[7] += hi_bf(w.w); }
#pragma unroll
        for (int e = 0; e < 8; ++e) { s[e] += __shfl_xor(s[e], 16); s[e] += __shfl_xor(s[e], 32); }
        if (lane < 16) { float* o = KMP + (size_t)u * 128 + lane * 8; *(float4*)o = make_float4(s[0], s[1], s[2], s[3]); *(float4*)(o + 4) = make_float4(s[4], s[5], s[6], s[7]); } }
}
__device__ __forceinline__ void top3_insert(float g, int n, float& v1, float& v2, float& v3, int& i1, int& i2, int& i3) {
    const bool b1 = (g > v1) || (g == v1 && n < i1), b2 = (g > v2) || (g == v2 && n < i2), b3 = (g > v3) || (g == v3 && n < i3);
    const float nv3 = b2 ? v2 : (b3 ? g : v3), nv2 = b1 ? v1 : (b2 ? g : v2), nv1 = b1 ? g : v1;
    const int ni3 = b2 ? i2 : (b3 ? n : i3), ni2 = b1 ? i1 : (b2 ? n : i2), ni1 = b1 ? n : i1;
    v1 = nv1; v2 = nv2; v3 = nv3; i1 = ni1; i2 = ni2; i3 = ni3;
}
__device__ __forceinline__ void moba_select(const bf16* Z, const float* KM, unsigned* SEL, float* PLSE, LAS unsigned char* lds) {
    int tid_ = threadIdx.x; asm volatile("" : "+v"(tid_));
    const int lane = tid_ & 63, wave = __builtin_amdgcn_readfirstlane(tid_ >> 6), r = lane & 31, hh = lane >> 5, gw = blockIdx.x * 8 + wave, nw = gridDim.x * 8;
    for (int u = gw; u < 2048; u += nw) { const int h = u & 7, t0 = (u >> 3) * 32, qb = t0 >> 8; const size_t t = (size_t)t0 + r;
        f32x16 X;
#pragma unroll
        for (int i = 0; i < 16; ++i) X[i] = 0.f;
        if (qb > 0) {
            const bf16* qp = Z + t * NZ + Z_BQ + h * 128 + 8 * hh;
            const float* kq = KM + ((size_t)(h * 32 + r) * 2) * 128 + 8 * hh;
#pragma unroll 2
            for (int s = 0; s < 8; ++s) { const bf16x8 qf = *(const bf16x8*)(qp + 16 * s);
                const float4 a0 = *(const float4*)(kq + 16 * s), a1 = *(const float4*)(kq + 16 * s + 4), b0 = *(const float4*)(kq + 128 + 16 * s), b1 = *(const float4*)(kq + 128 + 16 * s + 4);
                float km[8] = {(a0.x + b0.x) * (1.f / 256.f), (a0.y + b0.y) * (1.f / 256.f), (a0.z + b0.z) * (1.f / 256.f), (a0.w + b0.w) * (1.f / 256.f), (a1.x + b1.x) * (1.f / 256.f), (a1.y + b1.y) * (1.f / 256.f), (a1.z + b1.z) * (1.f / 256.f), (a1.w + b1.w) * (1.f / 256.f)};
                float hi[8], lo[8];
#pragma unroll
                for (int e = 0; e < 8; ++e) { hi[e] = __uint_as_float(__float_as_uint(km[e]) & 0xffff0000u); lo[e] = km[e] - hi[e]; }
                X = MFMA32(pack8(hi), qf, X); X = MFMA32(pack8(lo), qf, X); }
        }
        float v1 = -INFINITY, v2 = -INFINITY, v3 = -INFINITY; int i1 = 255, i2 = 255, i3 = 255;
#pragma unroll
        for (int i = 0; i < 16; ++i) { const int n = (i & 3) + 8 * (i >> 2) + 4 * hh; top3_insert((n < qb) ? X[i] : -INFINITY, (n < qb) ? n : 255, v1, v2, v3, i1, i2, i3); }
        const float p1 = __shfl_xor(v1, 32), p2 = __shfl_xor(v2, 32), p3 = __shfl_xor(v3, 32); const int j1 = __shfl_xor(i1, 32), j2 = __shfl_xor(i2, 32), j3 = __shfl_xor(i3, 32);
        top3_insert(p1, j1, v1, v2, v3, i1, i2, i3); top3_insert(p2, j2, v1, v2, v3, i1, i2, i3); top3_insert(p3, j3, v1, v2, v3, i1, i2, i3);
        if (hh == 0) { SEL[(size_t)h * T_SEQ + t] = (unsigned)i1 | ((unsigned)i2 << 8) | ((unsigned)i3 << 16);
            float* pl = PLSE + (t * 8 + h) * 3;
            if (i1 == 255) pl[0] = -INFINITY;
            if (i2 == 255) pl[1] = -INFINITY;
            if (i3 == 255) pl[2] = -INFINITY; }
    }
}
__device__ __forceinline__ void moba_stage(const bf16* Z, const bf16* ZT, int h, int kb, LAS unsigned char* lds, int tid) {
    asm volatile("" : "+v"(tid));
    u32x4v kv[8], vv[8];
#pragma unroll
    for (int i = 0; i < 8; ++i) { const int idx = tid + 512 * i, row = idx >> 4, c = idx & 15; kv[i] = *(const u32x4v*)(Z + (size_t)(kb * 256 + row) * NZ + Z_BK + h * 128 + c * 8); }
#pragma unroll
    for (int i = 0; i < 8; ++i) { const int idx = tid + 512 * i, row = idx >> 5, c = idx & 31; vv[i] = *(const u32x4v*)(ZT + (size_t)(ZT_BV + h * 128 + row) * T_SEQ + kb * 256 + c * 8); }
#pragma unroll
    for (int i = 0; i < 8; ++i) { const int idx = tid + 512 * i, row = idx >> 4, c = idx & 15; *(LAS u32x4v*)(lds + row * 256 + ((c ^ (row & 15)) << 4)) = kv[i]; }
#pragma unroll
    for (int i = 0; i < 8; ++i) { const int idx = tid + 512 * i, row = idx >> 5, c = idx & 31; *(LAS u32x4v*)(lds + 65536 + row * 512 + ((c ^ (row & 15)) << 4)) = vv[i]; }
}
__device__ __forceinline__ void moba_tile(const bf16* Z, LAS unsigned char* lds, int h, int nkt, int diag, size_t tq, int qloc, int r, int hh, f32x16 (&acc)[4], float& m_out, float& l_out) {
    bf16x8 qf[8];
    const bf16* qp = Z + tq * NZ + Z_BQ + h * 128 + 8 * hh;
#pragma unroll
    for (int s = 0; s < 8; ++s) qf[s] = *(const bf16x8*)(qp + 16 * s);
#pragma unroll
    for (int dt = 0; dt < 4; ++dt)
#pragma unroll
        for (int i = 0; i < 16; ++i) acc[dt][i] = 0.f;
    float m = -1e30f, l = 0.f;
    const int kr = kperm(r), kx = kr & 15, vx = r & 15;
    for (int kt = 0; kt < nkt; ++kt) {
        f32x16 X;
#pragma unroll
        for (int i = 0; i < 16; ++i) X[i] = 0.f;
        LAS unsigned char* kb_ = lds + (32 * kt + kr) * 256;
#pragma unroll
        for (int s = 0; s < 8; ++s) { const bf16x8 kf = *(const LAS bf16x8*)(kb_ + (((2 * s + hh) ^ kx) << 4)); X = MFMA32(kf, qf[s], X); }
        float mx = -1e30f;
#pragma unroll
        for (int i = 0; i < 16; ++i) { float x = X[i] * MOBA_SCALE; if (kt == diag && (32 * kt + (i & 7) + 8 * hh + 16 * (i >> 3)) > qloc) x = -1e30f; X[i] = x; mx = fmaxf(mx, x); }
        mx = fmaxf(mx, __shfl_xor(mx, 32));
        const float mn = fmaxf(m, mx), alpha = __expf(m - mn);
        l *= alpha;
#pragma unroll
        for (int dt = 0; dt < 4; ++dt)
#pragma unroll
            for (int i = 0; i < 16; ++i) acc[dt][i] *= alpha;
        float P[16];
#pragma unroll
        for (int i = 0; i < 16; ++i) { const float p = (X[i] > -1e29f) ? __expf(X[i] - mn) : 0.f; P[i] = p; l += p; }
        m = mn;
#pragma unroll
        for (int s2 = 0; s2 < 2; ++s2) { const bf16x8 pf = pack8(P + 8 * s2);
#pragma unroll
            for (int dt = 0; dt < 4; ++dt) { const bf16x8 vf = *(const LAS bf16x8*)(lds + 65536 + (32 * dt + r) * 512 + (((4 * kt + 2 * s2 + hh) ^ vx) << 4)); acc[dt] = MFMA32(vf, pf, acc[dt]); } }
    }
    l += __shfl_xor(l, 32);
    m_out = m; l_out = l;
}
constexpr int MOBA_SEGS = 9, MOBA_ITEMS_PER_HEAD = 98, MOBA_ITEMS = 8 * MOBA_ITEMS_PER_HEAD;
__device__ __forceinline__ void moba_gather(const bf16* Z, const bf16* ZT, const unsigned* SEL, bf16* PO, float* PLSE, unsigned* qctr, LAS unsigned char* lds) {
    int tid_ = threadIdx.x; asm volatile("" : "+v"(tid_));
    const int tid = tid_, lane = tid & 63, wave = __builtin_amdgcn_readfirstlane(tid >> 6), r = lane & 31, hh = lane >> 5;
    LAS unsigned* cntp = (LAS unsigned*)(lds + LDS_MISC + 2048); LAS unsigned* lst = (LAS unsigned*)(lds + LDS_MISC + 4096);
    LAS unsigned* itp = (LAS unsigned*)(lds + LDS_MISC + 2048 + 64);
    for (;;) {
        __syncthreads();
        if (tid == 0) *itp = __hip_atomic_fetch_add(qctr, 1u, __ATOMIC_RELAXED, __HIP_MEMORY_SCOPE_AGENT);
        asm volatile("s_waitcnt vmcnt(0) lgkmcnt(0)" ::: "memory"); __syncthreads();
        const int it = (int)*itp; if (it >= MOBA_ITEMS) break;
        const int h = it & 7; int k = it >> 3, seg = 0, sa = 1, sb = 2;
        if (k < 76) { for (;;) { const int cnt = (sa < sb - 1) ? sa : sb - 1; if (k < cnt) break; k -= cnt; ++seg; sa = sb; sb = (seg < 3) ? sb + 1 : (seg < 5 ? sb + 2 : (seg < 7 ? sb + 4 : sb + 8)); } }
        else { k -= 76; for (;;) { const int cnt = (sb - 1 > sa) ? sb - 1 - sa : 0; if (k < cnt) break; k -= cnt; ++seg; sa = sb; sb = (seg < 3) ? sb + 1 : (seg < 5 ? sb + 2 : (seg < 7 ? sb + 4 : sb + 8)); } k += sa; }
        const int n = k, qa = (sa > n + 1) ? sa : n + 1;
        __syncthreads();
        moba_stage(Z, ZT, h, n, lds, tid);
        for (int base = qa * 256; base < sb * 256; base += 1024) {
            if (tid == 0) *cntp = 0u;
            asm volatile("s_waitcnt lgkmcnt(0)" ::: "memory"); __syncthreads();
#pragma unroll
            for (int sub = 0; sub < 2; ++sub) { const int t = base + sub * 512 + tid; int slot = -1;
                if (t < sb * 256) { const unsigned sel = SEL[(size_t)h * T_SEQ + t]; slot = ((sel & 0xffu) == (unsigned)n) ? 0 : ((((sel >> 8) & 0xffu) == (unsigned)n) ? 1 : ((((sel >> 16) & 0xffu) == (unsigned)n) ? 2 : -1)); }
                const unsigned long long bal = __ballot(slot >= 0); const int nb = __popcll(bal);
                unsigned wbase = 0u; if (lane == 0 && nb) wbase = __hip_atomic_fetch_add(cntp, (unsigned)nb, __ATOMIC_RELAXED, __HIP_MEMORY_SCOPE_WORKGROUP);
                wbase = __builtin_amdgcn_readfirstlane(wbase);
                if (slot >= 0) lst[wbase + __popcll(bal & ((1ull << lane) - 1ull))] = (unsigned)t | ((unsigned)slot << 16); }
            asm volatile("s_waitcnt lgkmcnt(0)" ::: "memory"); __syncthreads();
            const int count = (int)*cntp;
            for (int tb = wave * 32; tb < count; tb += 256) {
                const bool live = (tb + r) < count; const unsigned ent = lst[live ? tb + r : tb];
                const size_t tq = ent & 0xffffu; const int slot = (int)(ent >> 16);
                f32x16 acc[4]; float m, l;
                moba_tile(Z, lds, h, 8, -1, tq, 0, r, hh, acc, m, l);
                const float inv = 1.f / l;
                if (live) { bf16* po = PO + (((size_t)tq * 8 + h) * 3 + slot) * 128;
#pragma unroll
                    for (int dt = 0; dt < 4; ++dt)
#pragma unroll
                        for (int gq = 0; gq < 4; ++gq) *(uint2*)(po + 32 * dt + 8 * gq + 4 * hh) = make_uint2(pk_bf16(acc[dt][4 * gq] * inv, acc[dt][4 * gq + 1] * inv), pk_bf16(acc[dt][4 * gq + 2] * inv, acc[dt][4 * gq + 3] * inv));
                    if (hh == 0) PLSE[((size_t)tq * 8 + h) * 3 + slot] = m + __logf(l); }
            }
            __syncthreads();
        }
    }
    __syncthreads();
}
__device__ __forceinline__ void moba_own(const bf16* Z, const bf16* ZT, const bf16* PO, const float* PLSE, bf16* YB, LAS unsigned char* lds) {
    int tid_ = threadIdx.x; asm volatile("" : "+v"(tid_));
    const int tid = tid_, lane = tid & 63, wave = __builtin_amdgcn_readfirstlane(tid >> 6), r = lane & 31, hh = lane >> 5;
    for (int it = blockIdx.x; it < 256; it += gridDim.x) { const int h = it >> 5, qb = it & 31, kd = wave;
        __syncthreads();
        moba_stage(Z, ZT, h, qb, lds, tid);
        asm volatile("s_waitcnt lgkmcnt(0)" ::: "memory"); __syncthreads();
        const size_t tq = (size_t)qb * 256 + 32 * kd + r; const int qloc = 32 * kd + r;
        f32x16 acc[4]; float m, l;
        moba_tile(Z, lds, h, kd + 1, kd, tq, qloc, r, hh, acc, m, l);
        const float* pl = PLSE + (tq * 8 + h) * 3; const float e0 = pl[0], e1 = pl[1], e2 = pl[2];
        const float M = fmaxf(fmaxf(m, e0), fmaxf(e1, e2));
        const float wo = __expf(m - M), w0 = __expf(e0 - M), w1 = __expf(e1 - M), w2 = __expf(e2 - M), inv = 1.f / (l * wo + w0 + w1 + w2);
        const bf16* po = PO + ((tq * 8 + h) * 3) * 128;
#pragma unroll
        for (int dt = 0; dt < 4; ++dt)
#pragma unroll
            for (int gq = 0; gq < 4; ++gq) { const int d0 = 32 * dt + 8 * gq + 4 * hh;
                float o0 = acc[dt][4 * gq] * wo, o1 = acc[dt][4 * gq + 1] * wo, o2 = acc[dt][4 * gq + 2] * wo, o3 = acc[dt][4 * gq + 3] * wo;
                if (w0 > 0.f) { const uint2 p = *(const uint2*)(po + d0); o0 += w0 * lo_bf(p.x); o1 += w0 * hi_bf(p.x); o2 += w0 * lo_bf(p.y); o3 += w0 * hi_bf(p.y); }
                if (w1 > 0.f) { const uint2 p = *(const uint2*)(po + 128 + d0); o0 += w1 * lo_bf(p.x); o1 += w1 * hi_bf(p.x); o2 += w1 * lo_bf(p.y); o3 += w1 * hi_bf(p.y); }
                if (w2 > 0.f) { const uint2 p = *(const uint2*)(po + 256 + d0); o0 += w2 * lo_bf(p.x); o1 += w2 * hi_bf(p.x); o2 += w2 * lo_bf(p.y); o3 += w2 * hi_bf(p.y); }
                *(uint2*)(YB + tq * 1024 + h * 128 + d0) = make_uint2(pk_bf16(o0 * inv, o1 * inv), pk_bf16(o2 * inv, o3 * inv)); }
    }
    __syncthreads();
}

typedef const __attribute__((address_space(4))) MegaArgs* KArgs;
#define KP() ({ KArgs kp_ = kp0; asm volatile("" : "+s"(kp_)); kp_; })
__global__ void __launch_bounds__(512, 2) mega(MegaArgs a) {
    extern __shared__ __attribute__((aligned(16))) unsigned char lds_raw[];
    LAS unsigned char* lds = (LAS unsigned char*)lds_raw;
    volatile LAS unsigned* MISC = (volatile LAS unsigned*)(lds + LDS_MISC);
    for (int u = threadIdx.x; u < (LDS_BYTES - LDS_MISC) / 4; u += 512) ((LAS unsigned*)(lds + LDS_MISC))[u] = 0u;
    __syncthreads();
    const KArgs kp0 = (KArgs)__builtin_amdgcn_kernarg_segment_ptr();
    XcdBarrier bar = xcd_barrier_post((unsigned*)(a.ws + WS_CTL) + CW_BAR + a.li * XCD_BAR_WORDS, MISC + 8);
    const int G_ = (int)gridDim.x, c_ = (int)blockIdx.x;
#define IT(f) (KP()->items[it].f)
#define PH(k) (IT(p_lo) <= (k) && (k) < IT(p_hi))
    if (a.do_pro) { convert_range(kp0, lds, 0, CVT_PRO, c_, G_);
        phase_xinit(a.in[0], (float*)(a.ws + WS_X), (bf16*)(a.ws + WS_HN), (float*)(a.ws + WS_SCR + SC_SSQ)); xcd_barrier(bar); }
    for (int it = 0; it < kp0->n_items; ++it) {
        const int l = IT(l), hf = IT(hf), half = hf & 1;
        if (PH(1)) { KArgs kp = KP(); unsigned char* ws = kp->ws; unsigned char* lw = ws + WS_W + (size_t)l * LW_STRIDE;
            pg8::Gemm g{(const bf16*)(ws + WS_HN), (const bf16*)(lw + (half ? LW_GU2 : LW_GU1)), T_SEQ, NGU, DM}; pg8::StaticOrder S; S.init(T_SEQ, NGU, G_, c_);
            PG8_LAS float* tab = (PG8_LAS float*)(lds + LDS_MISC + 1024); int panel = -1; { pg8::Unit u0; if (S.next(0, u0)) { panel = u0.pm; pg8::rstd_table((const float*)(ws + WS_SCR + SC_SSQ), tab, panel, (int)threadIdx.x); } }
            pg8::EpiSwiGLU E{(bf16*)(ws + WS_HID), (const float*)(ws + WS_SCR + SC_SSQ), tab, DFF, panel}; pg8::gemm_phase<pg8::EpiSwiGLU, pg8::StaticOrder, true, true>(lds, g, S, E);
            { const int rem = ((T_SEQ / 256) * (NGU / 256)) % G_, q = 3 * l + (half ? 2 : 0), hi = cvt_slot_hi(q) < CVT_TOTAL ? cvt_slot_hi(q) : CVT_TOTAL;
              if (!(hf & 2) && rem && c_ >= rem && cvt_slot_lo(q) < hi) { KArgs kq = KP(); convert_range(kq, lds, cvt_slot_lo(q), hi, c_ - rem, G_ - rem); } }
            xcd_barrier(bar); }
        if (PH(2)) { KArgs kp = KP(); unsigned char* ws = kp->ws; unsigned char* lw = ws + WS_W + (size_t)l * LW_STRIDE;
            pg8::Gemm g{(const bf16*)(ws + WS_HID), (const bf16*)(lw + (half ? LW_D2 : LW_D1)), T_SEQ, DM, DFF}; pg8::StaticOrder S; S.init(T_SEQ, DM, G_, c_);
            pg8::EpiResAdd E{(float*)(ws + WS_X), (bf16*)(ws + WS_HN), (float*)(ws + WS_SCR + SC_SSQ), DM, (hf & 2) ? 0.f : 0.5f}; pg8::gemm_phase<pg8::EpiResAdd, pg8::StaticOrder, true, true>(lds, g, S, E); xcd_barrier(bar); }
        if (half == 0) {
            if (PH(4)) { KArgs kp = KP(); unsigned char* ws = kp->ws; unsigned char* lw = ws + WS_W + (size_t)l * LW_STRIDE;
                pg8::Gemm g{(const bf16*)(ws + WS_HN), (const bf16*)(lw + LW_IN), T_SEQ, NZP, DM}; pg8::ZOrder S; S.init(T_SEQ, NZP, G_, c_);
                PG8_LAS float* tab = (PG8_LAS float*)(lds + LDS_MISC + 1024); int panel = -1; { pg8::Unit u0; if (S.next(0, u0)) { panel = (u0.aux == 2) ? u0.pn : u0.pm; pg8::rstd_table((const float*)(ws + WS_SCR + SC_SSQ), tab, panel, (int)threadIdx.x); } }
                pg8::EpiZ E{(bf16*)(ws + WS_Z), (float*)(ws + WS_G), (bf16*)(ws + WS_ZT), (const float*)(ws + WS_SCR + SC_SSQ), tab, NZ, T_SEQ, panel, 0}; pg8::gemm_phase<pg8::EpiZ, pg8::ZOrder, true, true>(lds, g, S, E);
                { const int rem = ((T_SEQ / 256) * (NZP / 256)) % G_, q = 3 * l + 1, hi = cvt_slot_hi(q) < CVT_TOTAL ? cvt_slot_hi(q) : CVT_TOTAL;
                  if (!(hf & 2) && rem && c_ >= rem && cvt_slot_lo(q) < hi) { KArgs kq = KP(); convert_range(kq, lds, cvt_slot_lo(q), hi, c_ - rem, G_ - rem); } }
                xcd_barrier(bar); }
            if (PH(5)) {
#if MIX_MOBA
                { KArgs kp = KP(); unsigned char* ws = kp->ws; moba_kmean((const bf16*)(ws + WS_Z), (float*)(ws + WS_SCR + SC_KM)); }
#endif
#if MIX_ML
                { KArgs kp = KP(); unsigned char* ws = kp->ws; ml_ktrans((const bf16*)(ws + WS_Z), (bf16*)(ws + WS_SCR + SC_AKT), lds); }
#endif
#if MIX_LRU
                { KArgs kp = KP(); unsigned char* ws = kp->ws; unsigned char* lw = ws + WS_W + (size_t)l * LW_STRIDE;
                  lru_pass<1>((const bf16*)(ws + WS_Z), (const bf16*)(lw + LW_LRU), kp->in[10] + (size_t)l * 4096, kp->in[11] + (size_t)l * 1024, kp->in[13] + (size_t)l * 1024, kp->in[15] + (size_t)l * 1024, kp->in[16] + (size_t)l * 1024,
                              (float2*)(ws + WS_SCR + SC_CARRY), (bf16*)(ws + WS_YC), lds); }
#endif
                xcd_barrier(bar); }
            if (PH(6)) {
#if MIX_MOBA
                { KArgs kp = KP(); unsigned char* ws = kp->ws; unsigned char* sc = ws + WS_SCR; moba_select((const bf16*)(ws + WS_Z), (const float*)(sc + SC_KM), (unsigned*)(sc + SC_SEL), (float*)(sc + SC_PLSE), lds); }
#endif
#if MIX_ML
                { KArgs kp = KP(); unsigned char* ws = kp->ws; unsigned char* sc = ws + WS_SCR;
                  ml_local((const bf16*)(ws + WS_ZT), (const bf16*)(sc + SC_AKT), (const float*)(ws + WS_G), kp->in[7] + l * 4, kp->in[8] + l * 4, (float*)(sc + SC_LST), (float*)(sc + SC_NL), (float2*)(sc + SC_BG), lds); }
#endif
#if MIX_LRU
                { KArgs kp = KP(); unsigned char* ws = kp->ws; unsigned char* lw = ws + WS_W + (size_t)l * LW_STRIDE;
                  lru_pass<2>((const bf16*)(ws + WS_Z), (const bf16*)(lw + LW_LRU), kp->in[10] + (size_t)l * 4096, kp->in[11] + (size_t)l * 1024, kp->in[13] + (size_t)l * 1024, kp->in[15] + (size_t)l * 1024, kp->in[16] + (size_t)l * 1024,
                              (float2*)(ws + WS_SCR + SC_CARRY), (bf16*)(ws + WS_YC), lds); }
#endif
                xcd_barrier(bar); }
            if (PH(7)) {
#if MIX_MOBA
                { KArgs kp = KP(); unsigned char* ws = kp->ws; unsigned char* sc = ws + WS_SCR; moba_gather((const bf16*)(ws + WS_Z), (const bf16*)(ws + WS_ZT), (const unsigned*)(sc + SC_SEL), (bf16*)(sc + SC_PO), (float*)(sc + SC_PLSE), (unsigned*)(ws + WS_CTL) + CW_Q + it, lds); }
#endif
#if MIX_ML
                { KArgs kp = KP(); unsigned char* sc = kp->ws + WS_SCR;
                  ml_scan((const float*)(sc + SC_LST), (const float*)(sc + SC_NL), (const float2*)(sc + SC_BG), (bf16*)(sc + SC_CST), (float*)(sc + SC_NST), (float*)(sc + SC_MST)); }
#endif
                xcd_barrier(bar); }
            if (PH(8)) {
#if MIX_MOBA
                { KArgs kp = KP(); unsigned char* ws = kp->ws; unsigned char* sc = ws + WS_SCR; moba_own((const bf16*)(ws + WS_Z), (const bf16*)(ws + WS_ZT), (const bf16*)(sc + SC_PO), (const float*)(sc + SC_PLSE), (bf16*)(ws + WS_YB), lds); }
#endif
#if MIX_ML
                { KArgs kp = KP(); unsigned char* ws = kp->ws; unsigned char* sc = ws + WS_SCR;
                  ml_out((const bf16*)(ws + WS_Z), (const bf16*)(ws + WS_ZT), (const float*)(ws + WS_G), kp->in[7] + l * 4, kp->in[8] + l * 4, (const bf16*)(sc + SC_CST), (const float*)(sc + SC_NST), (const float*)(sc + SC_MST),
                         kp->in[9] + (size_t)l * 1024, (bf16*)(ws + WS_YA), lds); }
#endif
                xcd_barrier(bar); }
            if (PH(9)) { KArgs kp = KP(); unsigned char* ws = kp->ws; unsigned char* lw = ws + WS_W + (size_t)l * LW_STRIDE;
                pg8::Gemm g{(const bf16*)(ws + WS_YA), (const bf16*)(lw + LW_UPA), T_SEQ, DM, 1024}; pg8::MergeOrder S; S.init(T_SEQ, DM, G_, c_); S.astride = SZ_Y / 2; S.bstride = SZ_WUP / 2;
                pg8::EpiMerge E{(bf16*)(ws + WS_MG), (const bf16*)(ws + WS_Z) + Z_GA, DM, NZ, 2048, 0}; pg8::gemm_phase<pg8::EpiMerge, pg8::MergeOrder, true, true>(lds, g, S, E); xcd_barrier(bar); }
            if (PH(10)) { KArgs kp = KP(); unsigned char* ws = kp->ws; unsigned char* lw = ws + WS_W + (size_t)l * LW_STRIDE;
                pg8::Gemm g{(const bf16*)(ws + WS_MG), (const bf16*)(lw + LW_OUT), T_SEQ, DM, DM}; pg8::StaticOrder S; S.init(T_SEQ, DM, G_, c_);
                pg8::EpiResAdd E{(float*)(ws + WS_X), (bf16*)(ws + WS_HN), (float*)(ws + WS_SCR + SC_SSQ), DM, (hf & 2) ? 0.f : 1.0f}; pg8::gemm_phase<pg8::EpiResAdd, pg8::StaticOrder, true, true>(lds, g, S, E); xcd_barrier(bar); }
        }
    }
    if (a.do_fin) phase_final((const bf16*)(a.ws + WS_HN), a.in[25], a.out);
#undef PH
#undef IT
}
extern "C" void kernel_launch(void* const* d_in, const int* in_sizes, int n_in, void* d_out, int out_size, void* d_ws, size_t ws_size, hipStream_t stream) {
    if (n_in != 26 || out_size != T_SEQ * DM || ws_size < WS_END) { fprintf(stderr, "kernel_launch: unexpected problem (n_in %d out %d ws %zu need %zu)\n", n_in, out_size, ws_size, (size_t)WS_END); return; }
    static int grid = 0;
    if (!grid) { int dev = 0, cus = 0, per_cu = 0; (void)hipGetDevice(&dev); (void)hipDeviceGetAttribute(&cus, hipDeviceAttributeMultiprocessorCount, dev);
        (void)hipFuncSetAttribute((const void*)mega, hipFuncAttributeMaxDynamicSharedMemorySize, LDS_BYTES);
        if (hipOccupancyMaxActiveBlocksPerMultiprocessor(&per_cu, (const void*)mega, 512, LDS_BYTES) != hipSuccess || per_cu < 1) fprintf(stderr, "kernel_launch: occupancy query reports %d blocks per CU\n", per_cu);
        (void)hipGetLastError();
        grid = 256; if (cus != 256) fprintf(stderr, "kernel_launch: built for 256 CUs (one workgroup per CU), device reports %d\n", cus); }
    unsigned char* ws = (unsigned char*)d_ws;
    (void)hipMemsetAsync(ws + WS_CTL, 0, CTL_BYTES, stream);
    MegaArgs a; memset(&a, 0, sizeof a); for (int i = 0; i < 26; ++i) a.in[i] = (const float*)d_in[i]; a.out = (float*)d_out; a.ws = ws;
    a.do_pro = 1; a.do_fin = 1; a.li = 0; int n = 0;
    for (int l = 0; l < NLAYER; ++l) {
        a.items[n++] = PItem{l, 0, 0, 11};
#ifdef DUP_LO
        a.items[n++] = PItem{l, 2 | DUP_HF, DUP_LO, DUP_HI};
#endif
        a.items[n++] = PItem{l, 1, 0, 11}; }
    a.n_items = n;
    hipLaunchKernelGGL(mega, dim3(grid), dim3(512), LDS_BYTES, stream, a);
}
```

```cpp
#include <hip/hip_runtime.h>
#include <cstdio>
#include <cstdint>
#include <cstring>
#define LAS __attribute__((address_space(3)))
typedef unsigned short bf16;
constexpr int T_SEQ = 8192, DM = 2048, DFF = 5504, NLAYER = 4;
constexpr int NGU = 2 * DFF;
constexpr int NZ = 13312;
constexpr int NZP = 15616;
constexpr int NZT = 2048;
constexpr int Z_AQ = 0, Z_AK = 1024, Z_AO = 2048, Z_BQ = 3072, Z_BK = 4096, Z_CX = 5120, Z_CG = 6144, Z_GA = 7168, Z_GB = 9216, Z_GC = 11264;
constexpr int ZT_AV = 0, ZT_BV = 1024;
constexpr float RMS_EPS = 1e-6f;
__device__ __forceinline__ float bf2f(unsigned short b) { return __uint_as_float(((unsigned)b) << 16); }
__device__ __forceinline__ unsigned short f2bf(float f) { unsigned u = __float_as_uint(f); return (unsigned short)((u + 0x7fffu + ((u >> 16) & 1u)) >> 16); }
__device__ __forceinline__ float sigmoidf_(float x) { return 1.f / (1.f + __expf(-x)); }
__device__ __forceinline__ float lo_bf(unsigned w) { return __uint_as_float(w << 16); }
__device__ __forceinline__ float hi_bf(unsigned w) { return __uint_as_float(w & 0xffff0000u); }
__device__ __forceinline__ int win_src_col(int n) {
    if (n < 2048) return n;
    if (n < 3072) return 3072 + (n - 2048);
    if (n < 5120) return n + 1032;
    if (n < 13312) return n + 2056;
    if (n < 13320) return 4096 + (n - 13312);
    if (n < 13568) return -1;
    if (n < 14592) return 2048 + (n - 13568);
    return 6152 + (n - 14592);
}
#define MIX_LRU 1
#define MIX_ML 1
#define MIX_MOBA 1
namespace pg8 {
#define PG8_LAS __attribute__((address_space(3)))
typedef unsigned short bf16_t;
typedef short bf16x8 __attribute__((ext_vector_type(8)));
typedef float f32x4 __attribute__((ext_vector_type(4)));
typedef unsigned u32x4 __attribute__((ext_vector_type(4)));
constexpr int BM = 256, BK = 64, HALF = 128, HTB = HALF * BK * 2  , STAGE_BYTES = 8 * HTB, NXCD = 8, WGM = 8;

__host__ __device__ __forceinline__ int lds_byte(int r, int c) { const int st = (r >> 4) * 2 + (c >> 5), rr = r & 15, cc = c & 31, ob = rr * 64 + cc * 2; return st * 1024 + (ob ^ (((ob >> 9) & 1) << 5)); }
__host__ __device__ __forceinline__ void stage_rc(int b, int& R, int& C) { const int st = b / 1024, sb = b % 1024, swz = sb ^ (((sb >> 9) & 1) << 5); R = (st >> 1) * 16 + swz / 64; C = (st & 1) * 32 + (swz % 64) / 2; }
__host__ __device__ __forceinline__ int perm32(int rho) { const int n = rho >> 4, i = rho & 15; return 8 * (i >> 2) + 4 * n + (i & 3); }

struct Unit { int pm, pn, aux; };
struct Gemm { const bf16_t* A; const bf16_t* Bt; int M, N, K; };

struct StaticOrder {
    int nM, nN, nwg, G, c;
    __host__ __device__ void init(int M, int N, int G_, int c_) { nM = M / BM; nN = N / BM; nwg = nM * nN; G = G_; c = c_; }
    __host__ __device__ __forceinline__ bool next(int i, Unit& u) const {
        const long L = (long)i * G + c; if (L >= nwg) return false;
        int wgid = (int)L; { const int q = nwg / NXCD, r = nwg % NXCD, xcd = wgid % NXCD, off = wgid / NXCD; wgid = (xcd < r ? xcd * (q + 1) : r * (q + 1) + (xcd - r) * q) + off; }
        const int nig = WGM * nN, gid = wgid / nig, fm = gid * WGM, gsz = (nM - fm) < WGM ? (nM - fm) : WGM;
        u.pm = fm + ((wgid % nig) % gsz); u.pn = (wgid % nig) / gsz; u.aux = 0; return true;
    }
    __device__ __forceinline__ void bases(const Gemm& g, const Unit& u, size_t tstep, const char*& a, const char*& b) const { a = (const char*)g.A + (size_t)u.pm * tstep; b = (const char*)g.Bt + (size_t)u.pn * tstep; }
    __device__ __forceinline__ void a_ready(const Unit&) const {}
    __device__ __forceinline__ void done(const Unit&) const {}
};
__device__ __forceinline__ unsigned cvt_pk_bf16(float lo, float hi) { unsigned r; asm volatile("v_cvt_pk_bf16_f32 %0, %1, %2" : "=v"(r) : "v"(lo), "v"(hi)); return r; }
typedef float f32x2 __attribute__((ext_vector_type(2)));
typedef unsigned u32x2 __attribute__((ext_vector_type(2)));
__device__ __forceinline__ float fast_sigmoid(float x) { return __builtin_amdgcn_rcpf(1.f + __expf(-x)); }
__device__ __forceinline__ void row_rstd8(const PG8_LAS float* tab, int rloc, float (&rs)[2][4]) {
#pragma unroll
    for (int ai = 0; ai < 2; ++ai)
#pragma unroll
        for (int m = 0; m < 4; ++m) rs[ai][m] = tab[rloc + ai * HALF + m * 16];
}
__device__ __forceinline__ void rstd_table(const float* SSQ, PG8_LAS float* tab, int panel, int tid) {
    asm volatile("" : "+v"(tid));
    const float* p = SSQ + ((size_t)panel * BM + (tid >> 1)) * 32 + (tid & 1) * 16; float t = 0.f;
#pragma unroll
    for (int q = 0; q < 4; ++q) { const f32x4 a = *(const f32x4*)(p + 4 * q); t += (a[0] + a[1]) + (a[2] + a[3]); }
    t += __shfl_xor(t, 1);
    if ((tid & 1) == 0) tab[tid >> 1] = __builtin_amdgcn_rsqf(t * (1.f / 2048.f) + 1e-6f);
    asm volatile("s_waitcnt lgkmcnt(0)" ::: "memory"); __builtin_amdgcn_s_barrier(); asm volatile("" ::: "memory");
}
struct EpiSwiGLU {
    static constexpr bool PERM = true, AFTER_DRAIN = false;
    bf16_t* O; const float* SSQ; const PG8_LAS float* tab; int ldc; int panel;
    __device__ __forceinline__ void operator()(const f32x4 (&acc)[2][2][4][2], const Unit& u, int wr, int wc, int fr, int fq) const {
        const int row0 = u.pm * BM + wr * 64 + fr, col0 = u.pn * HALF + wc * 32 + 8 * fq;
        float rs[2][4]; row_rstd8(tab, wr * 64 + fr, rs);
#pragma unroll
        for (int ai = 0; ai < 2; ++ai)
#pragma unroll
            for (int m = 0; m < 4; ++m) { bf16_t* rowp = O + (size_t)(row0 + ai * HALF + m * 16) * ldc + col0;
                const f32x2 r2 = (f32x2){rs[ai][m], rs[ai][m]}; f32x2 h2[4];
#pragma unroll
                for (int n = 0; n < 2; ++n)
#pragma unroll
                    for (int q = 0; q < 2; ++q) { const f32x2 g = (f32x2){acc[ai][0][m][n][2 * q], acc[ai][0][m][n][2 * q + 1]} * r2, up = (f32x2){acc[ai][1][m][n][2 * q], acc[ai][1][m][n][2 * q + 1]} * r2;
                        const f32x2 t = g * (-1.4426950408889634f); f32x2 d; d.x = __builtin_amdgcn_exp2f(t.x); d.y = __builtin_amdgcn_exp2f(t.y); d = d + 1.0f;
                        f32x2 rc; rc.x = __builtin_amdgcn_rcpf(d.x); rc.y = __builtin_amdgcn_rcpf(d.y); h2[n * 2 + q] = (g * up) * rc; }
                u32x4 w; w.x = cvt_pk_bf16(h2[0].x, h2[0].y); w.y = cvt_pk_bf16(h2[1].x, h2[1].y); w.z = cvt_pk_bf16(h2[2].x, h2[2].y); w.w = cvt_pk_bf16(h2[3].x, h2[3].y);
                *(u32x4*)rowp = w; }
    }
};
struct EpiResAdd {
    static constexpr bool PERM = false, AFTER_DRAIN = false;
    float* X; bf16_t* XB; float* SSQ; int ldc; float alpha;
    __device__ __forceinline__ void operator()(const f32x4 (&acc)[2][2][4][2], const Unit& u, int wr, int wc, int fr, int fq) const {
        const int row0 = u.pm * BM + wr * 64 + fr, col0 = u.pn * BM + wc * 32 + 4 * fq;
        u32x2 xv[3][4];
#define RA_LOAD(rg, b) do { const bf16_t* rp_ = XB + (size_t)(row0 + ((rg) >> 2) * HALF + ((rg) & 3) * 16) * ldc + col0; \
            xv[b][0] = *(const u32x2*)(rp_); xv[b][1] = *(const u32x2*)(rp_ + 16); xv[b][2] = *(const u32x2*)(rp_ + HALF); xv[b][3] = *(const u32x2*)(rp_ + HALF + 16); } while (0)
        RA_LOAD(0, 0); RA_LOAD(1, 1);
#pragma unroll
        for (int rg = 0; rg < 8; ++rg) { const int ai = rg >> 2, m = rg & 3;
            if (rg + 2 < 8) RA_LOAD(rg + 2, (rg + 2) % 3);
            const size_t row = (size_t)(row0 + ai * HALF + m * 16); bf16_t* rowb = XB + row * ldc + col0; float ss = 0.f;
#pragma unroll
            for (int bj = 0; bj < 2; ++bj)
#pragma unroll
                for (int n = 0; n < 2; ++n) { const u32x2 o = xv[rg % 3][bj * 2 + n]; const f32x4 p = acc[ai][bj][m][n] * alpha;
                    u32x2 w; w.x = cvt_pk_bf16(__uint_as_float(o.x << 16) + p[0], __uint_as_float(o.x & 0xffff0000u) + p[1]); w.y = cvt_pk_bf16(__uint_as_float(o.y << 16) + p[2], __uint_as_float(o.y & 0xffff0000u) + p[3]);
                    *(u32x2*)(rowb + bj * HALF + n * 16) = w;
                    const float r0 = __uint_as_float(w.x << 16), r1 = __uint_as_float(w.x & 0xffff0000u), r2 = __uint_as_float(w.y << 16), r3 = __uint_as_float(w.y & 0xffff0000u);
                    ss += (r0 * r0 + r1 * r1) + (r2 * r2 + r3 * r3); }
            ss += __shfl_xor(ss, 16); ss += __shfl_xor(ss, 32);
            if (fq == 0) SSQ[row * 32 + u.pn * 4 + wc] = ss; }
#undef RA_LOAD
    }
};
struct EpiZ {
    static constexpr bool PERM = true, AFTER_DRAIN = false;
    bf16_t* Z; float* G; bf16_t* ZT; const float* SSQ; const PG8_LAS float* tab; int ldz; int ldt; int panel; int pad;
    __device__ __forceinline__ void operator()(const f32x4 (&acc)[2][2][4][2], const Unit& u, int wr, int wc, int fr, int fq) const {
        const int row0 = u.pm * BM + wr * 64 + fr;
        if (u.aux == 0) {
            float rs[2][4]; row_rstd8(tab, wr * 64 + fr, rs);
            const int col0 = u.pn * BM + wc * 64 + 8 * fq;
#pragma unroll
            for (int ai = 0; ai < 2; ++ai)
#pragma unroll
                for (int m = 0; m < 4; ++m) { bf16_t* rowp = Z + (size_t)(row0 + ai * HALF + m * 16) * ldz + col0; const float r = rs[ai][m];
#pragma unroll
                    for (int bj = 0; bj < 2; ++bj) { const f32x4 v0 = acc[ai][bj][m][0] * r, v1 = acc[ai][bj][m][1] * r;
                        u32x4 w; w.x = cvt_pk_bf16(v0[0], v0[1]); w.y = cvt_pk_bf16(v0[2], v0[3]); w.z = cvt_pk_bf16(v1[0], v1[1]); w.w = cvt_pk_bf16(v1[2], v1[3]);
                        *(u32x4*)(rowp + bj * 32) = w; } }
        } else if (u.aux == 1) {
            float rs[2][4]; row_rstd8(tab, wr * 64 + fr, rs);
            if (wc == 0 && fq == 0) {
#pragma unroll
                for (int ai = 0; ai < 2; ++ai)
#pragma unroll
                    for (int m = 0; m < 4; ++m) { float* gp = G + (size_t)(row0 + ai * HALF + m * 16) * 8;
                        *(f32x4*)gp = acc[ai][0][m][0] * rs[ai][m]; *(f32x4*)(gp + 4) = acc[ai][0][m][1] * rs[ai][m]; } }
        } else {
            const int tb = u.pn * BM + wc * 32 + 8 * fq; float rt[16];
#pragma unroll
            for (int j = 0; j < 16; ++j) rt[j] = tab[wc * 32 + 8 * fq + 128 * (j >> 3) + (j & 7)];
            const int col0 = tb;
#pragma unroll
            for (int ai = 0; ai < 2; ++ai)
#pragma unroll
                for (int m = 0; m < 4; ++m) { bf16_t* rowp = ZT + (size_t)(row0 + ai * HALF + m * 16) * ldt + col0;
#pragma unroll
                    for (int bj = 0; bj < 2; ++bj) { const f32x4 v0 = acc[ai][bj][m][0], v1 = acc[ai][bj][m][1];
                        u32x4 w; w.x = cvt_pk_bf16(v0[0] * rt[8 * bj], v0[1] * rt[8 * bj + 1]); w.y = cvt_pk_bf16(v0[2] * rt[8 * bj + 2], v0[3] * rt[8 * bj + 3]);
                        w.z = cvt_pk_bf16(v1[0] * rt[8 * bj + 4], v1[1] * rt[8 * bj + 5]); w.w = cvt_pk_bf16(v1[2] * rt[8 * bj + 6], v1[3] * rt[8 * bj + 7]);
                        *(u32x4*)(rowp + bj * HALF) = w; } }
        }
    }
};
struct ZOrder : StaticOrder {
    __device__ __forceinline__ bool next(int i, Unit& u) const {
        if (!StaticOrder::next(i, u)) return false;
        const int v = u.pn;
        if (v < 52) u.aux = 0; else if (v == 52) u.aux = 1; else { u.aux = 2; u.pn = u.pm; u.pm = v - 53; }
        return true;
    }
    __device__ __forceinline__ void bases(const Gemm& g, const Unit& u, size_t tstep, const char*& a, const char*& b) const {
        if (u.aux == 2) { a = (const char*)g.Bt + (size_t)(53 + u.pm) * tstep; b = (const char*)g.A + (size_t)u.pn * tstep; }
        else { a = (const char*)g.A + (size_t)u.pm * tstep; b = (const char*)g.Bt + (size_t)u.pn * tstep; }
    }
};
struct EpiMerge {
    static constexpr bool PERM = true, AFTER_DRAIN = false;
    bf16_t* MG; const bf16_t* Zg; int ldm; int ldz; int gstride; int pad;
    __device__ __forceinline__ void operator()(const f32x4 (&acc)[2][2][4][2], const Unit& u, int wr, int wc, int fr, int fq) const {
        const int row0 = u.pm * BM + wr * 64 + fr, col0 = u.pn * BM + wc * 32 + 8 * fq; const bool first = (u.aux == 0); const bf16_t* zg = Zg + (size_t)u.aux * gstride;
        u32x4 gzb[3], odb[3];
#define MG_LOAD(st, b) do { const size_t r_ = (size_t)(row0 + ((st) >> 3) * HALF + (((st) >> 1) & 3) * 16); const int c_ = col0 + ((st) & 1) * HALF; \
            gzb[b] = *(const u32x4*)(zg + r_ * ldz + c_); odb[b] = (u32x4){0u, 0u, 0u, 0u}; if (!first) odb[b] = *(const u32x4*)(MG + r_ * ldm + c_); } while (0)
        MG_LOAD(0, 0); MG_LOAD(1, 1);
#pragma unroll
        for (int st = 0; st < 16; ++st) { const int ai = st >> 3, m = (st >> 1) & 3, bj = st & 1;
            if (st + 2 < 16) MG_LOAD(st + 2, (st + 2) % 3);
            const size_t r = (size_t)(row0 + ai * HALF + m * 16); const int c = col0 + bj * HALF;
            const u32x4 gz = gzb[st % 3], old = odb[st % 3];
            float o[8];
#pragma unroll
            for (int j = 0; j < 4; ++j) { const unsigned gw = gz[j], ow = old[j];
                const float g0 = __uint_as_float(gw << 16), g1 = __uint_as_float(gw & 0xffff0000u), o0 = __uint_as_float(ow << 16), o1 = __uint_as_float(ow & 0xffff0000u);
                const float a0 = acc[ai][bj][m][j >> 1][(j & 1) * 2], a1 = acc[ai][bj][m][j >> 1][(j & 1) * 2 + 1];
                o[2 * j] = o0 + fast_sigmoid(g0) * a0; o[2 * j + 1] = o1 + fast_sigmoid(g1) * a1; }
            u32x4 w; w.x = cvt_pk_bf16(o[0], o[1]); w.y = cvt_pk_bf16(o[2], o[3]); w.z = cvt_pk_bf16(o[4], o[5]); w.w = cvt_pk_bf16(o[6], o[7]);
            *(u32x4*)(MG + r * ldm + c) = w; }
#undef MG_LOAD
    }
};
struct MergeOrder : StaticOrder {
    size_t astride, bstride;
    __device__ __forceinline__ bool next(int i, Unit& u) const { if (!StaticOrder::next(i / 3, u)) return false; u.aux = i % 3; return true; }
    __device__ __forceinline__ void bases(const Gemm& g, const Unit& u, size_t tstep, const char*& a, const char*& b) const {
        a = (const char*)(g.A + (size_t)u.aux * astride) + (size_t)u.pm * tstep; b = (const char*)(g.Bt + (size_t)u.aux * bstride) + (size_t)u.pn * tstep; }
};
template <class Epi, class Sched, bool ALIGN_EPI = false, bool SP2 = false>
__device__ __forceinline__ void gemm_phase(PG8_LAS unsigned char* lds, const Gemm g, const Sched& S, const Epi& E) {
    int tid_ = threadIdx.x; asm volatile("" : "+v"(tid_));
    const int tid = tid_, wid = __builtin_amdgcn_readfirstlane(tid >> 6), lane = tid & 63, wr = wid >> 2, wc = wid & 3, fr = lane & 15, fq = lane >> 4;
    const int K = g.K, nt = K / BK;
    unsigned voffA[2], voffB[2];
#pragma unroll
    for (int i = 0; i < 2; ++i) { int R, C; stage_rc(tid * 16 + i * 8192, R, C); const int Rb = Epi::PERM ? ((R & ~31) + perm32(R & 31)) : R;
        voffA[i] = (unsigned)(R * K + C) * 2u; voffB[i] = (unsigned)(Rb * K + C) * 2u; }
    const size_t kstep = (size_t)(BK * 2);
    const size_t hstep = (size_t)HALF * K * 2;
    const size_t tstep = 2 * hstep;
    const unsigned ldsw = (unsigned)wid * 1024u;
    const int aoff = lds_byte(wr * 64 + fr, fq * 8), boff = lds_byte(wc * 32 + fr, fq * 8);
#define PG8_SA(b, h) (((b) * 2 + (h)) * HTB)
#define PG8_SB(b, h) ((4 + (b) * 2 + (h)) * HTB)
#define PG8_STAGE(bufoff, gbase, voff) do { _Pragma("unroll") for (int _i = 0; _i < 2; ++_i) \
        __builtin_amdgcn_global_load_lds((const unsigned*)((const char*)(gbase) + (voff)[_i]), (PG8_LAS unsigned*)(lds + (bufoff) + ldsw + _i * 8192), 16, 0, 0); } while (0)
#define PG8_LDA(dst, b, h) do { _Pragma("unroll") for (int m = 0; m < 4; ++m) _Pragma("unroll") for (int k = 0; k < 2; ++k) dst[m][k] = *(const PG8_LAS bf16x8*)(lds + PG8_SA(b, h) + aoff + m * 2048 + k * 1024); } while (0)
#define PG8_LDB(dst, b, h) do { _Pragma("unroll") for (int n = 0; n < 2; ++n) _Pragma("unroll") for (int k = 0; k < 2; ++k) dst[n][k] = *(const PG8_LAS bf16x8*)(lds + PG8_SB(b, h) + boff + n * 2048 + k * 1024); } while (0)
#define PG8_MMA(ai, bj, At, Bt) do { __builtin_amdgcn_s_setprio(1); _Pragma("unroll") for (int m = 0; m < 4; ++m) _Pragma("unroll") for (int n = 0; n < 2; ++n) _Pragma("unroll") for (int k = 0; k < 2; ++k) \
        acc[ai][bj][m][n] = __builtin_amdgcn_mfma_f32_16x16x32_bf16(Bt[n][k], At[m][k], acc[ai][bj][m][n], 0, 0, 0); __builtin_amdgcn_s_setprio(0); } while (0)
#define PG8_WAIT_V(n) asm volatile("s_waitcnt vmcnt(" #n ")" ::: "memory")
#define PG8_WAIT_L(n) asm volatile("s_waitcnt lgkmcnt(" #n ")" ::: "memory")
#define PG8_BAR __builtin_amdgcn_s_barrier()
#define PG8_SCHED __builtin_amdgcn_sched_barrier(0)
    Unit cur, nxt; int ui = 0;
    if (!S.next(0, cur)) return;
    f32x4 acc[2][2][4][2];
#pragma unroll
    for (int a = 0; a < 2; ++a)
#pragma unroll
        for (int b = 0; b < 2; ++b)
#pragma unroll
            for (int m = 0; m < 4; ++m)
#pragma unroll
                for (int n = 0; n < 2; ++n) acc[a][b][m][n] = (f32x4){0.f, 0.f, 0.f, 0.f};
    bf16x8 At[4][2], B0[2][2], B1[2][2];
    const char* cA; const char* cB; S.bases(g, cur, tstep, cA, cB);
    S.a_ready(cur);
    if constexpr (SP2) {
        PG8_STAGE(PG8_SB(0, 0), cB, voffB); PG8_STAGE(PG8_SB(0, 1), cB + hstep, voffB); PG8_STAGE(PG8_SA(0, 0), cA, voffA); PG8_STAGE(PG8_SA(0, 1), cA + hstep, voffA);
        if (wr == 1) PG8_BAR;
        PG8_WAIT_V(2); PG8_BAR;
        PG8_STAGE(PG8_SB(1, 0), cB + kstep, voffB); PG8_STAGE(PG8_SA(1, 0), cA + kstep, voffA); PG8_STAGE(PG8_SB(1, 1), cB + hstep + kstep, voffB);
        PG8_WAIT_V(6); PG8_BAR;
    } else {
        PG8_STAGE(PG8_SB(0, 0), cB, voffB); PG8_STAGE(PG8_SA(0, 0), cA, voffA); PG8_STAGE(PG8_SB(0, 1), cB + hstep, voffB); PG8_STAGE(PG8_SA(0, 1), cA + hstep, voffA);
        if (wr == 1) PG8_BAR;
        PG8_WAIT_V(4); PG8_BAR;
        PG8_STAGE(PG8_SB(1, 0), cB + kstep, voffB); PG8_STAGE(PG8_SA(1, 0), cA + kstep, voffA); PG8_STAGE(PG8_SB(1, 1), cB + hstep + kstep, voffB);
        PG8_WAIT_V(6); PG8_BAR;
    }
    for (;;) {
        const bool has_next = S.next(ui + 1, nxt);
        const char* nA = cA; const char* nB = cB; if (has_next) S.bases(g, nxt, tstep, nA, nB);
        for (int t = 0; t < nt; t += 2) {
            const bool last = (t == nt - 2);
            const char* a1 = cA + (size_t)(t + 1) * kstep;
            const char* a2 = last ? nA : cA + (size_t)(t + 2) * kstep; const char* b2 = last ? nB : cB + (size_t)(t + 2) * kstep;
            const char* a3 = a2 + kstep; const char* b3 = b2 + kstep;
            if (last && has_next) S.a_ready(nxt);
            if constexpr (SP2) {
            PG8_LDB(B0, 0, 0); PG8_LDB(B1, 0, 1); PG8_SCHED; PG8_LDA(At, 0, 0); PG8_STAGE(PG8_SA(1, 1), a1 + hstep, voffA);
            PG8_WAIT_V(8); PG8_WAIT_L(0); PG8_BAR; PG8_MMA(0, 0, At, B0); PG8_MMA(0, 1, At, B1); PG8_BAR; PG8_SCHED;
            PG8_LDA(At, 0, 1); PG8_STAGE(PG8_SB(0, 0), b2, voffB); PG8_STAGE(PG8_SB(0, 1), b2 + hstep, voffB); PG8_STAGE(PG8_SA(0, 0), a2, voffA);
            PG8_WAIT_V(8); PG8_WAIT_L(0); PG8_BAR; PG8_MMA(1, 0, At, B0); PG8_MMA(1, 1, At, B1); PG8_BAR; PG8_SCHED;
            PG8_LDB(B0, 1, 0); PG8_LDB(B1, 1, 1); PG8_SCHED; PG8_LDA(At, 1, 0); PG8_STAGE(PG8_SA(0, 1), a2 + hstep, voffA);
            PG8_WAIT_V(8); PG8_WAIT_L(0); PG8_BAR; PG8_MMA(0, 0, At, B0); PG8_MMA(0, 1, At, B1); PG8_BAR; PG8_SCHED;
            PG8_LDA(At, 1, 1); PG8_STAGE(PG8_SB(1, 0), b3, voffB); PG8_STAGE(PG8_SB(1, 1), b3 + hstep, voffB); PG8_STAGE(PG8_SA(1, 0), a3, voffA);
            PG8_WAIT_V(8); PG8_WAIT_L(0); PG8_BAR; PG8_MMA(1, 0, At, B0); PG8_MMA(1, 1, At, B1); PG8_BAR; PG8_SCHED;
            } else {
            PG8_LDB(B0, 0, 0); PG8_SCHED; PG8_LDA(At, 0, 0); PG8_STAGE(PG8_SA(1, 1), a1 + hstep, voffA);
            PG8_WAIT_L(8); PG8_BAR; PG8_WAIT_L(0); PG8_MMA(0, 0, At, B0); PG8_BAR; PG8_SCHED;
            PG8_LDB(B1, 0, 1); PG8_STAGE(PG8_SB(0, 0), b2, voffB);
            PG8_BAR; PG8_WAIT_L(0); PG8_MMA(0, 1, At, B1); PG8_BAR;
            PG8_LDA(At, 0, 1); PG8_STAGE(PG8_SA(0, 0), a2, voffA);
            PG8_BAR; PG8_WAIT_L(0); PG8_MMA(1, 0, At, B0); PG8_BAR; PG8_SCHED;
            PG8_STAGE(PG8_SB(0, 1), b2 + hstep, voffB);
            PG8_WAIT_V(6); PG8_BAR; PG8_MMA(1, 1, At, B1); PG8_BAR;
            PG8_LDB(B0, 1, 0); PG8_SCHED; PG8_LDA(At, 1, 0); PG8_STAGE(PG8_SA(0, 1), a2 + hstep, voffA);
            PG8_WAIT_L(8); PG8_BAR; PG8_WAIT_L(0); PG8_MMA(0, 0, At, B0); PG8_BAR; PG8_SCHED;
            PG8_LDB(B1, 1, 1); PG8_STAGE(PG8_SB(1, 0), b3, voffB);
            PG8_BAR; PG8_WAIT_L(0); PG8_MMA(0, 1, At, B1); PG8_BAR;
            PG8_LDA(At, 1, 1); PG8_STAGE(PG8_SA(1, 0), a3, voffA);
            PG8_BAR; PG8_WAIT_L(0); PG8_MMA(1, 0, At, B0); PG8_BAR; PG8_SCHED;
            PG8_STAGE(PG8_SB(1, 1), b3 + hstep, voffB);
            PG8_WAIT_V(6); PG8_BAR; PG8_MMA(1, 1, At, B1); PG8_BAR;
            }
        }
        if constexpr (ALIGN_EPI) { if (wr == 0) PG8_BAR; }
        if constexpr (!Epi::AFTER_DRAIN) { E(acc, cur, wr, wc, fr, fq); S.done(cur); }
        if (!has_next) break;
#pragma unroll
        for (int a = 0; a < 2; ++a)
#pragma unroll
            for (int b = 0; b < 2; ++b)
#pragma unroll
                for (int m = 0; m < 4; ++m)
#pragma unroll
                    for (int n = 0; n < 2; ++n) acc[a][b][m][n] = (f32x4){0.f, 0.f, 0.f, 0.f};
        cur = nxt; cA = nA; cB = nB; ++ui;
        if constexpr (ALIGN_EPI) { if (wr == 1) PG8_BAR; }
    }
    PG8_WAIT_V(0);
    if constexpr (!ALIGN_EPI) { if (wr == 0) PG8_BAR; }
    PG8_BAR;
    if constexpr (Epi::AFTER_DRAIN) { E.fused(acc, cur, wr, wc, fr, fq, lds, wid, lane); S.done(cur); }
#undef PG8_SA
#undef PG8_SB
#undef PG8_STAGE
#undef PG8_LDA
#undef PG8_LDB
#undef PG8_MMA
#undef PG8_WAIT_V
#undef PG8_WAIT_L
#undef PG8_BAR
#undef PG8_SCHED
}
}
#define XB_TMO      128
#define XB_XCNT(j)  (256  + 64 * (j))
#define XB_XSUB(j)  (1280 + 64 * (j))
#define XB_XGEN(j)  (2304 + 64 * (j))
#define XB_TOP      3328
#define XB_TOPGEN   3392
#define XCD_BAR_WORDS 3456
#define XB_SPIN_CAP (1u << 18)

__device__ __forceinline__ unsigned xb_ld(unsigned* p)              { return __hip_atomic_load(p, __ATOMIC_RELAXED, __HIP_MEMORY_SCOPE_AGENT); }
__device__ __forceinline__ unsigned xb_add(unsigned* p, unsigned v) { return __hip_atomic_fetch_add(p, v, __ATOMIC_RELAXED, __HIP_MEMORY_SCOPE_AGENT); }
__device__ __forceinline__ unsigned xb_xcc_id() { return (unsigned)__builtin_amdgcn_s_getreg((3 << 11) | 20) & 0xFu; }
#define XB_SPIN(cond, bar) do { unsigned _sp = 0; while (cond) { __builtin_amdgcn_s_sleep(1); \
    if ((++_sp & 255u) == 0u) { if (xb_ld(&(bar)[XB_TMO])) break; if (_sp > XB_SPIN_CAP) { atomicAdd(&(bar)[XB_TMO], 1u); break; } } } } while (0)

struct XcdBarrier {
    unsigned* bar; unsigned x;
    volatile LAS unsigned* st;
};

__device__ __forceinline__ XcdBarrier xcd_barrier_post(unsigned* bar, volatile LAS unsigned* st) {
    XcdBarrier b; b.bar = bar; b.x = xb_xcc_id(); b.st = st;
    if (threadIdx.x == 0) (void)xb_add(&bar[XB_XCNT(b.x)], 1u);
    return b;
}
__device__ __forceinline__ void xcd_barrier_complete(unsigned* bar, unsigned x, unsigned& nloc, unsigned& nx) {
    const unsigned G = gridDim.x * gridDim.y * gridDim.z;
    unsigned sum, cnt, mine, sp = 0u;
    for (;;) {
        sum = 0u; cnt = 0u; mine = 0u;
#pragma unroll
        for (unsigned j = 0; j < 16; ++j) { const unsigned c = xb_ld(&bar[XB_XCNT(j)]); sum += c; cnt += (c > 0u) ? 1u : 0u; mine = (j == x) ? c : mine; }
        if (sum == G) break;
        __builtin_amdgcn_s_sleep(1);
        if ((++sp & 255u) == 0u) { if (xb_ld(&bar[XB_TMO])) break; if (sp > XB_SPIN_CAP) { atomicAdd(&bar[XB_TMO], 1u); break; } }
    }
    nloc = mine > 0u ? mine : 1u; nx = cnt > 0u ? cnt : 1u;
}

__device__ __forceinline__ void xcd_barrier(const XcdBarrier& b) {
    asm volatile("s_waitcnt vmcnt(0)" ::: "memory");
    __syncthreads();
    if (threadIdx.x == 0) {
        unsigned* bar = b.bar;
        __builtin_amdgcn_s_waitcnt(0);
        unsigned nloc = b.st[0], nx = b.st[1];
        if (nloc == 0u) { xcd_barrier_complete(bar, b.x, nloc, nx); b.st[0] = nloc; b.st[1] = nx; }
        const unsigned old = xb_add(&bar[XB_XSUB(b.x)], 1u);
        const unsigned gen = old / nloc;
        if (old + 1u == (gen + 1u) * nloc) {
            __builtin_amdgcn_fence(__ATOMIC_RELEASE, "agent");
            asm volatile("s_waitcnt vmcnt(0)" ::: "memory");
            const unsigned og = xb_add(&bar[XB_TOP], 1u);
            const unsigned tg = og / nx;
            if (og + 1u == (tg + 1u) * nx) xb_add(&bar[XB_TOPGEN], 1u);
            else XB_SPIN(xb_ld(&bar[XB_TOPGEN]) == tg, bar);
            __builtin_amdgcn_fence(__ATOMIC_ACQUIRE, "agent");
            xb_add(&bar[XB_XGEN(b.x)], 1u);
            asm volatile("s_waitcnt vmcnt(0)" ::: "memory");
        } else {
            XB_SPIN(xb_ld(&bar[XB_XGEN(b.x)]) == gen, bar);
            __builtin_amdgcn_fence(__ATOMIC_ACQUIRE, "agent");
            asm volatile("s_waitcnt vmcnt(0)" ::: "memory");
        }
    }
    __syncthreads();
}
constexpr size_t MiB = 1u << 20;
constexpr size_t SZ_WGU = (size_t)NGU * DM * 2, SZ_WD = (size_t)DM * DFF * 2, SZ_WIN = (size_t)NZP * DM * 2, SZ_WUP = (size_t)DM * 1024 * 2, SZ_WOUT = (size_t)DM * DM * 2, SZ_LRUW = (size_t)8 * 256 * 128 * 2;
constexpr size_t LW_GU1 = 0, LW_D1 = LW_GU1 + SZ_WGU, LW_IN = LW_D1 + SZ_WD, LW_UPA = LW_IN + SZ_WIN, LW_UPB = LW_UPA + SZ_WUP, LW_UPC = LW_UPB + SZ_WUP, LW_OUT = LW_UPC + SZ_WUP,
                 LW_GU2 = LW_OUT + SZ_WOUT, LW_D2 = LW_GU2 + SZ_WGU, LW_LRU = LW_D2 + SZ_WD, LW_END = LW_LRU + SZ_LRUW;
constexpr size_t LW_STRIDE = (LW_END + MiB - 1) / MiB * MiB;
constexpr size_t SZ_Y = (size_t)T_SEQ * 1024 * 2;
constexpr size_t WS_CTL = 0, CTL_BYTES = 2 * MiB, WS_W = CTL_BYTES, WS_X = WS_W + NLAYER * LW_STRIDE, WS_HN = WS_X + (size_t)T_SEQ * DM * 4, WS_HID = WS_HN + (size_t)T_SEQ * DM * 2,
                 WS_Z = WS_HID + (size_t)T_SEQ * DFF * 2, WS_ZT = WS_Z + (size_t)T_SEQ * NZ * 2, WS_G = WS_ZT + (size_t)NZT * T_SEQ * 2, WS_YA = WS_G + 1 * MiB, WS_YB = WS_YA + SZ_Y, WS_YC = WS_YB + SZ_Y,
                 WS_MG = WS_YC + SZ_Y, WS_SCR = WS_MG + (size_t)T_SEQ * DM * 2;
constexpr size_t SC_XC = 0, SC_LA = SC_XC + (size_t)T_SEQ * 1024 * 4, SC_LU = SC_LA + (size_t)T_SEQ * 1024 * 4, SC_MLA = SC_LU + (size_t)T_SEQ * 1024 * 4, SC_MLM = SC_MLA + 1 * MiB, SC_MLF = SC_MLM + 1 * MiB,
                 SC_KM = SC_MLF + 1 * MiB, SC_CARRY = SC_KM + 1 * MiB, SC_AKT = SC_CARRY + 1 * MiB, SC_LST = SC_AKT + (size_t)1024 * T_SEQ * 2, SC_CST = SC_LST + (size_t)64 * 4 * 65536 * 4, SC_NL = SC_CST + (size_t)64 * 4 * 65536 * 2,
                 SC_NST = SC_NL + 1 * MiB, SC_BG = SC_NST + 1 * MiB, SC_MST = SC_BG + 1 * MiB, SC_SEL = SC_MST + 1 * MiB, SC_PLSE = SC_SEL + 1 * MiB, SC_PO = SC_PLSE + 1 * MiB, SC_SSQ = SC_PO + (size_t)T_SEQ * 8 * 3 * 128 * 2, SC_END = SC_SSQ + 1 * MiB;
constexpr size_t WS_END = WS_SCR + SC_END;
constexpr int CW_BAR = 1024, MAX_LAUNCH = 96, CW_Q = 512;
constexpr int LDS_STAGE = 131072, LDS_MISC = LDS_STAGE, LDS_BYTES = 147456;

#include <hip/hip_runtime.h>
__device__ __forceinline__ unsigned pk_bf16(float lo, float hi) { unsigned r; asm volatile("v_cvt_pk_bf16_f32 %0, %1, %2" : "=v"(r) : "v"(lo), "v"(hi)); return r; }
struct PItem { int l, hf, p_lo, p_hi; };
constexpr int MAX_ITEMS = 48;
struct MegaArgs { const float* in[26]; float* out; unsigned char* ws; int n_items, do_pro, do_fin, li; PItem items[MAX_ITEMS]; };
__device__ __forceinline__ float wave_sum(float v) {
#pragma unroll
    for (int o = 1; o < 64; o <<= 1) v += __shfl_xor(v, o);
    return v;
}
constexpr int CT_GU = (NGU / 64) * (DM / 64), CT_D = (DM / 64) * (DFF / 64), CT_IN = (NZP / 64) * (DM / 64), CT_UP = (DM / 64) * (1024 / 64), CT_OUT = (DM / 64) * (DM / 64), CT_LRU = 8 * 4 * 2;
constexpr int CT_LAYER = 2 * CT_GU + 2 * CT_D + CT_IN + 3 * CT_UP + CT_OUT + CT_LRU;
typedef float f32x4w __attribute__((ext_vector_type(4)));
typedef unsigned u32x4w __attribute__((ext_vector_type(4)));
struct ConvTile { const float* sp; const float* gs; bf16* dp; int K, Nsrc; float sc, gm; };
template <class KA> __device__ __forceinline__ ConvTile conv_desc(KA a, int gidx, int lane) {
    const int l = gidx / CT_LAYER; int r = gidx - l * CT_LAYER; unsigned char* lw = a->ws + WS_W + (size_t)l * LW_STRIDE;
    const float* s0; const float* s1 = nullptr; const float* gs = nullptr; bf16* dst; int K, Nsrc, mode = 0, ntn;
    if (r < CT_GU) { gs = a->in[1] + (size_t)l * DM; s0 = a->in[2] + (size_t)l * DM * DFF; s1 = a->in[3] + (size_t)l * DM * DFF; dst = (bf16*)(lw + LW_GU1); K = DM; Nsrc = DFF; mode = 1; ntn = NGU / 64; }
    else if ((r -= CT_GU) < CT_D) { s0 = a->in[4] + (size_t)l * DFF * DM; dst = (bf16*)(lw + LW_D1); K = DFF; Nsrc = DM; ntn = DM / 64; }
    else if ((r -= CT_D) < CT_IN) { gs = a->in[5] + (size_t)l * DM; s0 = a->in[6] + (size_t)l * DM * 15368; dst = (bf16*)(lw + LW_IN); K = DM; Nsrc = 15368; mode = 2; ntn = NZP / 64; }
    else if ((r -= CT_IN) < CT_LRU) { const int blk = r >> 3; r &= 7; s0 = a->in[12] + ((size_t)l * 8 + blk) * 128 * 128; s1 = a->in[14] + ((size_t)l * 8 + blk) * 128 * 128; dst = (bf16*)(lw + LW_LRU) + (size_t)blk * 256 * 128; K = 128; Nsrc = 128; mode = 3; ntn = 4; }
    else if ((r -= CT_LRU) < 3 * CT_UP) { const int b = r / CT_UP; r -= b * CT_UP; s0 = (b == 0 ? a->in[17] : (b == 1 ? a->in[18] : a->in[19])) + (size_t)l * 1024 * DM; dst = (bf16*)(lw + LW_UPA + (size_t)b * SZ_WUP); K = 1024; Nsrc = DM; ntn = DM / 64; }
    else if ((r -= 3 * CT_UP) < CT_OUT) { s0 = a->in[20] + (size_t)l * DM * DM; dst = (bf16*)(lw + LW_OUT); K = DM; Nsrc = DM; ntn = DM / 64; }
    else if ((r -= CT_OUT) < CT_GU) { gs = a->in[21] + (size_t)l * DM; s0 = a->in[22] + (size_t)l * DM * DFF; s1 = a->in[23] + (size_t)l * DM * DFF; dst = (bf16*)(lw + LW_GU2); K = DM; Nsrc = DFF; mode = 1; ntn = NGU / 64; }
    else { r -= CT_GU; s0 = a->in[24] + (size_t)l * DFF * DM; dst = (bf16*)(lw + LW_D2); K = DFF; Nsrc = DM; ntn = DM / 64; }
    int nti, kti; if (mode == 1 || mode == 2) { const int grp = r >> 7, w = r & 127; kti = w >> 2; nti = grp * 4 + (w & 3); } else { nti = r % ntn; kti = r / ntn; }
    const int n0 = nti * 64, k0 = kti * 64, n = n0 + (lane & 15) * 4; const float* src = s0; int col = n; float sc = 1.f;
    if (mode == 1) { const int b = (n >> 7) & 1; col = ((n >> 8) << 7) | (n & 127); src = b ? s1 : s0; }
    else if (mode == 2) { int nl = n; if (n < NZ) { const int p_ = n & 255; nl = (n & ~255) + 64 * ((p_ >> 5) & 3) + 32 * (p_ >> 7) + (p_ & 31); }
        col = win_src_col(nl); if (nl >= Z_AK && nl < Z_AO) sc = 0.0625f; }
    else if (mode == 3) { src = (n & 128) ? s1 : s0; col = n & 127; }
    if (col < 0) { sc = 0.f; col = 0; }
    ConvTile t; t.sp = src + (size_t)(k0 + (lane >> 4)) * Nsrc + col; t.gs = (gs ? gs : a->in[1]) + k0 % DM + (lane >> 4); t.gm = gs ? 1.f : 0.f; t.dp = dst + (size_t)n0 * K + k0; t.K = K; t.Nsrc = Nsrc; t.sc = sc; return t;
}
__device__ __forceinline__ void conv_load(const ConvTile& t, f32x4w (&v)[16], float (&g)[16]) {
#pragma unroll
    for (int i = 0; i < 16; ++i) g[i] = t.gs[4 * i];
#pragma unroll
    for (int i = 0; i < 16; ++i) v[i] = __builtin_nontemporal_load((const f32x4w*)(t.sp + (size_t)(4 * i) * t.Nsrc));
}
__device__ __forceinline__ void conv_finish(const ConvTile& t, const f32x4w (&v)[16], const float (&gg)[16], LAS unsigned short* tl, int lane) {
    const int nl = (lane & 15) * 4;
#pragma unroll
    for (int i = 0; i < 16; ++i) { const float g = (gg[i] * t.gm + (1.f - t.gm)) * t.sc;
        LAS unsigned* w = (LAS unsigned*)(tl + (4 * i + (lane >> 4)) * 66 + nl); w[0] = pk_bf16(v[i][0] * g, v[i][1] * g); w[1] = pk_bf16(v[i][2] * g, v[i][3] * g); }
    asm volatile("s_waitcnt lgkmcnt(0)" ::: "memory");
    const int kc = (lane & 7) * 8;
#pragma unroll
    for (int q = 0; q < 8; ++q) { const int r = 8 * q + (lane >> 3); unsigned w[4];
#pragma unroll
        for (int e = 0; e < 4; ++e) w[e] = (unsigned)tl[(kc + 2 * e) * 66 + r] | ((unsigned)tl[(kc + 2 * e + 1) * 66 + r] << 16);
        __builtin_nontemporal_store((u32x4w){w[0], w[1], w[2], w[3]}, (u32x4w*)(t.dp + (size_t)r * t.K + kc)); }
    asm volatile("s_waitcnt lgkmcnt(0)" ::: "memory");
}
template <class KA> __device__ __forceinline__ void convert_range(KA a, LAS unsigned char* lds, int t_lo, int t_hi, int rank, int nrank) {
    int tid_ = threadIdx.x; asm volatile("" : "+v"(tid_));
    const int lane = tid_ & 63, wave = __builtin_amdgcn_readfirstlane(tid_ >> 6); LAS unsigned short* tl = (LAS unsigned short*)(lds + wave * 16384);
    const int stride = nrank * 8; int it = t_lo + rank * 8 + wave;
    if (it >= t_hi) return;
    f32x4w va[16], vb[16]; float ga[16], gb[16];
    ConvTile ta = conv_desc(a, it, lane), tb = ta; conv_load(ta, va, ga);
    for (;;) {
        const bool nb = (it + stride) < t_hi; tb = conv_desc(a, nb ? it + stride : it, lane); conv_load(tb, vb, gb);
        conv_finish(ta, va, ga, tl, lane);
        if (!nb) break;
        it += stride;
        const bool na = (it + stride) < t_hi; ta = conv_desc(a, na ? it + stride : it, lane); conv_load(ta, va, ga);
        conv_finish(tb, vb, gb, tl, lane);
        if (!na) break;
        it += stride;
    }
}
constexpr int CVT_PRO = 8704, CVT_GU = 9600, CVT_Z = 7400, CVT_TOTAL = NLAYER * CT_LAYER;
__host__ __device__ constexpr int cvt_slot_lo(int q) { return CVT_PRO + (q / 3) * (2 * CVT_GU + CVT_Z) + (q % 3 == 0 ? 0 : (q % 3 == 1 ? CVT_GU : CVT_GU + CVT_Z)); }
__host__ __device__ constexpr int cvt_slot_hi(int q) { return cvt_slot_lo(q) + (q % 3 == 1 ? CVT_Z : CVT_GU); }
__host__ __device__ constexpr int cvt_need_before(int q) {
    return (q / 3) * CT_LAYER + (q % 3 == 0 ? CT_GU + CT_D + CT_IN : (q % 3 == 1 ? CT_GU + CT_D + CT_IN + CT_LRU + 3 * CT_UP + CT_OUT + CT_GU : CT_LAYER + ((q / 3) + 1 < NLAYER ? CT_GU : 0))); }
__host__ __device__ constexpr bool cvt_schedule_ok() { if (CVT_PRO < CT_GU) return false; for (int q = 0; q < 3 * NLAYER; ++q) { const int hi = cvt_slot_hi(q) < CVT_TOTAL ? cvt_slot_hi(q) : CVT_TOTAL; if (hi < cvt_need_before(q)) return false; } return cvt_slot_hi(3 * NLAYER - 1) >= CVT_TOTAL; }
static_assert(cvt_schedule_ok(), "conversion schedule: a weight matrix would be read before it is converted");
__device__ __forceinline__ void phase_xinit(const float* x, float* X, bf16* XB, float* SSQ) {
    int tid_ = threadIdx.x; asm volatile("" : "+v"(tid_));
    const int lane = tid_ & 63, gw = blockIdx.x * 8 + (tid_ >> 6), nw = gridDim.x * 8;
    for (int row = gw; row < T_SEQ; row += nw) {
        const float4* xr = (const float4*)(x + (size_t)row * DM) + lane;
        float4 v[8]; float ss = 0.f;
#pragma unroll
        for (int j = 0; j < 8; ++j) v[j] = xr[64 * j];
#pragma unroll
        for (int j = 0; j < 8; ++j) { const unsigned w0 = pk_bf16(v[j].x, v[j].y), w1 = pk_bf16(v[j].z, v[j].w); ((uint2*)(XB + (size_t)row * DM))[lane + 64 * j] = make_uint2(w0, w1);
            const float r0 = lo_bf(w0), r1 = hi_bf(w0), r2 = lo_bf(w1), r3 = hi_bf(w1); ss += (r0 * r0 + r1 * r1) + (r2 * r2 + r3 * r3); }
        ss = wave_sum(ss);
        if (lane < 32) SSQ[(size_t)row * 32 + lane] = (lane == 0) ? ss : 0.f;
    }
}
__device__ __forceinline__ void phase_final(const bf16* XB, const float* g, float* out) {
    int tid_ = threadIdx.x; asm volatile("" : "+v"(tid_));
    const int lane = tid_ & 63, gw = blockIdx.x * 8 + (tid_ >> 6), nw = gridDim.x * 8;
    for (int row = gw; row < T_SEQ; row += nw) {
        const uint4* xr = (const uint4*)(XB + (size_t)row * DM) + lane;
        uint4 w[4]; float ss = 0.f;
#pragma unroll
        for (int j = 0; j < 4; ++j) w[j] = xr[64 * j];
#pragma unroll
        for (int j = 0; j < 4; ++j) { const float a0 = lo_bf(w[j].x), a1 = hi_bf(w[j].x), a2 = lo_bf(w[j].y), a3 = hi_bf(w[j].y), a4 = lo_bf(w[j].z), a5 = hi_bf(w[j].z), a6 = lo_bf(w[j].w), a7 = hi_bf(w[j].w);
            ss += (a0 * a0 + a1 * a1) + (a2 * a2 + a3 * a3) + (a4 * a4 + a5 * a5) + (a6 * a6 + a7 * a7); }
        const float rstd = rsqrtf(wave_sum(ss) * (1.f / DM) + RMS_EPS);
#pragma unroll
        for (int j = 0; j < 4; ++j) { const float4 g0 = *(const float4*)(g + 512 * j + 8 * lane), g1 = *(const float4*)(g + 512 * j + 8 * lane + 4); float* o = out + (size_t)row * DM + 512 * j + 8 * lane;
            *(float4*)o = make_float4(lo_bf(w[j].x) * rstd * g0.x, hi_bf(w[j].x) * rstd * g0.y, lo_bf(w[j].y) * rstd * g0.z, hi_bf(w[j].y) * rstd * g0.w);
            *(float4*)(o + 4) = make_float4(lo_bf(w[j].z) * rstd * g1.x, hi_bf(w[j].z) * rstd * g1.y, lo_bf(w[j].w) * rstd * g1.z, hi_bf(w[j].w) * rstd * g1.w); }
    }
}
__device__ __forceinline__ void phase_norm(const float* src, const float* g, bf16* obf, float* of32, float* xcopy) {
    int tid_ = threadIdx.x; asm volatile("" : "+v"(tid_));
    const int lane = tid_ & 63, gw = blockIdx.x * 8 + (tid_ >> 6), nw = gridDim.x * 8;
    const float4* gr = (const float4*)g + lane;
    for (int row = gw; row < T_SEQ; row += nw) {
        const float4* xr = (const float4*)(src + (size_t)row * DM) + lane;
        float4 v[8]; float ss = 0.f;
#pragma unroll
        for (int j = 0; j < 8; ++j) { v[j] = xr[64 * j]; ss += v[j].x * v[j].x + v[j].y * v[j].y + v[j].z * v[j].z + v[j].w * v[j].w; }
        const float rstd = rsqrtf(wave_sum(ss) * (1.f / DM) + RMS_EPS);
        if (xcopy) {
#pragma unroll
            for (int j = 0; j < 8; ++j) ((float4*)(xcopy + (size_t)row * DM))[lane + 64 * j] = v[j]; }
#pragma unroll
        for (int j = 0; j < 8; ++j) { const float4 gg = gr[64 * j]; const float a = v[j].x * rstd * gg.x, b = v[j].y * rstd * gg.y, c = v[j].z * rstd * gg.z, d = v[j].w * rstd * gg.w;
            if (of32) ((float4*)(of32 + (size_t)row * DM))[lane + 64 * j] = make_float4(a, b, c, d);
            else ((uint2*)(obf + (size_t)row * DM))[lane + 64 * j] = make_uint2((unsigned)f2bf(a) | ((unsigned)f2bf(b) << 16), (unsigned)f2bf(c) | ((unsigned)f2bf(d) << 16)); }
    }
}
typedef short bf16x8 __attribute__((ext_vector_type(8)));
typedef short bf16x4 __attribute__((ext_vector_type(4)));
typedef float f32x16 __attribute__((ext_vector_type(16)));
typedef float f32x4v __attribute__((ext_vector_type(4)));
typedef unsigned u32x4v __attribute__((ext_vector_type(4)));
#define MFMA32(a, b, c) __builtin_amdgcn_mfma_f32_32x32x16_bf16((a), (b), (c), 0, 0, 0)
__device__ __forceinline__ bf16x8 pack8(const float* v) { typedef unsigned u32x4_ __attribute__((ext_vector_type(4))); u32x4_ w; w.x = pk_bf16(v[0], v[1]); w.y = pk_bf16(v[2], v[3]); w.z = pk_bf16(v[4], v[5]); w.w = pk_bf16(v[6], v[7]); return __builtin_bit_cast(bf16x8, w); }
__device__ __forceinline__ float gelu_tanh_f(float x) { const float u = 0.7978845608028654f * (x + 0.044715f * x * x * x); const float th = 1.f - 2.f / (1.f + __expf(2.f * u)); return 0.5f * x * (1.f + th); }
__device__ __forceinline__ int kperm(int r) { return (r & 0x13) | ((r & 4) << 1) | ((r & 8) >> 1); }
__device__ __forceinline__ float neg_expm1_small(float x, float a_half) {
    const float p = -x * (1.f + x * (0.5f + x * (0.16666667f + x * (0.041666668f + x * (0.0083333338f + x * 0.0013888889f)))));
    return (x > -0.25f) ? p : (1.f - a_half * a_half);
}
#define LRU_BAR() do { asm volatile("s_waitcnt vmcnt(0) lgkmcnt(0)" ::: "memory"); __builtin_amdgcn_s_barrier(); asm volatile("" ::: "memory"); } while (0)
template <int PASS> __device__ __forceinline__ void lru_pass(const bf16* __restrict__ Z, const bf16* __restrict__ LW, const float* __restrict__ cw_g, const float* __restrict__ cb_g, const float* __restrict__ b_a, const float* __restrict__ b_x, const float* __restrict__ lam,
                                                              float2* __restrict__ CARRY, bf16* __restrict__ YC, LAS unsigned char* lds) {
    int tid_ = threadIdx.x; asm volatile("" : "+v"(tid_));
    const int tid = tid_, lane = tid & 63, wave = __builtin_amdgcn_readfirstlane(tid >> 6), r = lane & 31, hh = lane >> 5, jt = wave & 3, th = wave >> 2;
    LAS unsigned short* RAW = (LAS unsigned short*)lds; LAS unsigned char* XC = lds + 36864; LAS unsigned short* GT = (LAS unsigned short*)(lds + 69632);
    LAS float* xcomp = (LAS float*)(lds + LDS_MISC + 1024);
    for (int u = blockIdx.x; u < 512; u += gridDim.x) {
        const int R = u >> 3, blk = u & 7, tok0 = R * 128, dd = 32 * jt + r, d = blk * 128 + dd;
        LRU_BAR();
        { int t_ = tid; asm volatile("" : "+v"(t_));
#pragma unroll
          for (int i = 0; i < 5; ++i) { const int idx = t_ + 512 * i; if (idx < 131 * 16) { const int row = idx >> 4, c = idx & 15, t = tok0 - 3 + row; u32x4v v = (u32x4v){0u, 0u, 0u, 0u};
              if (t >= 0) v = *(const u32x4v*)(Z + (size_t)t * NZ + Z_CX + blk * 128 + c * 8); *(LAS u32x4v*)(RAW + row * 128 + c * 8) = v; } }
          if (PASS == 2) {
#pragma unroll
              for (int i = 0; i < 4; ++i) { const int idx = t_ + 512 * i, row = idx >> 4, c = idx & 15; *(LAS u32x4v*)(GT + row * 128 + c * 8) = *(const u32x4v*)(Z + (size_t)(tok0 + row) * NZ + Z_CG + blk * 128 + c * 8); } } }
        const bf16* wt = LW + (size_t)blk * 256 * 128;
        bf16x8 ba[8], bx[8];
#pragma unroll
        for (int s = 0; s < 8; ++s) { ba[s] = *(const bf16x8*)(wt + (size_t)dd * 128 + 16 * s + 8 * hh); bx[s] = *(const bf16x8*)(wt + (size_t)(128 + dd) * 128 + 16 * s + 8 * hh); }
        const float bav = b_a[d], bxv = b_x[d], sp8 = 8.f * log1pf(expf(-lam[d]));
        const float w0 = cw_g[d], w1 = cw_g[1024 + d], w2 = cw_g[2048 + d], w3 = cw_g[3072 + d], wb = cb_g[d];
        float hc = 0.f;
        if (PASS == 2) { for (int q0 = 0; q0 < R; q0 += 8) { float2 cc[8];
#pragma unroll
                for (int j = 0; j < 8; ++j) cc[j] = (q0 + j < R) ? CARRY[(size_t)(q0 + j) * 1024 + d] : make_float2(1.f, 0.f);
#pragma unroll
                for (int j = 0; j < 8; ++j) hc = hc * cc[j].x + cc[j].y; } }
        LRU_BAR();
        { const int c8 = tid & 15; const float* cwp = cw_g + blk * 128 + c8 * 8; float cw[4][8], cbv[8];
#pragma unroll
          for (int jj = 0; jj < 4; ++jj) { const float4 q0 = *(const float4*)(cwp + jj * 1024), q1 = *(const float4*)(cwp + jj * 1024 + 4); cw[jj][0] = q0.x; cw[jj][1] = q0.y; cw[jj][2] = q0.z; cw[jj][3] = q0.w; cw[jj][4] = q1.x; cw[jj][5] = q1.y; cw[jj][6] = q1.z; cw[jj][7] = q1.w; }
          { const float4 q0 = *(const float4*)(cb_g + blk * 128 + c8 * 8), q1 = *(const float4*)(cb_g + blk * 128 + c8 * 8 + 4); cbv[0] = q0.x; cbv[1] = q0.y; cbv[2] = q0.z; cbv[3] = q0.w; cbv[4] = q1.x; cbv[5] = q1.y; cbv[6] = q1.z; cbv[7] = q1.w; }
#pragma unroll
          for (int i = 0; i < 4; ++i) { const int t = (tid >> 4) + 32 * i; float xv[8];
#pragma unroll
              for (int e = 0; e < 8; ++e) xv[e] = cbv[e];
#pragma unroll
              for (int jj = 0; jj < 4; ++jj) { const u32x4v raw = *(const LAS u32x4v*)(RAW + (t + jj) * 128 + c8 * 8);
                  xv[0] += cw[jj][0] * lo_bf(raw[0]); xv[1] += cw[jj][1] * hi_bf(raw[0]); xv[2] += cw[jj][2] * lo_bf(raw[1]); xv[3] += cw[jj][3] * hi_bf(raw[1]);
                  xv[4] += cw[jj][4] * lo_bf(raw[2]); xv[5] += cw[jj][5] * hi_bf(raw[2]); xv[6] += cw[jj][6] * lo_bf(raw[3]); xv[7] += cw[jj][7] * hi_bf(raw[3]); }
              *(LAS bf16x8*)(XC + t * 256 + ((c8 ^ (t & 15)) << 4)) = pack8(xv); } }
        LRU_BAR();
        float av[2][16], uv[2][16]; float Aw = 1.f, Hw = 0.f;
        float Ag[2][4], Hg[2][4], Ap[2][4], Hp[2][4];
#pragma unroll
        for (int tt = 0; tt < 2; ++tt) {
            const int tl0 = 64 * th + 32 * tt;
            f32x16 accA, accX;
#pragma unroll
            for (int i = 0; i < 16; ++i) { accA[i] = 0.f; accX[i] = 0.f; }
#pragma unroll
            for (int s = 0; s < 8; ++s) { const bf16x8 af = *(const LAS bf16x8*)(XC + (tl0 + r) * 256 + (((2 * s + hh) ^ (r & 15)) << 4)); accA = MFMA32(af, ba[s], accA); accX = MFMA32(af, bx[s], accX); }
#pragma unroll
            for (int gq = 0; gq < 4; ++gq) { const int t0 = tl0 + 8 * gq + 4 * hh; float cxr[7];
#pragma unroll
                for (int q = 0; q < 7; ++q) cxr[q] = bf2f(RAW[(t0 + q) * 128 + dd]);
#pragma unroll
                for (int e = 0; e < 4; ++e) { const int i = 4 * gq + e;
                    const float xc = wb + w0 * cxr[e] + w1 * cxr[e + 1] + w2 * cxr[e + 2] + w3 * cxr[e + 3];
                    const float rr = __builtin_amdgcn_rcpf(1.f + __expf(-(accA[i] + bav))), ig = __builtin_amdgcn_rcpf(1.f + __expf(-(accX[i] + bxv)));
                    const float la = -sp8 * rr, a_ = __expf(la); av[tt][i] = a_; uv[tt][i] = __builtin_amdgcn_sqrtf(neg_expm1_small(2.f * la, a_)) * (ig * xc); } }
#pragma unroll
            for (int gq = 0; gq < 4; ++gq) { float A = av[tt][4 * gq], H = uv[tt][4 * gq];
#pragma unroll
                for (int e = 1; e < 4; ++e) { H = H * av[tt][4 * gq + e] + uv[tt][4 * gq + e]; A *= av[tt][4 * gq + e]; }
                Ag[tt][gq] = A; Hg[tt][gq] = H; Ap[tt][gq] = __shfl_xor(A, 32); Hp[tt][gq] = __shfl_xor(H, 32); }
#pragma unroll
            for (int p = 0; p < 8; ++p) { const bool own = ((p & 1) == hh); const float A = own ? Ag[tt][p >> 1] : Ap[tt][p >> 1], H = own ? Hg[tt][p >> 1] : Hp[tt][p >> 1]; Hw = Hw * A + H; Aw *= A; }
        }
        if (hh == 0) { xcomp[(wave * 32 + r) * 2] = Aw; xcomp[(wave * 32 + r) * 2 + 1] = Hw; }
        LRU_BAR();
        if (PASS == 1) {
            if (th == 0 && hh == 0) { const float A1 = xcomp[((wave + 4) * 32 + r) * 2], H1 = xcomp[((wave + 4) * 32 + r) * 2 + 1]; CARRY[(size_t)R * 1024 + d] = make_float2(Aw * A1, Hw * A1 + H1); }
        } else {
            if (th == 1) { const float A0 = xcomp[((wave - 4) * 32 + r) * 2], H0 = xcomp[((wave - 4) * 32 + r) * 2 + 1]; hc = hc * A0 + H0; }
#pragma unroll
            for (int tt = 0; tt < 2; ++tt) { const int tl0 = 64 * th + 32 * tt; float hin[4];
#pragma unroll
                for (int p = 0; p < 8; ++p) { const bool own = ((p & 1) == hh); if (own) hin[p >> 1] = hc; const float A = own ? Ag[tt][p >> 1] : Ap[tt][p >> 1], H = own ? Hg[tt][p >> 1] : Hp[tt][p >> 1]; hc = hc * A + H; }
#pragma unroll
                for (int gq = 0; gq < 4; ++gq) { float h = hin[gq]; const int t0 = tl0 + 8 * gq + 4 * hh;
#pragma unroll
                    for (int e = 0; e < 4; ++e) { h = h * av[tt][4 * gq + e] + uv[tt][4 * gq + e];
                        YC[(size_t)(tok0 + t0 + e) * 1024 + d] = f2bf(h * gelu_tanh_f(bf2f(GT[(t0 + e) * 128 + dd]))); } } }
        }
    }
    LRU_BAR();
}
__device__ __forceinline__ float wave_incl_sum(float v, int lane) {
#pragma unroll
    for (int o = 1; o < 64; o <<= 1) { const float t = __shfl_up(v, o); if (lane >= o) v += t; }
    return v;
}
__device__ __forceinline__ float wave_incl_max(float v, int lane) {
#pragma unroll
    for (int o = 1; o < 64; o <<= 1) { const float t = __shfl_up(v, o); if (lane >= o) v = fmaxf(v, t); }
    return v;
}
__device__ __forceinline__ float wave_max(float v) {
#pragma unroll
    for (int o = 1; o < 64; o <<= 1) v = fmaxf(v, __shfl_xor(v, o));
    return v;
}
constexpr int ML_L = 128, ML_NC = T_SEQ / ML_L;
struct ChunkGates { float a0, a1, b0, b1, Bc; };
__device__ __forceinline__ ChunkGates chunk_gates(const float* G, float bi, float bfv, int tok0, int h, int lane) {
    const size_t t = (size_t)tok0 + 2 * lane;
    const float ip0 = G[t * 8 + h] + bi, fp0 = G[t * 8 + 4 + h] + bfv, ip1 = G[(t + 1) * 8 + h] + bi, fp1 = G[(t + 1) * 8 + 4 + h] + bfv;
    const float lf0 = fminf(fp0, 0.f) - log1pf(expf(-fabsf(fp0))), lf1 = fminf(fp1, 0.f) - log1pf(expf(-fabsf(fp1)));
    const float s1 = lf0 + lf1, inc = wave_incl_sum(s1, lane), excl = inc - s1;
    ChunkGates g; g.b0 = excl + lf0; g.b1 = inc; g.Bc = __builtin_bit_cast(float, __builtin_amdgcn_readlane(__builtin_bit_cast(int, inc), 63)); g.a0 = ip0 - g.b0; g.a1 = ip1 - g.b1; return g;
}
__device__ __forceinline__ void ml_ktrans(const bf16* __restrict__ Z, bf16* __restrict__ AKT, LAS unsigned char* lds) {
    int tid_ = threadIdx.x; asm volatile("" : "+v"(tid_));
    const int lane = tid_ & 63, wave = __builtin_amdgcn_readfirstlane(tid_ >> 6), gw = blockIdx.x * 8 + wave, nw = gridDim.x * 8;
    LAS unsigned short* tl = (LAS unsigned short*)(lds + wave * 16384);
    for (int u = gw; u < 2048; u += nw) { const int tok0 = (u >> 4) * 64, ch0 = (u & 15) * 64;
#pragma unroll
        for (int i = 0; i < 8; ++i) { const int tk = 8 * i + (lane >> 3), cc = (lane & 7) * 8;
            *(LAS u32x4v*)(tl + tk * 72 + cc) = *(const u32x4v*)(Z + (size_t)(tok0 + tk) * NZ + Z_AK + ch0 + cc); }
        asm volatile("s_waitcnt lgkmcnt(0)" ::: "memory");
#pragma unroll
        for (int i = 0; i < 8; ++i) { const int ch = 8 * i + (lane >> 3), tc = (lane & 7) * 8; unsigned w[4];
#pragma unroll
            for (int e = 0; e < 4; ++e) w[e] = (unsigned)tl[(tc + 2 * e) * 72 + ch] | ((unsigned)tl[(tc + 2 * e + 1) * 72 + ch] << 16);
            *(uint4*)(AKT + (size_t)(ch0 + ch) * T_SEQ + tok0 + tc) = make_uint4(w[0], w[1], w[2], w[3]); }
        asm volatile("s_waitcnt lgkmcnt(0)" ::: "memory");
    }
}
template <int CHUNKS> __device__ __forceinline__ void ml_stage(LAS unsigned char* dst, const bf16* src, size_t row_stride, int tid) {
    asm volatile("" : "+v"(tid));
    u32x4v v[8];
#pragma unroll
    for (int i = 0; i < 8; ++i) { const int idx = tid + 512 * i, row = idx / CHUNKS, c = idx % CHUNKS; v[i] = *(const u32x4v*)(src + (size_t)row * row_stride + c * 8); }
#pragma unroll
    for (int i = 0; i < 8; ++i) { const int idx = tid + 512 * i, row = idx / CHUNKS, c = idx % CHUNKS; *(LAS u32x4v*)(dst + row * (CHUNKS * 16) + ((c ^ (row & 15)) << 4)) = v[i]; }
}
#define ML_BAR() do { asm volatile("s_waitcnt vmcnt(0) lgkmcnt(0)" ::: "memory"); __builtin_amdgcn_s_barrier(); asm volatile("" ::: "memory"); } while (0)
template <int CHUNKS> __device__ __forceinline__ void ml_load(u32x4v (&v)[8], const bf16* src, size_t row_stride, int tid) {
    asm volatile("" : "+v"(tid));
#pragma unroll
    for (int i = 0; i < 8; ++i) { const int idx = tid + 512 * i, row = idx / CHUNKS, c = idx % CHUNKS; v[i] = *(const u32x4v*)(src + (size_t)row * row_stride + c * 8); }
}
template <int CHUNKS> __device__ __forceinline__ void ml_store(LAS unsigned char* dst, const u32x4v (&v)[8], int tid) {
    asm volatile("" : "+v"(tid));
#pragma unroll
    for (int i = 0; i < 8; ++i) { const int idx = tid + 512 * i, row = idx / CHUNKS, c = idx % CHUNKS; *(LAS u32x4v*)(dst + row * (CHUNKS * 16) + ((c ^ (row & 15)) << 4)) = v[i]; }
}
#define ML_BAR_L() do { asm volatile("s_waitcnt lgkmcnt(0)" ::: "memory"); __builtin_amdgcn_s_barrier(); asm volatile("" ::: "memory"); } while (0)
__device__ __forceinline__ void ml_local(const bf16* __restrict__ ZT, const bf16* __restrict__ AKT, const float* __restrict__ G, const float* __restrict__ b_i, const float* __restrict__ b_f, float* __restrict__ LST, float* __restrict__ NL, float2* __restrict__ BG, LAS unsigned char* lds) {
    int tid_ = threadIdx.x; asm volatile("" : "+v"(tid_));
    const int tid = tid_, lane = tid & 63, wave = __builtin_amdgcn_readfirstlane(tid >> 6), r = lane & 31, hh = lane >> 5, it = wave;
    LAS float* wl = (LAS float*)(lds + LDS_MISC + 12288);
    for (int u = blockIdx.x; u < ML_NC * 4; u += gridDim.x) { const int c = u >> 2, h = u & 3, tok0 = c * ML_L;
        ML_BAR();
        ml_stage<16>(lds, ZT + (size_t)(ZT_AV + h * 256) * T_SEQ + tok0, T_SEQ, tid);
        ml_stage<16>(lds + 65536, AKT + (size_t)(h * 256) * T_SEQ + tok0, T_SEQ, tid);
        if (wave == 0) { const ChunkGates cg = chunk_gates(G, b_i[h], b_f[h], tok0, h, lane);
            const float g0 = cg.Bc + cg.a0, g1 = cg.Bc + cg.a1, Gc = wave_max(fmaxf(g0, g1));
            wl[2 * lane] = __expf(g0 - Gc); wl[2 * lane + 1] = __expf(g1 - Gc);
            if (lane == 0) BG[h * ML_NC + c] = make_float2(cg.Bc, Gc); }
        ML_BAR();
        f32x16 acc[8];
#pragma unroll
        for (int jt = 0; jt < 8; ++jt)
#pragma unroll
            for (int i = 0; i < 16; ++i) acc[jt][i] = 0.f;
        const int vrow = 32 * it + r, x = r & 15;
#pragma unroll 2
        for (int s = 0; s < 8; ++s) {
            const u32x4v vr = *(const LAS u32x4v*)(lds + vrow * 256 + (((2 * s + hh) ^ x) << 4));
            const f32x4v w0 = *(const LAS f32x4v*)(wl + 16 * s + 8 * hh), w1 = *(const LAS f32x4v*)(wl + 16 * s + 8 * hh + 4);
            float vv[8] = {lo_bf(vr[0]) * w0[0], hi_bf(vr[0]) * w0[1], lo_bf(vr[1]) * w0[2], hi_bf(vr[1]) * w0[3], lo_bf(vr[2]) * w1[0], hi_bf(vr[2]) * w1[1], lo_bf(vr[3]) * w1[2], hi_bf(vr[3]) * w1[3]};
            const bf16x8 af = pack8(vv);
#pragma unroll
            for (int jt = 0; jt < 8; ++jt) { const bf16x8 bfr = *(const LAS bf16x8*)(lds + 65536 + (32 * jt + r) * 256 + (((2 * s + hh) ^ x) << 4)); acc[jt] = MFMA32(af, bfr, acc[jt]); }
        }
        float* lo = LST + ((size_t)(c * 4 + h) * 256 + 32 * it + 4 * hh) * 256 + r;
#pragma unroll
        for (int jt = 0; jt < 8; ++jt)
#pragma unroll
            for (int i = 0; i < 16; ++i) lo[(size_t)((i & 3) + 8 * (i >> 2)) * 256 + 32 * jt] = acc[jt][i];
        { float ns = 0.f;
#pragma unroll
            for (int q = 0; q < 8; ++q) { const u32x4v kv = *(const LAS u32x4v*)(lds + 65536 + vrow * 256 + (((8 * hh + q) ^ x) << 4)); const f32x4v w0 = *(const LAS f32x4v*)(wl + 64 * hh + 8 * q), w1 = *(const LAS f32x4v*)(wl + 64 * hh + 8 * q + 4);
                ns += lo_bf(kv[0]) * w0[0] + hi_bf(kv[0]) * w0[1] + lo_bf(kv[1]) * w0[2] + hi_bf(kv[1]) * w0[3] + lo_bf(kv[2]) * w1[0] + hi_bf(kv[2]) * w1[1] + lo_bf(kv[3]) * w1[2] + hi_bf(kv[3]) * w1[3]; }
            ns += __shfl_xor(ns, 32);
            if (hh == 0) NL[(size_t)(c * 4 + h) * 256 + 32 * it + r] = ns; }
    }
    ML_BAR();
}
__device__ __forceinline__ void ml_scan(const float* __restrict__ LST, const float* __restrict__ NL, const float2* __restrict__ BG, bf16* __restrict__ CST, float* __restrict__ NST, float* __restrict__ MST) {
    int tid_ = threadIdx.x; asm volatile("" : "+v"(tid_));
    const int lane = tid_ & 63, wave = __builtin_amdgcn_readfirstlane(tid_ >> 6), gw = blockIdx.x * 8 + wave, nw = gridDim.x * 8;
    for (int u = gw; u < 2048; u += nw) {
        const int h = u >> 9; const size_t e = ((size_t)u * 64 + lane) * 2;
        const size_t eh = e - (size_t)h * 65536;
        float c0 = 0.f, c1 = 0.f, m = 0.f;
        const bool do_n = (u & 511) < 4;  const int nk = (u & 511) * 64 + lane;
        float nv = 0.f;
        for (int cb = 0; cb < ML_NC; cb += 8) {
            float2 lv[8], bg[8]; float nl[8];
#pragma unroll
            for (int j = 0; j < 8; ++j) { lv[j] = *(const float2*)(LST + (size_t)((cb + j) * 4 + h) * 65536 + eh); bg[j] = BG[h * ML_NC + cb + j]; nl[j] = do_n ? NL[(size_t)((cb + j) * 4 + h) * 256 + nk] : 0.f; }
#pragma unroll
            for (int j = 0; j < 8; ++j) { const int c = cb + j;
                *(unsigned*)(CST + (size_t)(c * 4 + h) * 65536 + eh) = pk_bf16(c0, c1);
                if (eh == 0) MST[h * ML_NC + c] = m;
                const float mn = fmaxf(bg[j].x + m, bg[j].y), dec = __expf(bg[j].x + m - mn), inj = __expf(bg[j].y - mn);
                c0 = dec * c0 + inj * lv[j].x; c1 = dec * c1 + inj * lv[j].y;
                if (do_n) { NST[(size_t)(c * 4 + h) * 256 + nk] = nv; nv = dec * nv + inj * nl[j]; }
                m = mn; }
        }
    }
}
__device__ __forceinline__ void ml_out(const bf16* __restrict__ Z, const bf16* __restrict__ ZT, const float* __restrict__ G, const float* __restrict__ b_i, const float* __restrict__ b_f, const bf16* __restrict__ CST, const float* __restrict__ NST, const float* __restrict__ MST, const float* __restrict__ gain, bf16* __restrict__ YA, LAS unsigned char* lds) {
    int tid_ = threadIdx.x; asm volatile("" : "+v"(tid_));
    const int tid = tid_, lane = tid & 63, wave = __builtin_amdgcn_readfirstlane(tid >> 6), r = lane & 31, hh = lane >> 5, qt = wave >> 1, dvh = wave & 1;
    LAS float* al = (LAS float*)(lds + LDS_MISC + 12288);
    LAS float* xch = (LAS float*)(lds + LDS_MISC + 1024);
    LAS float* gl = (LAS float*)(lds + LDS_MISC + 2048); LAS float* nl = (LAS float*)(lds + LDS_MISC + 3072);
    LAS unsigned char* TA = lds; LAS unsigned char* TB = lds + 65536;
    const int x = r & 15, kr = kperm(r), kx = kr & 15;
    for (int u = blockIdx.x; u < ML_NC * 4; u += gridDim.x) { const int c = u >> 2, h = u & 3, tok0 = c * ML_L;
        ML_BAR();
        ml_stage<32>(TA, Z + (size_t)tok0 * NZ + Z_AQ + h * 256, NZ, tid);
        ml_stage<16>(TB, CST + (size_t)(c * 4 + h) * 65536, 256, tid);
        { int t_ = tid; asm volatile("" : "+v"(t_)); if (t_ < 256) gl[t_] = gain[h * 256 + t_]; else nl[t_ - 256] = NST[(size_t)(c * 4 + h) * 256 + t_ - 256]; }
        if (wave == 0) { const ChunkGates cg = chunk_gates(G, b_i[h], b_f[h], tok0, h, lane);
            const float pm1 = fmaxf(cg.a0, cg.a1), inc = wave_incl_max(pm1, lane); float ex = __shfl_up(inc, 1); if (lane == 0) ex = -INFINITY;
            al[2 * lane] = cg.a0; al[2 * lane + 1] = cg.a1; al[128 + 2 * lane] = fmaxf(ex, cg.a0); al[128 + 2 * lane + 1] = inc; al[256 + 2 * lane] = cg.b0; al[256 + 2 * lane + 1] = cg.b1; }
        u32x4v pre[8];
        ml_load<16>(pre, CST + (size_t)(c * 4 + h) * 65536 + 128, 256, tid);
        ML_BAR_L();
        const float mc = MST[h * ML_NC + c];
        const int tq = 32 * qt + r; const size_t tglob = (size_t)tok0 + tq;
        const float Mt = fmaxf(mc, al[128 + tq]), wi = __expf(mc - Mt), emt = __expf(-(al[256 + tq] + Mt));
        f32x16 acc[4];
#pragma unroll
        for (int dt = 0; dt < 4; ++dt)
#pragma unroll
            for (int i = 0; i < 16; ++i) acc[dt][i] = 0.f;
        const LAS float* nrow = nl + 8 * hh;
        float qn = 0.f;
#pragma unroll
        for (int half = 0; half < 2; ++half) {
            if (half == 1) { ML_BAR_L(); ml_store<16>(TB, pre, tid); ml_load<32>(pre, Z + (size_t)tok0 * NZ + Z_AK + h * 256, NZ, tid); ML_BAR_L(); }
#pragma unroll 2
            for (int s8 = 0; s8 < 8; ++s8) { const int s = 8 * half + s8;
                const u32x4v qr = *(const LAS u32x4v*)(TA + tq * 512 + (((2 * s + hh) ^ x) << 4)); const bf16x8 qf = __builtin_bit_cast(bf16x8, qr);
                const f32x4v n0 = *(const LAS f32x4v*)(nrow + 16 * s), n1 = *(const LAS f32x4v*)(nrow + 16 * s + 4);
                qn += lo_bf(qr[0]) * n0[0] + hi_bf(qr[0]) * n0[1] + lo_bf(qr[1]) * n0[2] + hi_bf(qr[1]) * n0[3] + lo_bf(qr[2]) * n1[0] + hi_bf(qr[2]) * n1[1] + lo_bf(qr[3]) * n1[2] + hi_bf(qr[3]) * n1[3];
#pragma unroll
                for (int dt = 0; dt < 4; ++dt) { const bf16x8 cf = *(const LAS bf16x8*)(TB + (128 * dvh + 32 * dt + r) * 256 + (((2 * s8 + hh) ^ x) << 4)); acc[dt] = MFMA32(cf, qf, acc[dt]); }
            }
        }
        qn += __shfl_xor(qn, 32);
#pragma unroll
        for (int dt = 0; dt < 4; ++dt)
#pragma unroll
            for (int i = 0; i < 16; ++i) acc[dt][i] *= wi;
        ML_BAR_L(); ml_store<32>(TB, pre, tid); ml_load<16>(pre, ZT + (size_t)(ZT_AV + h * 256) * T_SEQ + tok0, T_SEQ, tid); ML_BAR_L();
        bf16x8 pf[4][2]; float dsum = 0.f;
#pragma unroll
        for (int kt = 0; kt < 4; ++kt) { if (kt <= qt) {
            f32x16 X;
#pragma unroll
            for (int i = 0; i < 16; ++i) X[i] = 0.f;
#pragma unroll 2
            for (int s = 0; s < 16; ++s) { const bf16x8 kf = *(const LAS bf16x8*)(TB + (32 * kt + kr) * 512 + (((2 * s + hh) ^ kx) << 4)), qf = *(const LAS bf16x8*)(TA + tq * 512 + (((2 * s + hh) ^ x) << 4)); X = MFMA32(kf, qf, X); }
            float P[16];
#pragma unroll
            for (int g8 = 0; g8 < 2; ++g8) { const int s0 = 32 * kt + 16 * g8 + 8 * hh; const f32x4v a0 = *(const LAS f32x4v*)(al + s0), a1 = *(const LAS f32x4v*)(al + s0 + 4);
#pragma unroll
                for (int e = 0; e < 8; ++e) { const float av = (e < 4) ? a0[e & 3] : a1[e & 3]; const float p = (s0 + e <= tq) ? X[8 * g8 + e] * __expf(av - Mt) : 0.f; P[8 * g8 + e] = p; dsum += p; } }
            pf[kt][0] = pack8(P); pf[kt][1] = pack8(P + 8); } }
        dsum += __shfl_xor(dsum, 32);
        ML_BAR_L(); ml_store<16>(TB, pre, tid); ML_BAR_L();
        uint2 ow[16];
#pragma unroll
        for (int j = 0; j < 16; ++j) ow[j] = *(const uint2*)(Z + tglob * NZ + Z_AO + h * 256 + 128 * dvh + 32 * (j >> 2) + 8 * (j & 3) + 4 * hh);
#pragma unroll
        for (int kt = 0; kt < 4; ++kt) { if (kt <= qt) {
#pragma unroll
            for (int s2 = 0; s2 < 2; ++s2)
#pragma unroll
                for (int dt = 0; dt < 4; ++dt) { const bf16x8 vf = *(const LAS bf16x8*)(TB + (128 * dvh + 32 * dt + r) * 256 + (((4 * kt + 2 * s2 + hh) ^ x) << 4)); acc[dt] = MFMA32(vf, pf[kt][s2], acc[dt]); } } }
        const float den = dsum + wi * qn, inv = 1.f / fmaxf(fabsf(den), emt);
        float ss = 0.f;
#pragma unroll
        for (int dt = 0; dt < 4; ++dt)
#pragma unroll
            for (int i = 0; i < 16; ++i) { acc[dt][i] *= inv; ss += acc[dt][i] * acc[dt][i]; }
        ss += __shfl_xor(ss, 32);
        if (hh == 0) xch[wave * 32 + r] = ss;
        ML_BAR();
        const float rs = rsqrtf((ss + xch[(wave ^ 1) * 32 + r]) * (1.f / 256.f) + RMS_EPS);
#pragma unroll
        for (int dt = 0; dt < 4; ++dt)
#pragma unroll
            for (int gq = 0; gq < 4; ++gq) { const int dv0 = 128 * dvh + 32 * dt + 8 * gq + 4 * hh;
                const uint2 o2 = ow[4 * dt + gq]; const f32x4v gg = *(const LAS f32x4v*)(gl + dv0);
                const float y0 = sigmoidf_(lo_bf(o2.x)) * acc[dt][4 * gq] * rs * gg[0], y1 = sigmoidf_(hi_bf(o2.x)) * acc[dt][4 * gq + 1] * rs * gg[1],
                            y2 = sigmoidf_(lo_bf(o2.y)) * acc[dt][4 * gq + 2] * rs * gg[2], y3 = sigmoidf_(hi_bf(o2.y)) * acc[dt][4 * gq + 3] * rs * gg[3];
                *(uint2*)(YA + tglob * 1024 + h * 256 + dv0) = make_uint2(pk_bf16(y0, y1), pk_bf16(y2, y3)); }
    }
    ML_BAR();
}
constexpr float MOBA_SCALE = 0.08838834764831845f;
__device__ __forceinline__ void moba_kmean(const bf16* __restrict__ Z, float* __restrict__ KMP) {
    int tid_ = threadIdx.x; asm volatile("" : "+v"(tid_));
    const int lane = tid_ & 63, wave = __builtin_amdgcn_readfirstlane(tid_ >> 6), gw = blockIdx.x * 8 + wave, nw = gridDim.x * 8;
    for (int u = gw; u < 512; u += nw) { const int h = u >> 6, n = (u >> 1) & 31, half = u & 1; float s[8];
#pragma unroll
        for (int e = 0; e < 8; ++e) s[e] = 0.f;
        const bf16* kp = Z + (size_t)(n * 256 + half * 128 + (lane >> 4)) * NZ + Z_BK + h * 128 + (lane & 15) * 8;
#pragma unroll 8
        for (int j = 0; j < 32; ++j) { const uint4 w = *(const uint4*)(kp + (size_t)(4 * j) * NZ);
            s[0] += lo_bf(w.x); s[1] += hi_bf(w.x); s[2] += lo_bf(w.y); s[3] += hi_bf(w.y); s[4] += lo_bf(w.z); s[5] += hi_bf(w.z); s[6] += lo_bf(w.w); s[7] += hi_bf(w.w); }
#pragma unroll
        for (int e = 0; e < 8; ++e) { s[e] += __shfl_xor(s[e], 16); s[e] += __shfl_xor(s[e], 32); }
        if (lane < 16) { float* o = KMP + (size_t)u * 128 + lane * 8; *(float4*)o = make_float4(s[0], s[1], s[2], s[3]); *(float4*)(o + 4) = make_float4(s[4], s[5], s[6], s[7]); } }
}
__device__ __forceinline__ void top3_insert(float g, int n, float& v1, float& v2, float& v3, int& i1, int& i2, int& i3) {
    const bool b1 = (g > v1) || (g == v1 && n < i1), b2 = (g > v2) || (g == v2 && n < i2), b3 = (g > v3) || (g == v3 && n < i3);
    const float nv3 = b2 ? v2 : (b3 ? g : v3), nv2 = b1 ? v1 : (b2 ? g : v2), nv1 = b1 ? g : v1;
    const int ni3 = b2 ? i2 : (b3 ? n : i3), ni2 = b1 ? i1 : (b2 ? n : i2), ni1 = b1 ? n : i1;
    v1 = nv1; v2 = nv2; v3 = nv3; i1 = ni1; i2 = ni2; i3 = ni3;
}
__device__ __forceinline__ void moba_select(const bf16* __restrict__ Z, const float* __restrict__ KM, unsigned* __restrict__ SEL, float* __restrict__ PLSE, LAS unsigned char* lds) {
    int tid_ = threadIdx.x; asm volatile("" : "+v"(tid_));
    const int lane = tid_ & 63, wave = __builtin_amdgcn_readfirstlane(tid_ >> 6), r = lane & 31, hh = lane >> 5, gw = blockIdx.x * 8 + wave, nw = gridDim.x * 8;
    for (int u = gw; u < 2048; u += nw) { const int h = u & 7, t0 = (u >> 3) * 32, qb = t0 >> 8; const size_t t = (size_t)t0 + r;
        f32x16 X;
#pragma unroll
        for (int i = 0; i < 16; ++i) X[i] = 0.f;
        if (qb > 0) {
            const bf16* qp = Z + t * NZ + Z_BQ + h * 128 + 8 * hh;
            const float* kq = KM + ((size_t)(h * 32 + r) * 2) * 128 + 8 * hh;
#pragma unroll 2
            for (int s = 0; s < 8; ++s) { const bf16x8 qf = *(const bf16x8*)(qp + 16 * s);
                const float4 a0 = *(const float4*)(kq + 16 * s), a1 = *(const float4*)(kq + 16 * s + 4), b0 = *(const float4*)(kq + 128 + 16 * s), b1 = *(const float4*)(kq + 128 + 16 * s + 4);
                float km[8] = {(a0.x + b0.x) * (1.f / 256.f), (a0.y + b0.y) * (1.f / 256.f), (a0.z + b0.z) * (1.f / 256.f), (a0.w + b0.w) * (1.f / 256.f), (a1.x + b1.x) * (1.f / 256.f), (a1.y + b1.y) * (1.f / 256.f), (a1.z + b1.z) * (1.f / 256.f), (a1.w + b1.w) * (1.f / 256.f)};
                float hi[8], lo[8];
#pragma unroll
                for (int e = 0; e < 8; ++e) { hi[e] = __uint_as_float(__float_as_uint(km[e]) & 0xffff0000u); lo[e] = km[e] - hi[e]; }
                X = MFMA32(pack8(hi), qf, X); X = MFMA32(pack8(lo), qf, X); }
        }
        float v1 = -INFINITY, v2 = -INFINITY, v3 = -INFINITY; int i1 = 255, i2 = 255, i3 = 255;
#pragma unroll
        for (int i = 0; i < 16; ++i) { const int n = (i & 3) + 8 * (i >> 2) + 4 * hh; top3_insert((n < qb) ? X[i] : -INFINITY, (n < qb) ? n : 255, v1, v2, v3, i1, i2, i3); }
        const float p1 = __shfl_xor(v1, 32), p2 = __shfl_xor(v2, 32), p3 = __shfl_xor(v3, 32); const int j1 = __shfl_xor(i1, 32), j2 = __shfl_xor(i2, 32), j3 = __shfl_xor(i3, 32);
        top3_insert(p1, j1, v1, v2, v3, i1, i2, i3); top3_insert(p2, j2, v1, v2, v3, i1, i2, i3); top3_insert(p3, j3, v1, v2, v3, i1, i2, i3);
        if (hh == 0) { SEL[(size_t)h * T_SEQ + t] = (unsigned)i1 | ((unsigned)i2 << 8) | ((unsigned)i3 << 16);
            float* pl = PLSE + (t * 8 + h) * 3;
            if (i1 == 255) pl[0] = -INFINITY;
            if (i2 == 255) pl[1] = -INFINITY;
            if (i3 == 255) pl[2] = -INFINITY; }
    }
}
__device__ __forceinline__ void moba_stage(const bf16* __restrict__ Z, const bf16* __restrict__ ZT, int h, int kb, LAS unsigned char* lds, int tid) {
    asm volatile("" : "+v"(tid));
    u32x4v kv[8], vv[8];
#pragma unroll
    for (int i = 0; i < 8; ++i) { const int idx = tid + 512 * i, row = idx >> 4, c = idx & 15; kv[i] = *(const u32x4v*)(Z + (size_t)(kb * 256 + row) * NZ + Z_BK + h * 128 + c * 8); }
#pragma unroll
    for (int i = 0; i < 8; ++i) { const int idx = tid + 512 * i, row = idx >> 5, c = idx & 31; vv[i] = *(const u32x4v*)(ZT + (size_t)(ZT_BV + h * 128 + row) * T_SEQ + kb * 256 + c * 8); }
#pragma unroll
    for (int i = 0; i < 8; ++i) { const int idx = tid + 512 * i, row = idx >> 4, c = idx & 15; *(LAS u32x4v*)(lds + row * 256 + ((c ^ (row & 15)) << 4)) = kv[i]; }
#pragma unroll
    for (int i = 0; i < 8; ++i) { const int idx = tid + 512 * i, row = idx >> 5, c = idx & 31; *(LAS u32x4v*)(lds + 65536 + row * 512 + ((c ^ (row & 15)) << 4)) = vv[i]; }
}
__device__ __forceinline__ void moba_tile(const bf16* __restrict__ Z, LAS unsigned char* lds, int h, int nkt, int diag, size_t tq, int qloc, int r, int hh, f32x16 (&acc)[4], float& m_out, float& l_out) {
    bf16x8 qf[8];
    const bf16* qp = Z + tq * NZ + Z_BQ + h * 128 + 8 * hh;
#pragma unroll
    for (int s = 0; s < 8; ++s) qf[s] = *(const bf16x8*)(qp + 16 * s);
#pragma unroll
    for (int dt = 0; dt < 4; ++dt)
#pragma unroll
        for (int i = 0; i < 16; ++i) acc[dt][i] = 0.f;
    float m = -1e30f, l = 0.f;
    const int kr = kperm(r), kx = kr & 15, vx = r & 15;
    for (int kt = 0; kt < nkt; ++kt) {
        f32x16 X;
#pragma unroll
        for (int i = 0; i < 16; ++i) X[i] = 0.f;
        LAS unsigned char* kb_ = lds + (32 * kt + kr) * 256;
#pragma unroll
        for (int s = 0; s < 8; ++s) { const bf16x8 kf = *(const LAS bf16x8*)(kb_ + (((2 * s + hh) ^ kx) << 4)); X = MFMA32(kf, qf[s], X); }
        float mx = -1e30f;
#pragma unroll
        for (int i = 0; i < 16; ++i) { float x = X[i] * MOBA_SCALE; if (kt == diag && (32 * kt + (i & 7) + 8 * hh + 16 * (i >> 3)) > qloc) x = -1e30f; X[i] = x; mx = fmaxf(mx, x); }
        mx = fmaxf(mx, __shfl_xor(mx, 32));
        const float mn = fmaxf(m, mx), alpha = __expf(m - mn);
        l *= alpha;
#pragma unroll
        for (int dt = 0; dt < 4; ++dt)
#pragma unroll
            for (int i = 0; i < 16; ++i) acc[dt][i] *= alpha;
        float P[16];
#pragma unroll
        for (int i = 0; i < 16; ++i) { const float p = (X[i] > -1e29f) ? __expf(X[i] - mn) : 0.f; P[i] = p; l += p; }
        m = mn;
#pragma unroll
        for (int s2 = 0; s2 < 2; ++s2) { const bf16x8 pf = pack8(P + 8 * s2);
#pragma unroll
            for (int dt = 0; dt < 4; ++dt) { const bf16x8 vf = *(const LAS bf16x8*)(lds + 65536 + (32 * dt + r) * 512 + (((4 * kt + 2 * s2 + hh) ^ vx) << 4)); acc[dt] = MFMA32(vf, pf, acc[dt]); } }
    }
    l += __shfl_xor(l, 32);
    m_out = m; l_out = l;
}
constexpr int MOBA_SEGS = 9, MOBA_ITEMS_PER_HEAD = 98, MOBA_ITEMS = 8 * MOBA_ITEMS_PER_HEAD;
__device__ __forceinline__ void moba_gather(const bf16* __restrict__ Z, const bf16* __restrict__ ZT, const unsigned* __restrict__ SEL, bf16* __restrict__ PO, float* __restrict__ PLSE, unsigned* qctr, LAS unsigned char* lds) {
    int tid_ = threadIdx.x; asm volatile("" : "+v"(tid_));
    const int tid = tid_, lane = tid & 63, wave = __builtin_amdgcn_readfirstlane(tid >> 6), r = lane & 31, hh = lane >> 5;
    LAS unsigned* cntp = (LAS unsigned*)(lds + LDS_MISC + 2048); LAS unsigned* lst = (LAS unsigned*)(lds + LDS_MISC + 4096);
    LAS unsigned* itp = (LAS unsigned*)(lds + LDS_MISC + 2048 + 64);
    for (;;) {
        __syncthreads();
        if (tid == 0) *itp = __hip_atomic_fetch_add(qctr, 1u, __ATOMIC_RELAXED, __HIP_MEMORY_SCOPE_AGENT);
        asm volatile("s_waitcnt vmcnt(0) lgkmcnt(0)" ::: "memory"); __syncthreads();
        const int it = (int)*itp; if (it >= MOBA_ITEMS) break;
        const int h = it & 7; int k = it >> 3, seg = 0, sa = 1, sb = 2;
        if (k < 76) { for (;;) { const int cnt = (sa < sb - 1) ? sa : sb - 1; if (k < cnt) break; k -= cnt; ++seg; sa = sb; sb = (seg < 3) ? sb + 1 : (seg < 5 ? sb + 2 : (seg < 7 ? sb + 4 : sb + 8)); } }
        else { k -= 76; for (;;) { const int cnt = (sb - 1 > sa) ? sb - 1 - sa : 0; if (k < cnt) break; k -= cnt; ++seg; sa = sb; sb = (seg < 3) ? sb + 1 : (seg < 5 ? sb + 2 : (seg < 7 ? sb + 4 : sb + 8)); } k += sa; }
        const int n = k, qa = (sa > n + 1) ? sa : n + 1;
        __syncthreads();
        moba_stage(Z, ZT, h, n, lds, tid);
        for (int base = qa * 256; base < sb * 256; base += 1024) {
            if (tid == 0) *cntp = 0u;
            asm volatile("s_waitcnt lgkmcnt(0)" ::: "memory"); __syncthreads();
#pragma unroll
            for (int sub = 0; sub < 2; ++sub) { const int t = base + sub * 512 + tid; int slot = -1;
                if (t < sb * 256) { const unsigned sel = SEL[(size_t)h * T_SEQ + t]; slot = ((sel & 0xffu) == (unsigned)n) ? 0 : ((((sel >> 8) & 0xffu) == (unsigned)n) ? 1 : ((((sel >> 16) & 0xffu) == (unsigned)n) ? 2 : -1)); }
                const unsigned long long bal = __ballot(slot >= 0); const int nb = __popcll(bal);
                unsigned wbase = 0u; if (lane == 0 && nb) wbase = __hip_atomic_fetch_add(cntp, (unsigned)nb, __ATOMIC_RELAXED, __HIP_MEMORY_SCOPE_WORKGROUP);
                wbase = __builtin_amdgcn_readfirstlane(wbase);
                if (slot >= 0) lst[wbase + __popcll(bal & ((1ull << lane) - 1ull))] = (unsigned)t | ((unsigned)slot << 16); }
            asm volatile("s_waitcnt lgkmcnt(0)" ::: "memory"); __syncthreads();
            const int count = (int)*cntp;
            for (int tb = wave * 32; tb < count; tb += 256) {
                const bool live = (tb + r) < count; const unsigned ent = lst[live ? tb + r : tb];
                const size_t tq = ent & 0xffffu; const int slot = (int)(ent >> 16);
                f32x16 acc[4]; float m, l;
                moba_tile(Z, lds, h, 8, -1, tq, 0, r, hh, acc, m, l);
                const float inv = 1.f / l;
                if (live) { bf16* po = PO + (((size_t)tq * 8 + h) * 3 + slot) * 128;
#pragma unroll
                    for (int dt = 0; dt < 4; ++dt)
#pragma unroll
                        for (int gq = 0; gq < 4; ++gq) *(uint2*)(po + 32 * dt + 8 * gq + 4 * hh) = make_uint2(pk_bf16(acc[dt][4 * gq] * inv, acc[dt][4 * gq + 1] * inv), pk_bf16(acc[dt][4 * gq + 2] * inv, acc[dt][4 * gq + 3] * inv));
                    if (hh == 0) PLSE[((size_t)tq * 8 + h) * 3 + slot] = m + __logf(l); }
            }
            __syncthreads();
        }
    }
    __syncthreads();
}
__device__ __forceinline__ void moba_own(const bf16* __restrict__ Z, const bf16* __restrict__ ZT, const bf16* __restrict__ PO, const float* __restrict__ PLSE, bf16* __restrict__ YB, LAS unsigned char* lds) {
    int tid_ = threadIdx.x; asm volatile("" : "+v"(tid_));
    const int tid = tid_, lane = tid & 63, wave = __builtin_amdgcn_readfirstlane(tid >> 6), r = lane & 31, hh = lane >> 5;
    for (int it = blockIdx.x; it < 256; it += gridDim.x) { const int h = it >> 5, qb = it & 31, kd = wave;
        __syncthreads();
        moba_stage(Z, ZT, h, qb, lds, tid);
        asm volatile("s_waitcnt lgkmcnt(0)" ::: "memory"); __syncthreads();
        const size_t tq = (size_t)qb * 256 + 32 * kd + r; const int qloc = 32 * kd + r;
        f32x16 acc[4]; float m, l;
        moba_tile(Z, lds, h, kd + 1, kd, tq, qloc, r, hh, acc, m, l);
        const float* pl = PLSE + (tq * 8 + h) * 3; const float e0 = pl[0], e1 = pl[1], e2 = pl[2];
        const float M = fmaxf(fmaxf(m, e0), fmaxf(e1, e2));
        const float wo = __expf(m - M), w0 = __expf(e0 - M), w1 = __expf(e1 - M), w2 = __expf(e2 - M), inv = 1.f / (l * wo + w0 + w1 + w2);
        const bf16* po = PO + ((tq * 8 + h) * 3) * 128;
        uint2 pp[3][16];
#pragma unroll
        for (int sl = 0; sl < 3; ++sl)
#pragma unroll
            for (int j = 0; j < 16; ++j) pp[sl][j] = *(const uint2*)(po + 128 * sl + 32 * (j >> 2) + 8 * (j & 3) + 4 * hh);
#pragma unroll
        for (int dt = 0; dt < 4; ++dt)
#pragma unroll
            for (int gq = 0; gq < 4; ++gq) { const int d0 = 32 * dt + 8 * gq + 4 * hh, j = 4 * dt + gq;
                float o0 = acc[dt][4 * gq] * wo, o1 = acc[dt][4 * gq + 1] * wo, o2 = acc[dt][4 * gq + 2] * wo, o3 = acc[dt][4 * gq + 3] * wo;
                { const uint2 p = pp[0][j]; const bool on = w0 > 0.f; o0 += on ? w0 * lo_bf(p.x) : 0.f; o1 += on ? w0 * hi_bf(p.x) : 0.f; o2 += on ? w0 * lo_bf(p.y) : 0.f; o3 += on ? w0 * hi_bf(p.y) : 0.f; }
                { const uint2 p = pp[1][j]; const bool on = w1 > 0.f; o0 += on ? w1 * lo_bf(p.x) : 0.f; o1 += on ? w1 * hi_bf(p.x) : 0.f; o2 += on ? w1 * lo_bf(p.y) : 0.f; o3 += on ? w1 * hi_bf(p.y) : 0.f; }
                { const uint2 p = pp[2][j]; const bool on = w2 > 0.f; o0 += on ? w2 * lo_bf(p.x) : 0.f; o1 += on ? w2 * hi_bf(p.x) : 0.f; o2 += on ? w2 * lo_bf(p.y) : 0.f; o3 += on ? w2 * hi_bf(p.y) : 0.f; }
                *(uint2*)(YB + tq * 1024 + h * 128 + d0) = make_uint2(pk_bf16(o0 * inv, o1 * inv), pk_bf16(o2 * inv, o3 * inv)); }
    }
    __syncthreads();
}

typedef const __attribute__((address_space(4))) MegaArgs* KArgs;
#define KP() ({ KArgs kp_ = kp0; asm volatile("" : "+s"(kp_)); kp_; })
__global__ void __launch_bounds__(512, 2) mega(MegaArgs a) {
    extern __shared__ __attribute__((aligned(16))) unsigned char lds_raw[];
    LAS unsigned char* lds = (LAS unsigned char*)lds_raw;
    volatile LAS unsigned* MISC = (volatile LAS unsigned*)(lds + LDS_MISC);
    for (int u = threadIdx.x; u < (LDS_BYTES - LDS_MISC) / 4; u += 512) ((LAS unsigned*)(lds + LDS_MISC))[u] = 0u;
    __syncthreads();
    const KArgs kp0 = (KArgs)__builtin_amdgcn_kernarg_segment_ptr();
    XcdBarrier bar = xcd_barrier_post((unsigned*)(a.ws + WS_CTL) + CW_BAR + a.li * XCD_BAR_WORDS, MISC + 8);
    const int G_ = (int)gridDim.x, c_ = (int)blockIdx.x;
#define IT(f) (KP()->items[it].f)
#define PH(k) (IT(p_lo) <= (k) && (k) < IT(p_hi))
    if (a.do_pro) { convert_range(kp0, lds, 0, CVT_PRO, c_, G_);
        phase_xinit(a.in[0], (float*)(a.ws + WS_X), (bf16*)(a.ws + WS_HN), (float*)(a.ws + WS_SCR + SC_SSQ)); xcd_barrier(bar); }
    for (int it = 0; it < kp0->n_items; ++it) {
        const int l = IT(l), hf = IT(hf), half = hf & 1;
        if (PH(1)) { KArgs kp = KP(); unsigned char* ws = kp->ws; unsigned char* lw = ws + WS_W + (size_t)l * LW_STRIDE;
            pg8::Gemm g{(const bf16*)(ws + WS_HN), (const bf16*)(lw + (half ? LW_GU2 : LW_GU1)), T_SEQ, NGU, DM}; pg8::StaticOrder S; S.init(T_SEQ, NGU, G_, c_);
            PG8_LAS float* tab = (PG8_LAS float*)(lds + LDS_MISC + 1024); int panel = -1; { pg8::Unit u0; if (S.next(0, u0)) { panel = u0.pm; pg8::rstd_table((const float*)(ws + WS_SCR + SC_SSQ), tab, panel, (int)threadIdx.x); } }
            pg8::EpiSwiGLU E{(bf16*)(ws + WS_HID), (const float*)(ws + WS_SCR + SC_SSQ), tab, DFF, panel}; pg8::gemm_phase<pg8::EpiSwiGLU, pg8::StaticOrder, true, true>(lds, g, S, E);
            { const int rem = ((T_SEQ / 256) * (NGU / 256)) % G_, q = 3 * l + (half ? 2 : 0), hi = cvt_slot_hi(q) < CVT_TOTAL ? cvt_slot_hi(q) : CVT_TOTAL;
              if (!(hf & 2) && rem && c_ >= rem && cvt_slot_lo(q) < hi) { KArgs kq = KP(); convert_range(kq, lds, cvt_slot_lo(q), hi, c_ - rem, G_ - rem); } }
            xcd_barrier(bar); }
        if (PH(2)) { KArgs kp = KP(); unsigned char* ws = kp->ws; unsigned char* lw = ws + WS_W + (size_t)l * LW_STRIDE;
            pg8::Gemm g{(const bf16*)(ws + WS_HID), (const bf16*)(lw + (half ? LW_D2 : LW_D1)), T_SEQ, DM, DFF}; pg8::StaticOrder S; S.init(T_SEQ, DM, G_, c_);
            pg8::EpiResAdd E{(float*)(ws + WS_X), (bf16*)(ws + WS_HN), (float*)(ws + WS_SCR + SC_SSQ), DM, (hf & 2) ? 0.f : 0.5f}; pg8::gemm_phase<pg8::EpiResAdd, pg8::StaticOrder, true, true>(lds, g, S, E); xcd_barrier(bar); }
        if (half == 0) {
            if (PH(4)) { KArgs kp = KP(); unsigned char* ws = kp->ws; unsigned char* lw = ws + WS_W + (size_t)l * LW_STRIDE;
                pg8::Gemm g{(const bf16*)(ws + WS_HN), (const bf16*)(lw + LW_IN), T_SEQ, NZP, DM}; pg8::ZOrder S; S.init(T_SEQ, NZP, G_, c_);
                PG8_LAS float* tab = (PG8_LAS float*)(lds + LDS_MISC + 1024); int panel = -1; { pg8::Unit u0; if (S.next(0, u0)) { panel = (u0.aux == 2) ? u0.pn : u0.pm; pg8::rstd_table((const float*)(ws + WS_SCR + SC_SSQ), tab, panel, (int)threadIdx.x); } }
                pg8::EpiZ E{(bf16*)(ws + WS_Z), (float*)(ws + WS_G), (bf16*)(ws + WS_ZT), (const float*)(ws + WS_SCR + SC_SSQ), tab, NZ, T_SEQ, panel, 0}; pg8::gemm_phase<pg8::EpiZ, pg8::ZOrder, true, true>(lds, g, S, E);
                { const int rem = ((T_SEQ / 256) * (NZP / 256)) % G_, q = 3 * l + 1, hi = cvt_slot_hi(q) < CVT_TOTAL ? cvt_slot_hi(q) : CVT_TOTAL;
                  if (!(hf & 2) && rem && c_ >= rem && cvt_slot_lo(q) < hi) { KArgs kq = KP(); convert_range(kq, lds, cvt_slot_lo(q), hi, c_ - rem, G_ - rem); } }
                xcd_barrier(bar); }
            if (PH(5)) {
#if MIX_MOBA
                { KArgs kp = KP(); unsigned char* ws = kp->ws; moba_kmean((const bf16*)(ws + WS_Z), (float*)(ws + WS_SCR + SC_KM)); }
#endif
#if MIX_ML
                { KArgs kp = KP(); unsigned char* ws = kp->ws; ml_ktrans((const bf16*)(ws + WS_Z), (bf16*)(ws + WS_SCR + SC_AKT), lds); }
#endif
#if MIX_LRU
                { KArgs kp = KP(); unsigned char* ws = kp->ws; unsigned char* lw = ws + WS_W + (size_t)l * LW_STRIDE;
                  lru_pass<1>((const bf16*)(ws + WS_Z), (const bf16*)(lw + LW_LRU), kp->in[10] + (size_t)l * 4096, kp->in[11] + (size_t)l * 1024, kp->in[13] + (size_t)l * 1024, kp->in[15] + (size_t)l * 1024, kp->in[16] + (size_t)l * 1024,
                              (float2*)(ws + WS_SCR + SC_CARRY), (bf16*)(ws + WS_YC), lds); }
#endif
                xcd_barrier(bar); }
            if (PH(6)) {
#if MIX_MOBA
                { KArgs kp = KP(); unsigned char* ws = kp->ws; unsigned char* sc = ws + WS_SCR; moba_select((const bf16*)(ws + WS_Z), (const float*)(sc + SC_KM), (unsigned*)(sc + SC_SEL), (float*)(sc + SC_PLSE), lds); }
#endif
#if MIX_ML
                { KArgs kp = KP(); unsigned char* ws = kp->ws; unsigned char* sc = ws + WS_SCR;
                  ml_local((const bf16*)(ws + WS_ZT), (const bf16*)(sc + SC_AKT), (const float*)(ws + WS_G), kp->in[7] + l * 4, kp->in[8] + l * 4, (float*)(sc + SC_LST), (float*)(sc + SC_NL), (float2*)(sc + SC_BG), lds); }
#endif
#if MIX_LRU
                { KArgs kp = KP(); unsigned char* ws = kp->ws; unsigned char* lw = ws + WS_W + (size_t)l * LW_STRIDE;
                  lru_pass<2>((const bf16*)(ws + WS_Z), (const bf16*)(lw + LW_LRU), kp->in[10] + (size_t)l * 4096, kp->in[11] + (size_t)l * 1024, kp->in[13] + (size_t)l * 1024, kp->in[15] + (size_t)l * 1024, kp->in[16] + (size_t)l * 1024,
                              (float2*)(ws + WS_SCR + SC_CARRY), (bf16*)(ws + WS_YC), lds); }
#endif
                xcd_barrier(bar); }
            if (PH(7)) {
#if MIX_MOBA
                { KArgs kp = KP(); unsigned char* ws = kp->ws; unsigned char* sc = ws + WS_SCR; moba_gather((const bf16*)(ws + WS_Z), (const bf16*)(ws + WS_ZT), (const unsigned*)(sc + SC_SEL), (bf16*)(sc + SC_PO), (float*)(sc + SC_PLSE), (unsigned*)(ws + WS_CTL) + CW_Q + it, lds); }
#endif
#if MIX_ML
                { KArgs kp = KP(); unsigned char* sc = kp->ws + WS_SCR;
                  ml_scan((const float*)(sc + SC_LST), (const float*)(sc + SC_NL), (const float2*)(sc + SC_BG), (bf16*)(sc + SC_CST), (float*)(sc + SC_NST), (float*)(sc + SC_MST)); }
#endif
                xcd_barrier(bar); }
            if (PH(8)) {
#if MIX_MOBA
                { KArgs kp = KP(); unsigned char* ws = kp->ws; unsigned char* sc = ws + WS_SCR; moba_own((const bf16*)(ws + WS_Z), (const bf16*)(ws + WS_ZT), (const bf16*)(sc + SC_PO), (const float*)(sc + SC_PLSE), (bf16*)(ws + WS_YB), lds); }
#endif
#if MIX_ML
                { KArgs kp = KP(); unsigned char* ws = kp->ws; unsigned char* sc = ws + WS_SCR;
                  ml_out((const bf16*)(ws + WS_Z), (const bf16*)(ws + WS_ZT), (const float*)(ws + WS_G), kp->in[7] + l * 4, kp->in[8] + l * 4, (const bf16*)(sc + SC_CST), (const float*)(sc + SC_NST), (const float*)(sc + SC_MST),
                         kp->in[9] + (size_t)l * 1024, (bf16*)(ws + WS_YA), lds); }
#endif
                xcd_barrier(bar); }
            if (PH(9)) { KArgs kp = KP(); unsigned char* ws = kp->ws; unsigned char* lw = ws + WS_W + (size_t)l * LW_STRIDE;
                pg8::Gemm g{(const bf16*)(ws + WS_YA), (const bf16*)(lw + LW_UPA), T_SEQ, DM, 1024}; pg8::MergeOrder S; S.init(T_SEQ, DM, G_, c_); S.astride = SZ_Y / 2; S.bstride = SZ_WUP / 2;
                pg8::EpiMerge E{(bf16*)(ws + WS_MG), (const bf16*)(ws + WS_Z) + Z_GA, DM, NZ, 2048, 0}; pg8::gemm_phase<pg8::EpiMerge, pg8::MergeOrder, true, true>(lds, g, S, E); xcd_barrier(bar); }
            if (PH(10)) { KArgs kp = KP(); unsigned char* ws = kp->ws; unsigned char* lw = ws + WS_W + (size_t)l * LW_STRIDE;
                pg8::Gemm g{(const bf16*)(ws + WS_MG), (const bf16*)(lw + LW_OUT), T_SEQ, DM, DM}; pg8::StaticOrder S; S.init(T_SEQ, DM, G_, c_);
                pg8::EpiResAdd E{(float*)(ws + WS_X), (bf16*)(ws + WS_HN), (float*)(ws + WS_SCR + SC_SSQ), DM, (hf & 2) ? 0.f : 1.0f}; pg8::gemm_phase<pg8::EpiResAdd, pg8::StaticOrder, true, true>(lds, g, S, E); xcd_barrier(bar); }
        }
    }
    if (a.do_fin) phase_final((const bf16*)(a.ws + WS_HN), a.in[25], a.out);
#undef PH
#undef IT
}
extern "C" void kernel_launch(void* const* d_in, const int* in_sizes, int n_in, void* d_out, int out_size, void* d_ws, size_t ws_size, hipStream_t stream) {
    if (n_in != 26 || out_size != T_SEQ * DM || ws_size < WS_END) { fprintf(stderr, "kernel_launch: unexpected problem (n_in %d out %d ws %zu need %zu)\n", n_in, out_size, ws_size, (size_t)WS_END); return; }
    static int grid = 0;
    if (!grid) { int dev = 0, cus = 0, per_cu = 0; (void)hipGetDevice(&dev); (void)hipDeviceGetAttribute(&cus, hipDeviceAttributeMultiprocessorCount, dev);
        (void)hipFuncSetAttribute((const void*)mega, hipFuncAttributeMaxDynamicSharedMemorySize, LDS_BYTES);
        if (hipOccupancyMaxActiveBlocksPerMultiprocessor(&per_cu, (const void*)mega, 512, LDS_BYTES) != hipSuccess || per_cu < 1) fprintf(stderr, "kernel_launch: occupancy query reports %d blocks per CU\n", per_cu);
        (void)hipGetLastError();
        grid = 256; if (cus != 256) fprintf(stderr, "kernel_launch: built for 256 CUs (one workgroup per CU), device reports %d\n", cus); }
    unsigned char* ws = (unsigned char*)d_ws;
    (void)hipMemsetAsync(ws + WS_CTL, 0, CTL_BYTES, stream);
    MegaArgs a; memset(&a, 0, sizeof a); for (int i = 0; i < 26; ++i) a.in[i] = (const float*)d_in[i]; a.out = (float*)d_out; a.ws = ws;
    a.do_pro = 1; a.do_fin = 1; a.li = 0; int n = 0;
    for (int l = 0; l < NLAYER; ++l) {
        a.items[n++] = PItem{l, 0, 0, 11};
#ifdef DUP_LO
        a.items[n++] = PItem{l, 2 | DUP_HF, DUP_LO, DUP_HI};
#endif
        a.items[n++] = PItem{l, 1, 0, 11}; }
    a.n_items = n;
    hipLaunchKernelGGL(mega, dim3(grid), dim3(512), LDS_BYTES, stream, a);
}
```

```cpp
#include <hip/hip_runtime.h>
#include <cstdio>
#include <cstdint>
#include <cstring>
#define LAS __attribute__((address_space(3)))
typedef unsigned short bf16;
constexpr int T_SEQ = 8192, DM = 2048, DFF = 5504, NLAYER = 4;
constexpr int NGU = 2 * DFF;
constexpr int NZ = 13312;
constexpr int NZP = 15616;
constexpr int NZT = 2048;
constexpr int Z_AQ = 0, Z_AK = 1024, Z_AO = 2048, Z_BQ = 3072, Z_BK = 4096, Z_CX = 5120, Z_CG = 6144, Z_GA = 7168, Z_GB = 9216, Z_GC = 11264;
constexpr int ZT_AV = 0, ZT_BV = 1024;
constexpr float RMS_EPS = 1e-6f;
__device__ __forceinline__ float bf2f(unsigned short b) { return __uint_as_float(((unsigned)b) << 16); }
__device__ __forceinline__ unsigned short f2bf(float f) { unsigned u = __float_as_uint(f); return (unsigned short)((u + 0x7fffu + ((u >> 16) & 1u)) >> 16); }
__device__ __forceinline__ float sigmoidf_(float x) { return __builtin_amdgcn_rcpf(1.f + __expf(-x)); }
__device__ __forceinline__ float lo_bf(unsigned w) { return __uint_as_float(w << 16); }
__device__ __forceinline__ float hi_bf(unsigned w) { return __uint_as_float(w & 0xffff0000u); }
__device__ __forceinline__ int win_src_col(int n) {
    if (n < 2048) return n;
    if (n < 3072) return 3072 + (n - 2048);
    if (n < 5120) return n + 1032;
    if (n < 13312) return n + 2056;
    if (n < 13320) return 4096 + (n - 13312);
    if (n < 13568) return -1;
    if (n < 14592) return 2048 + (n - 13568);
    return 6152 + (n - 14592);
}
#define MIX_LRU 1
#define MIX_ML 1
#define MIX_MOBA 1
namespace pg8 {
#define PG8_LAS __attribute__((address_space(3)))
typedef unsigned short bf16_t;
typedef short bf16x8 __attribute__((ext_vector_type(8)));
typedef float f32x4 __attribute__((ext_vector_type(4)));
typedef unsigned u32x4 __attribute__((ext_vector_type(4)));
constexpr int BM = 256, BK = 64, HALF = 128, HTB = HALF * BK * 2  , STAGE_BYTES = 8 * HTB, NXCD = 8, WGM = 8;

__host__ __device__ __forceinline__ int lds_byte(int r, int c) { const int st = (r >> 4) * 2 + (c >> 5), rr = r & 15, cc = c & 31, ob = rr * 64 + cc * 2; return st * 1024 + (ob ^ (((ob >> 9) & 1) << 5)); }
__host__ __device__ __forceinline__ void stage_rc(int b, int& R, int& C) { const int st = b / 1024, sb = b % 1024, swz = sb ^ (((sb >> 9) & 1) << 5); R = (st >> 1) * 16 + swz / 64; C = (st & 1) * 32 + (swz % 64) / 2; }
__host__ __device__ __forceinline__ int perm32(int rho) { const int n = rho >> 4, i = rho & 15; return 8 * (i >> 2) + 4 * n + (i & 3); }

struct Unit { int pm, pn, aux; };
struct Gemm { const bf16_t* A; const bf16_t* Bt; int M, N, K; };

struct StaticOrder {
    int nM, nN, nwg, G, c;
    __host__ __device__ void init(int M, int N, int G_, int c_) { nM = M / BM; nN = N / BM; nwg = nM * nN; G = G_; c = c_; }
    __host__ __device__ __forceinline__ bool next(int i, Unit& u) const {
        const long L = (long)i * G + c; if (L >= nwg) return false;
        int wgid = (int)L; { const int q = nwg / NXCD, r = nwg % NXCD, xcd = wgid % NXCD, off = wgid / NXCD; wgid = (xcd < r ? xcd * (q + 1) : r * (q + 1) + (xcd - r) * q) + off; }
        const int nig = WGM * nN, gid = wgid / nig, fm = gid * WGM, gsz = (nM - fm) < WGM ? (nM - fm) : WGM;
        u.pm = fm + ((wgid % nig) % gsz); u.pn = (wgid % nig) / gsz; u.aux = 0; return true;
    }
    __device__ __forceinline__ void bases(const Gemm& g, const Unit& u, size_t tstep, const char*& a, const char*& b) const { a = (const char*)g.A + (size_t)u.pm * tstep; b = (const char*)g.Bt + (size_t)u.pn * tstep; }
    __device__ __forceinline__ void a_ready(const Unit&) const {}
    __device__ __forceinline__ void done(const Unit&) const {}
};
__device__ __forceinline__ unsigned cvt_pk_bf16(float lo, float hi) { unsigned r; asm volatile("v_cvt_pk_bf16_f32 %0, %1, %2" : "=v"(r) : "v"(lo), "v"(hi)); return r; }
typedef float f32x2 __attribute__((ext_vector_type(2)));
typedef unsigned u32x2 __attribute__((ext_vector_type(2)));
__device__ __forceinline__ float fast_sigmoid(float x) { return __builtin_amdgcn_rcpf(1.f + __expf(-x)); }
__device__ __forceinline__ void row_rstd8(const PG8_LAS float* tab, int rloc, float (&rs)[2][4]) {
#pragma unroll
    for (int ai = 0; ai < 2; ++ai)
#pragma unroll
        for (int m = 0; m < 4; ++m) rs[ai][m] = tab[rloc + ai * HALF + m * 16];
}
__device__ __forceinline__ void rstd_table(const float* SSQ, PG8_LAS float* tab, int panel, int tid) {
    asm volatile("" : "+v"(tid));
    const float* p = SSQ + ((size_t)panel * BM + (tid >> 1)) * 32 + (tid & 1) * 16; float t = 0.f;
#pragma unroll
    for (int q = 0; q < 4; ++q) { const f32x4 a = *(const f32x4*)(p + 4 * q); t += (a[0] + a[1]) + (a[2] + a[3]); }
    t += __shfl_xor(t, 1);
    if ((tid & 1) == 0) tab[tid >> 1] = __builtin_amdgcn_rsqf(t * (1.f / 2048.f) + 1e-6f);
    asm volatile("s_waitcnt lgkmcnt(0)" ::: "memory"); __builtin_amdgcn_s_barrier(); asm volatile("" ::: "memory");
}
struct EpiSwiGLU {
    static constexpr bool PERM = true, AFTER_DRAIN = false, KEEP_ACC = false;
    bf16_t* O; const float* SSQ; const PG8_LAS float* tab; int ldc; int panel;
    __device__ __forceinline__ void operator()(const f32x4 (&acc)[2][2][4][2], const Unit& u, int wr, int wc, int fr, int fq) const {
        const int row0 = u.pm * BM + wr * 64 + fr, col0 = u.pn * HALF + wc * 32 + 8 * fq;
        float rs[2][4]; row_rstd8(tab, wr * 64 + fr, rs);
#pragma unroll
        for (int ai = 0; ai < 2; ++ai)
#pragma unroll
            for (int m = 0; m < 4; ++m) { bf16_t* rowp = O + (size_t)(row0 + ai * HALF + m * 16) * ldc + col0;
                const f32x2 r2 = (f32x2){rs[ai][m], rs[ai][m]}; f32x2 h2[4];
#pragma unroll
                for (int n = 0; n < 2; ++n)
#pragma unroll
                    for (int q = 0; q < 2; ++q) { const f32x2 g = (f32x2){acc[ai][0][m][n][2 * q], acc[ai][0][m][n][2 * q + 1]} * r2, up = (f32x2){acc[ai][1][m][n][2 * q], acc[ai][1][m][n][2 * q + 1]} * r2;
                        const f32x2 t = g * (-1.4426950408889634f); f32x2 d; d.x = __builtin_amdgcn_exp2f(t.x); d.y = __builtin_amdgcn_exp2f(t.y); d = d + 1.0f;
                        f32x2 rc; rc.x = __builtin_amdgcn_rcpf(d.x); rc.y = __builtin_amdgcn_rcpf(d.y); h2[n * 2 + q] = (g * up) * rc; }
                u32x4 w; w.x = cvt_pk_bf16(h2[0].x, h2[0].y); w.y = cvt_pk_bf16(h2[1].x, h2[1].y); w.z = cvt_pk_bf16(h2[2].x, h2[2].y); w.w = cvt_pk_bf16(h2[3].x, h2[3].y);
                *(u32x4*)rowp = w; }
    }
};
struct EpiResAdd {
    static constexpr bool PERM = false, AFTER_DRAIN = false, KEEP_ACC = false;
    float* X; bf16_t* XB; float* SSQ; int ldc; float alpha;
    __device__ __forceinline__ void operator()(const f32x4 (&acc)[2][2][4][2], const Unit& u, int wr, int wc, int fr, int fq) const {
        const int row0 = u.pm * BM + wr * 64 + fr, col0 = u.pn * BM + wc * 32 + 4 * fq;
        u32x2 xv[3][4];
#define RA_LOAD(rg, b) do { const bf16_t* rp_ = XB + (size_t)(row0 + ((rg) >> 2) * HALF + ((rg) & 3) * 16) * ldc + col0; \
            xv[b][0] = *(const u32x2*)(rp_); xv[b][1] = *(const u32x2*)(rp_ + 16); xv[b][2] = *(const u32x2*)(rp_ + HALF); xv[b][3] = *(const u32x2*)(rp_ + HALF + 16); } while (0)
        RA_LOAD(0, 0); RA_LOAD(1, 1);
#pragma unroll
        for (int rg = 0; rg < 8; ++rg) { const int ai = rg >> 2, m = rg & 3;
            if (rg + 2 < 8) RA_LOAD(rg + 2, (rg + 2) % 3);
            const size_t row = (size_t)(row0 + ai * HALF + m * 16); bf16_t* rowb = XB + row * ldc + col0; float ss = 0.f;
#pragma unroll
            for (int bj = 0; bj < 2; ++bj)
#pragma unroll
                for (int n = 0; n < 2; ++n) { const u32x2 o = xv[rg % 3][bj * 2 + n]; const f32x4 p = acc[ai][bj][m][n] * alpha;
                    u32x2 w; w.x = cvt_pk_bf16(__uint_as_float(o.x << 16) + p[0], __uint_as_float(o.x & 0xffff0000u) + p[1]); w.y = cvt_pk_bf16(__uint_as_float(o.y << 16) + p[2], __uint_as_float(o.y & 0xffff0000u) + p[3]);
                    *(u32x2*)(rowb + bj * HALF + n * 16) = w;
                    const float r0 = __uint_as_float(w.x << 16), r1 = __uint_as_float(w.x & 0xffff0000u), r2 = __uint_as_float(w.y << 16), r3 = __uint_as_float(w.y & 0xffff0000u);
                    ss += (r0 * r0 + r1 * r1) + (r2 * r2 + r3 * r3); }
            ss += __shfl_xor(ss, 16); ss += __shfl_xor(ss, 32);
            if (fq == 0) SSQ[row * 32 + u.pn * 4 + wc] = ss; }
#undef RA_LOAD
    }
};
struct EpiZ {
    static constexpr bool PERM = true, AFTER_DRAIN = false, KEEP_ACC = false;
    bf16_t* Z; float* G; bf16_t* ZT; const float* SSQ; const PG8_LAS float* tab; int ldz; int ldt; int panel; int pad;
    __device__ __forceinline__ void operator()(const f32x4 (&acc)[2][2][4][2], const Unit& u, int wr, int wc, int fr, int fq) const {
        const int row0 = u.pm * BM + wr * 64 + fr;
        if (u.aux == 0) {
            float rs[2][4]; row_rstd8(tab, wr * 64 + fr, rs);
            const int col0 = u.pn * BM + wc * 64 + 8 * fq;
#pragma unroll
            for (int ai = 0; ai < 2; ++ai)
#pragma unroll
                for (int m = 0; m < 4; ++m) { bf16_t* rowp = Z + (size_t)(row0 + ai * HALF + m * 16) * ldz + col0; const float r = rs[ai][m];
#pragma unroll
                    for (int bj = 0; bj < 2; ++bj) { const f32x4 v0 = acc[ai][bj][m][0] * r, v1 = acc[ai][bj][m][1] * r;
                        u32x4 w; w.x = cvt_pk_bf16(v0[0], v0[1]); w.y = cvt_pk_bf16(v0[2], v0[3]); w.z = cvt_pk_bf16(v1[0], v1[1]); w.w = cvt_pk_bf16(v1[2], v1[3]);
                        *(u32x4*)(rowp + bj * 32) = w; } }
        } else if (u.aux == 1) {
            float rs[2][4]; row_rstd8(tab, wr * 64 + fr, rs);
            if (wc == 0 && fq == 0) {
#pragma unroll
                for (int ai = 0; ai < 2; ++ai)
#pragma unroll
                    for (int m = 0; m < 4; ++m) { float* gp = G + (size_t)(row0 + ai * HALF + m * 16) * 8;
                        *(f32x4*)gp = acc[ai][0][m][0] * rs[ai][m]; *(f32x4*)(gp + 4) = acc[ai][0][m][1] * rs[ai][m]; } }
        } else {
            const int tb = u.pn * BM + wc * 32 + 8 * fq; float rt[16];
#pragma unroll
            for (int j = 0; j < 16; ++j) rt[j] = tab[wc * 32 + 8 * fq + 128 * (j >> 3) + (j & 7)];
            const int col0 = tb;
#pragma unroll
            for (int ai = 0; ai < 2; ++ai)
#pragma unroll
                for (int m = 0; m < 4; ++m) { bf16_t* rowp = ZT + (size_t)(row0 + ai * HALF + m * 16) * ldt + col0;
#pragma unroll
                    for (int bj = 0; bj < 2; ++bj) { const f32x4 v0 = acc[ai][bj][m][0], v1 = acc[ai][bj][m][1];
                        u32x4 w; w.x = cvt_pk_bf16(v0[0] * rt[8 * bj], v0[1] * rt[8 * bj + 1]); w.y = cvt_pk_bf16(v0[2] * rt[8 * bj + 2], v0[3] * rt[8 * bj + 3]);
                        w.z = cvt_pk_bf16(v1[0] * rt[8 * bj + 4], v1[1] * rt[8 * bj + 5]); w.w = cvt_pk_bf16(v1[2] * rt[8 * bj + 6], v1[3] * rt[8 * bj + 7]);
                        *(u32x4*)(rowp + bj * HALF) = w; } }
        }
    }
};
struct ZOrder : StaticOrder {
    __device__ __forceinline__ bool next(int i, Unit& u) const {
        if (!StaticOrder::next(i, u)) return false;
        const int v = u.pn;
        if (v < 52) u.aux = 0; else if (v == 52) u.aux = 1; else { u.aux = 2; u.pn = u.pm; u.pm = v - 53; }
        return true;
    }
    __device__ __forceinline__ void bases(const Gemm& g, const Unit& u, size_t tstep, const char*& a, const char*& b) const {
        if (u.aux == 2) { a = (const char*)g.Bt + (size_t)(53 + u.pm) * tstep; b = (const char*)g.A + (size_t)u.pn * tstep; }
        else { a = (const char*)g.A + (size_t)u.pm * tstep; b = (const char*)g.Bt + (size_t)u.pn * tstep; }
    }
};
struct EpiMerge {
    static constexpr bool PERM = true, AFTER_DRAIN = false, KEEP_ACC = true;
    bf16_t* MG; const bf16_t* Zg; static constexpr int ldm = 2048, ldz = 13312, gstride = 2048;
    __device__ __forceinline__ void operator()(f32x4 (&acc)[2][2][4][2], const Unit& u, int wr, int wc, int fr, int fq) const {
        const int row0 = u.pm * BM + wr * 64 + fr, col0 = u.pn * BM + wc * 32 + 8 * fq; const bf16_t* za = Zg + (size_t)u.aux * gstride; const bf16_t* zb = za + gstride;
        if (u.aux < 2) {
#pragma unroll
            for (int st = 0; st < 16; ++st) { const int ai = st >> 3, m = (st >> 1) & 3, bj = st & 1;
                const size_t r = (size_t)(row0 + ai * HALF + m * 16); const int c = col0 + bj * HALF;
                const u32x4 ga = *(const u32x4*)(za + r * ldz + c), gb = *(const u32x4*)(zb + r * ldz + c);
#pragma unroll
                for (int j = 0; j < 4; ++j) { const unsigned wa = ga[j], wb = gb[j];
                    const float a0 = fminf(fmaxf(__uint_as_float(wa << 16), -30.f), 30.f), a1 = fminf(fmaxf(__uint_as_float(wa & 0xffff0000u), -30.f), 30.f);
                    const float b0 = fminf(fmaxf(__uint_as_float(wb << 16), -30.f), 30.f), b1 = fminf(fmaxf(__uint_as_float(wb & 0xffff0000u), -30.f), 30.f);
                    const float r0 = (1.f + __expf(-b0)) * __builtin_amdgcn_rcpf(1.f + __expf(-a0)), r1 = (1.f + __expf(-b1)) * __builtin_amdgcn_rcpf(1.f + __expf(-a1));
                    acc[ai][bj][m][j >> 1][(j & 1) * 2] *= r0; acc[ai][bj][m][j >> 1][(j & 1) * 2 + 1] *= r1; }
                if ((st & 3) == 3) asm volatile("" ::: "memory"); }
        } else {
#pragma unroll
            for (int st = 0; st < 16; ++st) { const int ai = st >> 3, m = (st >> 1) & 3, bj = st & 1;
                const size_t r = (size_t)(row0 + ai * HALF + m * 16); const int c = col0 + bj * HALF;
                const u32x4 ga = *(const u32x4*)(za + r * ldz + c);
                float o[8];
#pragma unroll
                for (int j = 0; j < 4; ++j) { const unsigned wa = ga[j];
                    const float a0 = fminf(fmaxf(__uint_as_float(wa << 16), -30.f), 30.f), a1 = fminf(fmaxf(__uint_as_float(wa & 0xffff0000u), -30.f), 30.f);
                    o[2 * j] = acc[ai][bj][m][j >> 1][(j & 1) * 2] * fast_sigmoid(a0); o[2 * j + 1] = acc[ai][bj][m][j >> 1][(j & 1) * 2 + 1] * fast_sigmoid(a1); }
                u32x4 w; w.x = cvt_pk_bf16(o[0], o[1]); w.y = cvt_pk_bf16(o[2], o[3]); w.z = cvt_pk_bf16(o[4], o[5]); w.w = cvt_pk_bf16(o[6], o[7]);
                *(u32x4*)(MG + r * ldm + c) = w;
                if ((st & 3) == 3) asm volatile("" ::: "memory"); }
        }
    }
};
struct MergeOrder : StaticOrder {
    static constexpr size_t astride = (size_t)8192 * 1024, bstride = (size_t)2048 * 1024;
    __device__ __forceinline__ bool next(int i, Unit& u) const { if (!StaticOrder::next(i / 3, u)) return false; u.aux = i % 3; return true; }
    __device__ __forceinline__ void bases(const Gemm& g, const Unit& u, size_t tstep, const char*& a, const char*& b) const {
        a = (const char*)(g.A + (size_t)u.aux * astride) + (size_t)u.pm * tstep; b = (const char*)(g.Bt + (size_t)u.aux * bstride) + (size_t)u.pn * tstep; }
};
template <class Epi, class Sched, bool ALIGN_EPI = false, bool SP2 = false>
__device__ __forceinline__ void gemm_phase(PG8_LAS unsigned char* lds, const Gemm g, const Sched& S, const Epi& E) {
    int tid_ = threadIdx.x; asm volatile("" : "+v"(tid_));
    const int tid = tid_, wid = __builtin_amdgcn_readfirstlane(tid >> 6), lane = tid & 63, wr = wid >> 2, wc = wid & 3, fr = lane & 15, fq = lane >> 4;
    const int K = g.K, nt = K / BK;
    unsigned voffA[2], voffB[2];
#pragma unroll
    for (int i = 0; i < 2; ++i) { int R, C; stage_rc(tid * 16 + i * 8192, R, C); const int Rb = Epi::PERM ? ((R & ~31) + perm32(R & 31)) : R;
        voffA[i] = (unsigned)(R * K + C) * 2u; voffB[i] = (unsigned)(Rb * K + C) * 2u; }
    const size_t kstep = (size_t)(BK * 2);
    const size_t hstep = (size_t)HALF * K * 2;
    const size_t tstep = 2 * hstep;
    const unsigned ldsw = (unsigned)wid * 1024u;
    const int aoff = lds_byte(wr * 64 + fr, fq * 8), boff = lds_byte(wc * 32 + fr, fq * 8);
#define PG8_SA(b, h) (((b) * 2 + (h)) * HTB)
#define PG8_SB(b, h) ((4 + (b) * 2 + (h)) * HTB)
#define PG8_STAGE(bufoff, gbase, voff) do { _Pragma("unroll") for (int _i = 0; _i < 2; ++_i) \
        __builtin_amdgcn_global_load_lds((const unsigned*)((const char*)(gbase) + (voff)[_i]), (PG8_LAS unsigned*)(lds + (bufoff) + ldsw + _i * 8192), 16, 0, 0); } while (0)
#define PG8_LDA(dst, b, h) do { _Pragma("unroll") for (int m = 0; m < 4; ++m) _Pragma("unroll") for (int k = 0; k < 2; ++k) dst[m][k] = *(const PG8_LAS bf16x8*)(lds + PG8_SA(b, h) + aoff + m * 2048 + k * 1024); } while (0)
#define PG8_LDB(dst, b, h) do { _Pragma("unroll") for (int n = 0; n < 2; ++n) _Pragma("unroll") for (int k = 0; k < 2; ++k) dst[n][k] = *(const PG8_LAS bf16x8*)(lds + PG8_SB(b, h) + boff + n * 2048 + k * 1024); } while (0)
#define PG8_MMA(ai, bj, At, Bt) do { __builtin_amdgcn_s_setprio(1); _Pragma("unroll") for (int m = 0; m < 4; ++m) _Pragma("unroll") for (int n = 0; n < 2; ++n) _Pragma("unroll") for (int k = 0; k < 2; ++k) \
        acc[ai][bj][m][n] = __builtin_amdgcn_mfma_f32_16x16x32_bf16(Bt[n][k], At[m][k], acc[ai][bj][m][n], 0, 0, 0); __builtin_amdgcn_s_setprio(0); } while (0)
#define PG8_WAIT_V(n) asm volatile("s_waitcnt vmcnt(" #n ")" ::: "memory")
#define PG8_WAIT_L(n) asm volatile("s_waitcnt lgkmcnt(" #n ")" ::: "memory")
#define PG8_BAR __builtin_amdgcn_s_barrier()
#define PG8_SCHED __builtin_amdgcn_sched_barrier(0)
    Unit cur, nxt; int ui = 0;
    if (!S.next(0, cur)) return;
    f32x4 acc[2][2][4][2];
#pragma unroll
    for (int a = 0; a < 2; ++a)
#pragma unroll
        for (int b = 0; b < 2; ++b)
#pragma unroll
            for (int m = 0; m < 4; ++m)
#pragma unroll
                for (int n = 0; n < 2; ++n) acc[a][b][m][n] = (f32x4){0.f, 0.f, 0.f, 0.f};
    bf16x8 At[4][2], B0[2][2], B1[2][2];
    const char* cA; const char* cB; S.bases(g, cur, tstep, cA, cB);
    S.a_ready(cur);
    if constexpr (SP2) {
        PG8_STAGE(PG8_SB(0, 0), cB, voffB); PG8_STAGE(PG8_SB(0, 1), cB + hstep, voffB); PG8_STAGE(PG8_SA(0, 0), cA, voffA); PG8_STAGE(PG8_SA(0, 1), cA + hstep, voffA);
        if (wr == 1) PG8_BAR;
        PG8_WAIT_V(2); PG8_BAR;
        PG8_STAGE(PG8_SB(1, 0), cB + kstep, voffB); PG8_STAGE(PG8_SA(1, 0), cA + kstep, voffA); PG8_STAGE(PG8_SB(1, 1), cB + hstep + kstep, voffB);
        PG8_WAIT_V(6); PG8_BAR;
    } else {
        PG8_STAGE(PG8_SB(0, 0), cB, voffB); PG8_STAGE(PG8_SA(0, 0), cA, voffA); PG8_STAGE(PG8_SB(0, 1), cB + hstep, voffB); PG8_STAGE(PG8_SA(0, 1), cA + hstep, voffA);
        if (wr == 1) PG8_BAR;
        PG8_WAIT_V(4); PG8_BAR;
        PG8_STAGE(PG8_SB(1, 0), cB + kstep, voffB); PG8_STAGE(PG8_SA(1, 0), cA + kstep, voffA); PG8_STAGE(PG8_SB(1, 1), cB + hstep + kstep, voffB);
        PG8_WAIT_V(6); PG8_BAR;
    }
    for (;;) {
        const bool has_next = S.next(ui + 1, nxt);
        const char* nA = cA; const char* nB = cB; if (has_next) S.bases(g, nxt, tstep, nA, nB);
        for (int t = 0; t < nt; t += 2) {
            const bool last = (t == nt - 2);
            const char* a1 = cA + (size_t)(t + 1) * kstep;
            const char* a2 = last ? nA : cA + (size_t)(t + 2) * kstep; const char* b2 = last ? nB : cB + (size_t)(t + 2) * kstep;
            const char* a3 = a2 + kstep; const char* b3 = b2 + kstep;
            if (last && has_next) S.a_ready(nxt);
            if constexpr (SP2) {
            PG8_LDB(B0, 0, 0); PG8_LDB(B1, 0, 1); PG8_SCHED; PG8_LDA(At, 0, 0); PG8_STAGE(PG8_SA(1, 1), a1 + hstep, voffA);
            PG8_WAIT_V(8); PG8_WAIT_L(0); PG8_BAR; PG8_MMA(0, 0, At, B0); PG8_MMA(0, 1, At, B1); PG8_BAR; PG8_SCHED;
            PG8_LDA(At, 0, 1); PG8_STAGE(PG8_SB(0, 0), b2, voffB); PG8_STAGE(PG8_SB(0, 1), b2 + hstep, voffB); PG8_STAGE(PG8_SA(0, 0), a2, voffA);
            PG8_WAIT_V(8); PG8_WAIT_L(0); PG8_BAR; PG8_MMA(1, 0, At, B0); PG8_MMA(1, 1, At, B1); PG8_BAR; PG8_SCHED;
            PG8_LDB(B0, 1, 0); PG8_LDB(B1, 1, 1); PG8_SCHED; PG8_LDA(At, 1, 0); PG8_STAGE(PG8_SA(0, 1), a2 + hstep, voffA);
            PG8_WAIT_V(8); PG8_WAIT_L(0); PG8_BAR; PG8_MMA(0, 0, At, B0); PG8_MMA(0, 1, At, B1); PG8_BAR; PG8_SCHED;
            PG8_LDA(At, 1, 1); PG8_STAGE(PG8_SB(1, 0), b3, voffB); PG8_STAGE(PG8_SB(1, 1), b3 + hstep, voffB); PG8_STAGE(PG8_SA(1, 0), a3, voffA);
            PG8_WAIT_V(8); PG8_WAIT_L(0); PG8_BAR; PG8_MMA(1, 0, At, B0); PG8_MMA(1, 1, At, B1); PG8_BAR; PG8_SCHED;
            } else {
            PG8_LDB(B0, 0, 0); PG8_SCHED; PG8_LDA(At, 0, 0); PG8_STAGE(PG8_SA(1, 1), a1 + hstep, voffA);
            PG8_WAIT_L(8); PG8_BAR; PG8_WAIT_L(0); PG8_MMA(0, 0, At, B0); PG8_BAR; PG8_SCHED;
            PG8_LDB(B1, 0, 1); PG8_STAGE(PG8_SB(0, 0), b2, voffB);
            PG8_BAR; PG8_WAIT_L(0); PG8_MMA(0, 1, At, B1); PG8_BAR;
            PG8_LDA(At, 0, 1); PG8_STAGE(PG8_SA(0, 0), a2, voffA);
            PG8_BAR; PG8_WAIT_L(0); PG8_MMA(1, 0, At, B0); PG8_BAR; PG8_SCHED;
            PG8_STAGE(PG8_SB(0, 1), b2 + hstep, voffB);
            PG8_WAIT_V(6); PG8_BAR; PG8_MMA(1, 1, At, B1); PG8_BAR;
            PG8_LDB(B0, 1, 0); PG8_SCHED; PG8_LDA(At, 1, 0); PG8_STAGE(PG8_SA(0, 1), a2 + hstep, voffA);
            PG8_WAIT_L(8); PG8_BAR; PG8_WAIT_L(0); PG8_MMA(0, 0, At, B0); PG8_BAR; PG8_SCHED;
            PG8_LDB(B1, 1, 1); PG8_STAGE(PG8_SB(1, 0), b3, voffB);
            PG8_BAR; PG8_WAIT_L(0); PG8_MMA(0, 1, At, B1); PG8_BAR;
            PG8_LDA(At, 1, 1); PG8_STAGE(PG8_SA(1, 0), a3, voffA);
            PG8_BAR; PG8_WAIT_L(0); PG8_MMA(1, 0, At, B0); PG8_BAR; PG8_SCHED;
            PG8_STAGE(PG8_SB(1, 1), b3 + hstep, voffB);
            PG8_WAIT_V(6); PG8_BAR; PG8_MMA(1, 1, At, B1); PG8_BAR;
            }
        }
        if constexpr (ALIGN_EPI) { if (wr == 0) PG8_BAR; }
        if constexpr (!Epi::AFTER_DRAIN) { E(acc, cur, wr, wc, fr, fq); S.done(cur); }
        if (!has_next) break;
        bool zero_acc = true; if constexpr (Epi::KEEP_ACC) zero_acc = (cur.aux == 2);
        if (zero_acc) {
#pragma unroll
        for (int a = 0; a < 2; ++a)
#pragma unroll
            for (int b = 0; b < 2; ++b)
#pragma unroll
                for (int m = 0; m < 4; ++m)
#pragma unroll
                    for (int n = 0; n < 2; ++n) acc[a][b][m][n] = (f32x4){0.f, 0.f, 0.f, 0.f};
        }
        cur = nxt; cA = nA; cB = nB; ++ui;
        if constexpr (ALIGN_EPI) { if (wr == 1) PG8_BAR; }
    }
    PG8_WAIT_V(0);
    if constexpr (!ALIGN_EPI) { if (wr == 0) PG8_BAR; }
    PG8_BAR;
    if constexpr (Epi::AFTER_DRAIN) { E.fused(acc, cur, wr, wc, fr, fq, lds, wid, lane); S.done(cur); }
#undef PG8_SA
#undef PG8_SB
#undef PG8_STAGE
#undef PG8_LDA
#undef PG8_LDB
#undef PG8_MMA
#undef PG8_WAIT_V
#undef PG8_WAIT_L
#undef PG8_BAR
#undef PG8_SCHED
}
}
#define XB_TMO      128
#define XB_XCNT(j)  (256  + 64 * (j))
#define XB_XSUB(j)  (1280 + 64 * (j))
#define XB_XGEN(j)  (2304 + 64 * (j))
#define XB_TOP      3328
#define XB_TOPGEN   3392
#define XCD_BAR_WORDS 3456
#define XB_SPIN_CAP (1u << 18)

__device__ __forceinline__ unsigned xb_ld(unsigned* p)              { return __hip_atomic_load(p, __ATOMIC_RELAXED, __HIP_MEMORY_SCOPE_AGENT); }
__device__ __forceinline__ unsigned xb_add(unsigned* p, unsigned v) { return __hip_atomic_fetch_add(p, v, __ATOMIC_RELAXED, __HIP_MEMORY_SCOPE_AGENT); }
__device__ __forceinline__ unsigned xb_xcc_id() { return (unsigned)__builtin_amdgcn_s_getreg((3 << 11) | 20) & 0xFu; }
#define XB_SPIN(cond, bar) do { unsigned _sp = 0; while (cond) { __builtin_amdgcn_s_sleep(1); \
    if ((++_sp & 255u) == 0u) { if (xb_ld(&(bar)[XB_TMO])) break; if (_sp > XB_SPIN_CAP) { atomicAdd(&(bar)[XB_TMO], 1u); break; } } } } while (0)

struct XcdBarrier {
    unsigned* bar; unsigned x;
    volatile LAS unsigned* st;
};

__device__ __forceinline__ XcdBarrier xcd_barrier_post(unsigned* bar, volatile LAS unsigned* st) {
    XcdBarrier b; b.bar = bar; b.x = xb_xcc_id(); b.st = st;
    if (threadIdx.x == 0) (void)xb_add(&bar[XB_XCNT(b.x)], 1u);
    return b;
}
__device__ __forceinline__ void xcd_barrier_complete(unsigned* bar, unsigned x, unsigned& nloc, unsigned& nx) {
    const unsigned G = gridDim.x * gridDim.y * gridDim.z;
    unsigned sum, cnt, mine, sp = 0u;
    for (;;) {
        sum = 0u; cnt = 0u; mine = 0u;
#pragma unroll
        for (unsigned j = 0; j < 16; ++j) { const unsigned c = xb_ld(&bar[XB_XCNT(j)]); sum += c; cnt += (c > 0u) ? 1u : 0u; mine = (j == x) ? c : mine; }
        if (sum == G) break;
        __builtin_amdgcn_s_sleep(1);
        if ((++sp & 255u) == 0u) { if (xb_ld(&bar[XB_TMO])) break; if (sp > XB_SPIN_CAP) { atomicAdd(&bar[XB_TMO], 1u); break; } }
    }
    nloc = mine > 0u ? mine : 1u; nx = cnt > 0u ? cnt : 1u;
}

__device__ __forceinline__ void xcd_barrier(const XcdBarrier& b) {
    asm volatile("s_waitcnt vmcnt(0)" ::: "memory");
    __syncthreads();
    if (threadIdx.x == 0) {
        unsigned* bar = b.bar;
        __builtin_amdgcn_s_waitcnt(0);
        unsigned nloc = b.st[0], nx = b.st[1];
        if (nloc == 0u) { xcd_barrier_complete(bar, b.x, nloc, nx); b.st[0] = nloc; b.st[1] = nx; }
        const unsigned old = xb_add(&bar[XB_XSUB(b.x)], 1u);
        const unsigned gen = old / nloc;
        if (old + 1u == (gen + 1u) * nloc) {
            __builtin_amdgcn_fence(__ATOMIC_RELEASE, "agent");
            asm volatile("s_waitcnt vmcnt(0)" ::: "memory");
            const unsigned og = xb_add(&bar[XB_TOP], 1u);
            const unsigned tg = og / nx;
            if (og + 1u == (tg + 1u) * nx) xb_add(&bar[XB_TOPGEN], 1u);
            else XB_SPIN(xb_ld(&bar[XB_TOPGEN]) == tg, bar);
            __builtin_amdgcn_fence(__ATOMIC_ACQUIRE, "agent");
            xb_add(&bar[XB_XGEN(b.x)], 1u);
            asm volatile("s_waitcnt vmcnt(0)" ::: "memory");
        } else {
            XB_SPIN(xb_ld(&bar[XB_XGEN(b.x)]) == gen, bar);
            __builtin_amdgcn_fence(__ATOMIC_ACQUIRE, "agent");
            asm volatile("s_waitcnt vmcnt(0)" ::: "memory");
        }
    }
    __syncthreads();
}
constexpr size_t MiB = 1u << 20;
constexpr size_t SZ_WGU = (size_t)NGU * DM * 2, SZ_WD = (size_t)DM * DFF * 2, SZ_WIN = (size_t)NZP * DM * 2, SZ_WUP = (size_t)DM * 1024 * 2, SZ_WOUT = (size_t)DM * DM * 2, SZ_LRUW = (size_t)8 * 256 * 128 * 2;
constexpr size_t LW_GU1 = 0, LW_D1 = LW_GU1 + SZ_WGU, LW_IN = LW_D1 + SZ_WD, LW_UPA = LW_IN + SZ_WIN, LW_UPB = LW_UPA + SZ_WUP, LW_UPC = LW_UPB + SZ_WUP, LW_OUT = LW_UPC + SZ_WUP,
                 LW_GU2 = LW_OUT + SZ_WOUT, LW_D2 = LW_GU2 + SZ_WGU, LW_LRU = LW_D2 + SZ_WD, LW_END = LW_LRU + SZ_LRUW;
constexpr size_t LW_STRIDE = (LW_END + MiB - 1) / MiB * MiB;
constexpr size_t SZ_Y = (size_t)T_SEQ * 1024 * 2;
constexpr size_t WS_CTL = 0, CTL_BYTES = 2 * MiB, WS_W = CTL_BYTES, WS_X = WS_W + NLAYER * LW_STRIDE, WS_HN = WS_X + (size_t)T_SEQ * DM * 4, WS_HID = WS_HN + (size_t)T_SEQ * DM * 2,
                 WS_Z = WS_HID + (size_t)T_SEQ * DFF * 2, WS_ZT = WS_Z + (size_t)T_SEQ * NZ * 2, WS_G = WS_ZT + (size_t)NZT * T_SEQ * 2, WS_YA = WS_G + 1 * MiB, WS_YB = WS_YA + SZ_Y, WS_YC = WS_YB + SZ_Y,
                 WS_MG = WS_YC + SZ_Y, WS_SCR = WS_MG + (size_t)T_SEQ * DM * 2;
constexpr size_t SC_XC = 0, SC_LA = SC_XC + (size_t)T_SEQ * 1024 * 4, SC_LU = SC_LA + (size_t)T_SEQ * 1024 * 4, SC_MLA = SC_LU + (size_t)T_SEQ * 1024 * 4, SC_MLM = SC_MLA + 1 * MiB, SC_MLF = SC_MLM + 1 * MiB,
                 SC_KM = SC_MLF + 1 * MiB, SC_CARRY = SC_KM + 1 * MiB, SC_AKT = SC_CARRY + 1 * MiB, SC_LST = SC_AKT + (size_t)1024 * T_SEQ * 2, SC_CST = SC_LST + (size_t)64 * 4 * 65536 * 4, SC_NL = SC_CST + (size_t)64 * 4 * 65536 * 2,
                 SC_NST = SC_NL + 1 * MiB, SC_BG = SC_NST + 1 * MiB, SC_MST = SC_BG + 1 * MiB, SC_SEL = SC_MST + 1 * MiB, SC_PLSE = SC_SEL + 1 * MiB, SC_PO = SC_PLSE + 1 * MiB, SC_SSQ = SC_PO + (size_t)T_SEQ * 8 * 3 * 128 * 2, SC_END = SC_SSQ + 1 * MiB;
constexpr size_t WS_END = WS_SCR + SC_END;
constexpr int CW_BAR = 1024, MAX_LAUNCH = 96, CW_Q = 512;
constexpr int LDS_STAGE = 131072, LDS_MISC = LDS_STAGE, LDS_BYTES = 147456;

#include <hip/hip_runtime.h>
__device__ __forceinline__ unsigned pk_bf16(float lo, float hi) { unsigned r; asm volatile("v_cvt_pk_bf16_f32 %0, %1, %2" : "=v"(r) : "v"(lo), "v"(hi)); return r; }
struct PItem { int l, hf, p_lo, p_hi; };
constexpr int MAX_ITEMS = 48;
struct MegaArgs { const float* in[26]; float* out; unsigned char* ws; int n_items, do_pro, do_fin, li; PItem items[MAX_ITEMS]; };
__device__ __forceinline__ float wave_sum(float v) {
#pragma unroll
    for (int o = 1; o < 64; o <<= 1) v += __shfl_xor(v, o);
    return v;
}
constexpr int CT_GU = (NGU / 64) * (DM / 64), CT_D = (DM / 64) * (DFF / 64), CT_IN = (NZP / 64) * (DM / 64), CT_UP = (DM / 64) * (1024 / 64), CT_OUT = (DM / 64) * (DM / 64), CT_LRU = 8 * 4 * 2;
constexpr int CT_LAYER = 2 * CT_GU + 2 * CT_D + CT_IN + 3 * CT_UP + CT_OUT + CT_LRU;
typedef float f32x4w __attribute__((ext_vector_type(4)));
typedef unsigned u32x4w __attribute__((ext_vector_type(4)));
struct ConvTile { const float* sp; const float* gs; bf16* dp; int K, Nsrc; float sc, gm; };
template <class KA> __device__ __forceinline__ ConvTile conv_desc(KA a, int gidx, int lane) {
    const int l = gidx / CT_LAYER; int r = gidx - l * CT_LAYER; unsigned char* lw = a->ws + WS_W + (size_t)l * LW_STRIDE;
    const float* s0; const float* s1 = nullptr; const float* gs = nullptr; bf16* dst; int K, Nsrc, mode = 0, ntn;
    if (r < CT_GU) { gs = a->in[1] + (size_t)l * DM; s0 = a->in[2] + (size_t)l * DM * DFF; s1 = a->in[3] + (size_t)l * DM * DFF; dst = (bf16*)(lw + LW_GU1); K = DM; Nsrc = DFF; mode = 1; ntn = NGU / 64; }
    else if ((r -= CT_GU) < CT_D) { s0 = a->in[4] + (size_t)l * DFF * DM; dst = (bf16*)(lw + LW_D1); K = DFF; Nsrc = DM; ntn = DM / 64; }
    else if ((r -= CT_D) < CT_IN) { gs = a->in[5] + (size_t)l * DM; s0 = a->in[6] + (size_t)l * DM * 15368; dst = (bf16*)(lw + LW_IN); K = DM; Nsrc = 15368; mode = 2; ntn = NZP / 64; }
    else if ((r -= CT_IN) < CT_LRU) { const int blk = r >> 3; r &= 7; s0 = a->in[12] + ((size_t)l * 8 + blk) * 128 * 128; s1 = a->in[14] + ((size_t)l * 8 + blk) * 128 * 128; dst = (bf16*)(lw + LW_LRU) + (size_t)blk * 256 * 128; K = 128; Nsrc = 128; mode = 3; ntn = 4; }
    else if ((r -= CT_LRU) < 3 * CT_UP) { const int b = r / CT_UP; r -= b * CT_UP; s0 = (b == 0 ? a->in[17] : (b == 1 ? a->in[18] : a->in[19])) + (size_t)l * 1024 * DM; dst = (bf16*)(lw + LW_UPA + (size_t)b * SZ_WUP); K = 1024; Nsrc = DM; ntn = DM / 64; }
    else if ((r -= 3 * CT_UP) < CT_OUT) { s0 = a->in[20] + (size_t)l * DM * DM; dst = (bf16*)(lw + LW_OUT); K = DM; Nsrc = DM; ntn = DM / 64; }
    else if ((r -= CT_OUT) < CT_GU) { gs = a->in[21] + (size_t)l * DM; s0 = a->in[22] + (size_t)l * DM * DFF; s1 = a->in[23] + (size_t)l * DM * DFF; dst = (bf16*)(lw + LW_GU2); K = DM; Nsrc = DFF; mode = 1; ntn = NGU / 64; }
    else { r -= CT_GU; s0 = a->in[24] + (size_t)l * DFF * DM; dst = (bf16*)(lw + LW_D2); K = DFF; Nsrc = DM; ntn = DM / 64; }
    int nti, kti; if (mode == 1 || mode == 2) { const int grp = r >> 7, w = r & 127; kti = w >> 2; nti = grp * 4 + (w & 3); } else { nti = r % ntn; kti = r / ntn; }
    const int n0 = nti * 64, k0 = kti * 64, n = n0 + (lane & 15) * 4; const float* src = s0; int col = n; float sc = 1.f;
    if (mode == 1) { const int b = (n >> 7) & 1; col = ((n >> 8) << 7) | (n & 127); src = b ? s1 : s0; }
    else if (mode == 2) { int nl = n; if (n < NZ) { const int p_ = n & 255; nl = (n & ~255) + 64 * ((p_ >> 5) & 3) + 32 * (p_ >> 7) + (p_ & 31); }
        col = win_src_col(nl); if (nl >= Z_AK && nl < Z_AO) sc = 0.0625f; }
    else if (mode == 3) { src = (n & 128) ? s1 : s0; col = n & 127; }
    if (col < 0) { sc = 0.f; col = 0; }
    ConvTile t; t.sp = src + (size_t)(k0 + (lane >> 4)) * Nsrc + col; t.gs = (gs ? gs : a->in[1]) + k0 % DM + (lane >> 4); t.gm = gs ? 1.f : 0.f; t.dp = dst + (size_t)n0 * K + k0; t.K = K; t.Nsrc = Nsrc; t.sc = sc; return t;
}
__device__ __forceinline__ void conv_load(const ConvTile& t, f32x4w (&v)[16], float (&g)[16]) {
#pragma unroll
    for (int i = 0; i < 16; ++i) g[i] = t.gs[4 * i];
#pragma unroll
    for (int i = 0; i < 16; ++i) v[i] = __builtin_nontemporal_load((const f32x4w*)(t.sp + (size_t)(4 * i) * t.Nsrc));
}
__device__ __forceinline__ void conv_finish(const ConvTile& t, const f32x4w (&v)[16], const float (&gg)[16], LAS unsigned short* tl, int lane) {
    const int nl = (lane & 15) * 4;
#pragma unroll
    for (int i = 0; i < 16; ++i) { const float g = (gg[i] * t.gm + (1.f - t.gm)) * t.sc;
        LAS unsigned* w = (LAS unsigned*)(tl + (4 * i + (lane >> 4)) * 66 + nl); w[0] = pk_bf16(v[i][0] * g, v[i][1] * g); w[1] = pk_bf16(v[i][2] * g, v[i][3] * g); }
    asm volatile("s_waitcnt lgkmcnt(0)" ::: "memory");
    const int kc = (lane & 7) * 8;
#pragma unroll
    for (int q = 0; q < 8; ++q) { const int r = 8 * q + (lane >> 3); unsigned w[4];
#pragma unroll
        for (int e = 0; e < 4; ++e) w[e] = (unsigned)tl[(kc + 2 * e) * 66 + r] | ((unsigned)tl[(kc + 2 * e + 1) * 66 + r] << 16);
        __builtin_nontemporal_store((u32x4w){w[0], w[1], w[2], w[3]}, (u32x4w*)(t.dp + (size_t)r * t.K + kc)); }
    asm volatile("s_waitcnt lgkmcnt(0)" ::: "memory");
}
template <class KA> __device__ __forceinline__ void convert_range(KA a, LAS unsigned char* lds, int t_lo, int t_hi, int rank, int nrank) {
    int tid_ = threadIdx.x; asm volatile("" : "+v"(tid_));
    const int lane = tid_ & 63, wave = __builtin_amdgcn_readfirstlane(tid_ >> 6); LAS unsigned short* tl = (LAS unsigned short*)(lds + wave * 16384);
    const int stride = nrank * 8; int it = t_lo + rank * 8 + wave;
    if (it >= t_hi) return;
    f32x4w va[16], vb[16]; float ga[16], gb[16];
    ConvTile ta = conv_desc(a, it, lane), tb = ta; conv_load(ta, va, ga);
    for (;;) {
        const bool nb = (it + stride) < t_hi; tb = conv_desc(a, nb ? it + stride : it, lane); conv_load(tb, vb, gb);
        conv_finish(ta, va, ga, tl, lane);
        if (!nb) break;
        it += stride;
        const bool na = (it + stride) < t_hi; ta = conv_desc(a, na ? it + stride : it, lane); conv_load(ta, va, ga);
        conv_finish(tb, vb, gb, tl, lane);
        if (!na) break;
        it += stride;
    }
}
constexpr int CVT_PRO = 8704, CVT_GU = 9600, CVT_Z = 7400, CVT_TOTAL = NLAYER * CT_LAYER;
__host__ __device__ constexpr int cvt_slot_lo(int q) { return CVT_PRO + (q / 3) * (2 * CVT_GU + CVT_Z) + (q % 3 == 0 ? 0 : (q % 3 == 1 ? CVT_GU : CVT_GU + CVT_Z)); }
__host__ __device__ constexpr int cvt_slot_hi(int q) { return cvt_slot_lo(q) + (q % 3 == 1 ? CVT_Z : CVT_GU); }
__host__ __device__ constexpr int cvt_need_before(int q) {
    return (q / 3) * CT_LAYER + (q % 3 == 0 ? CT_GU + CT_D + CT_IN : (q % 3 == 1 ? CT_GU + CT_D + CT_IN + CT_LRU + 3 * CT_UP + CT_OUT + CT_GU : CT_LAYER + ((q / 3) + 1 < NLAYER ? CT_GU : 0))); }
__host__ __device__ constexpr bool cvt_schedule_ok() { if (CVT_PRO < CT_GU) return false; for (int q = 0; q < 3 * NLAYER; ++q) { const int hi = cvt_slot_hi(q) < CVT_TOTAL ? cvt_slot_hi(q) : CVT_TOTAL; if (hi < cvt_need_before(q)) return false; } return cvt_slot_hi(3 * NLAYER - 1) >= CVT_TOTAL; }
static_assert(T_SEQ % (2 * 256 * 8) == 0, "phase_final: two rows per wave");
static_assert(cvt_schedule_ok(), "conversion schedule: a weight matrix would be read before it is converted");
__device__ __forceinline__ void phase_xinit(const float* x, float* X, bf16* XB, float* SSQ) {
    int tid_ = threadIdx.x; asm volatile("" : "+v"(tid_));
    const int lane = tid_ & 63, gw = blockIdx.x * 8 + (tid_ >> 6), nw = gridDim.x * 8;
    for (int row = gw; row < T_SEQ; row += nw) {
        const float4* xr = (const float4*)(x + (size_t)row * DM) + lane;
        float4 v[8]; float ss = 0.f;
#pragma unroll
        for (int j = 0; j < 8; ++j) v[j] = xr[64 * j];
#pragma unroll
        for (int j = 0; j < 8; ++j) { const unsigned w0 = pk_bf16(v[j].x, v[j].y), w1 = pk_bf16(v[j].z, v[j].w); ((uint2*)(XB + (size_t)row * DM))[lane + 64 * j] = make_uint2(w0, w1);
            const float r0 = lo_bf(w0), r1 = hi_bf(w0), r2 = lo_bf(w1), r3 = hi_bf(w1); ss += (r0 * r0 + r1 * r1) + (r2 * r2 + r3 * r3); }
        ss = wave_sum(ss);
        if (lane < 32) SSQ[(size_t)row * 32 + lane] = (lane == 0) ? ss : 0.f;
    }
}
__device__ __forceinline__ void phase_final(const bf16* XB, const float* g, float* out) {
    int tid_ = threadIdx.x; asm volatile("" : "+v"(tid_));
    const int lane = tid_ & 63, gw = blockIdx.x * 8 + (tid_ >> 6), nw = gridDim.x * 8;
    for (int row0 = gw; row0 < T_SEQ; row0 += 2 * nw) {
        uint4 w[2][4];
#pragma unroll
        for (int q = 0; q < 2; ++q) { const uint4* xr = (const uint4*)(XB + (size_t)(row0 + q * nw) * DM) + lane;
#pragma unroll
            for (int j = 0; j < 4; ++j) w[q][j] = xr[64 * j]; }
#pragma unroll
        for (int q = 0; q < 2; ++q) { const int row = row0 + q * nw; float ss = 0.f;
#pragma unroll
            for (int j = 0; j < 4; ++j) { const float a0 = lo_bf(w[q][j].x), a1 = hi_bf(w[q][j].x), a2 = lo_bf(w[q][j].y), a3 = hi_bf(w[q][j].y), a4 = lo_bf(w[q][j].z), a5 = hi_bf(w[q][j].z), a6 = lo_bf(w[q][j].w), a7 = hi_bf(w[q][j].w);
                ss += (a0 * a0 + a1 * a1) + (a2 * a2 + a3 * a3) + (a4 * a4 + a5 * a5) + (a6 * a6 + a7 * a7); }
            const float rstd = rsqrtf(wave_sum(ss) * (1.f / DM) + RMS_EPS);
#pragma unroll
            for (int j = 0; j < 4; ++j) { const float4 g0 = *(const float4*)(g + 512 * j + 8 * lane), g1 = *(const float4*)(g + 512 * j + 8 * lane + 4); float* o = out + (size_t)row * DM + 512 * j + 8 * lane;
                *(float4*)o = make_float4(lo_bf(w[q][j].x) * rstd * g0.x, hi_bf(w[q][j].x) * rstd * g0.y, lo_bf(w[q][j].y) * rstd * g0.z, hi_bf(w[q][j].y) * rstd * g0.w);
                *(float4*)(o + 4) = make_float4(lo_bf(w[q][j].z) * rstd * g1.x, hi_bf(w[q][j].z) * rstd * g1.y, lo_bf(w[q][j].w) * rstd * g1.z, hi_bf(w[q][j].w) * rstd * g1.w); } }
    }
}
__device__ __forceinline__ void phase_norm(const float* src, const float* g, bf16* obf, float* of32, float* xcopy) {
    int tid_ = threadIdx.x; asm volatile("" : "+v"(tid_));
    const int lane = tid_ & 63, gw = blockIdx.x * 8 + (tid_ >> 6), nw = gridDim.x * 8;
    const float4* gr = (const float4*)g + lane;
    for (int row = gw; row < T_SEQ; row += nw) {
        const float4* xr = (const float4*)(src + (size_t)row * DM) + lane;
        float4 v[8]; float ss = 0.f;
#pragma unroll
        for (int j = 0; j < 8; ++j) { v[j] = xr[64 * j]; ss += v[j].x * v[j].x + v[j].y * v[j].y + v[j].z * v[j].z + v[j].w * v[j].w; }
        const float rstd = rsqrtf(wave_sum(ss) * (1.f / DM) + RMS_EPS);
        if (xcopy) {
#pragma unroll
            for (int j = 0; j < 8; ++j) ((float4*)(xcopy + (size_t)row * DM))[lane + 64 * j] = v[j]; }
#pragma unroll
        for (int j = 0; j < 8; ++j) { const float4 gg = gr[64 * j]; const float a = v[j].x * rstd * gg.x, b = v[j].y * rstd * gg.y, c = v[j].z * rstd * gg.z, d = v[j].w * rstd * gg.w;
            if (of32) ((float4*)(of32 + (size_t)row * DM))[lane + 64 * j] = make_float4(a, b, c, d);
            else ((uint2*)(obf + (size_t)row * DM))[lane + 64 * j] = make_uint2((unsigned)f2bf(a) | ((unsigned)f2bf(b) << 16), (unsigned)f2bf(c) | ((unsigned)f2bf(d) << 16)); }
    }
}
typedef short bf16x8 __attribute__((ext_vector_type(8)));
typedef short bf16x4 __attribute__((ext_vector_type(4)));
typedef float f32x16 __attribute__((ext_vector_type(16)));
typedef float f32x4v __attribute__((ext_vector_type(4)));
typedef unsigned u32x4v __attribute__((ext_vector_type(4)));
#define MFMA32(a, b, c) __builtin_amdgcn_mfma_f32_32x32x16_bf16((a), (b), (c), 0, 0, 0)
__device__ __forceinline__ bf16x8 pack8(const float* v) { typedef unsigned u32x4_ __attribute__((ext_vector_type(4))); u32x4_ w; w.x = pk_bf16(v[0], v[1]); w.y = pk_bf16(v[2], v[3]); w.z = pk_bf16(v[4], v[5]); w.w = pk_bf16(v[6], v[7]); return __builtin_bit_cast(bf16x8, w); }
__device__ __forceinline__ float gelu_tanh_f(float x) { const float u = 0.7978845608028654f * (x + 0.044715f * x * x * x); const float th = 1.f - 2.f * __builtin_amdgcn_rcpf(1.f + __expf(2.f * u)); return 0.5f * x * (1.f + th); }
__device__ __forceinline__ int kperm(int r) { return (r & 0x13) | ((r & 4) << 1) | ((r & 8) >> 1); }
__device__ __forceinline__ float neg_expm1_small(float x, float a_half) {
    const float p = -x * (1.f + x * (0.5f + x * (0.16666667f + x * (0.041666668f + x * (0.0083333338f + x * 0.0013888889f)))));
    return (x > -0.25f) ? p : (1.f - a_half * a_half);
}
#define LRU_BAR() do { asm volatile("s_waitcnt vmcnt(0) lgkmcnt(0)" ::: "memory"); __builtin_amdgcn_s_barrier(); asm volatile("" ::: "memory"); } while (0)
template <int PASS> __device__ __forceinline__ void lru_pass(const bf16* __restrict__ Z, const bf16* __restrict__ LW, const float* __restrict__ cw_g, const float* __restrict__ cb_g, const float* __restrict__ b_a, const float* __restrict__ b_x, const float* __restrict__ lam,
                                                              float2* __restrict__ CARRY, bf16* __restrict__ YC, float* __restrict__ LA, float* __restrict__ LU, LAS unsigned char* lds, const int u_lo, const int u_hi) {
    int tid_ = threadIdx.x; asm volatile("" : "+v"(tid_));
    const int tid = tid_, lane = tid & 63, wave = __builtin_amdgcn_readfirstlane(tid >> 6), r = lane & 31, hh = lane >> 5, jt = wave & 3, th = wave >> 2;
    LAS unsigned short* RAW = (LAS unsigned short*)lds; LAS unsigned char* XC = lds + 36864; LAS unsigned short* GT = (LAS unsigned short*)(lds + 69632);
    LAS float* xcomp = (LAS float*)(lds + LDS_MISC + 1024);
    for (int u = u_lo + blockIdx.x; u < u_hi; u += gridDim.x) {
        const int R = u >> 3, blk = u & 7, tok0 = R * 128, dd = 32 * jt + r, d = blk * 128 + dd;
        LRU_BAR();
        float av[2][16], uv[2][16]; float hc = 0.f;
        if constexpr (PASS == 1) {
            { int t_ = tid; asm volatile("" : "+v"(t_));
#pragma unroll
              for (int i = 0; i < 5; ++i) { const int idx = t_ + 512 * i; if (idx < 131 * 16) { const int row = idx >> 4, c = idx & 15, t = tok0 - 3 + row; u32x4v v = (u32x4v){0u, 0u, 0u, 0u};
                  if (t >= 0) v = *(const u32x4v*)(Z + (size_t)t * NZ + Z_CX + blk * 128 + c * 8); *(LAS u32x4v*)(RAW + row * 128 + c * 8) = v; } } }
            const bf16* wt = LW + (size_t)blk * 256 * 128;
            bf16x8 ba[8], bx[8];
#pragma unroll
            for (int s = 0; s < 8; ++s) { ba[s] = *(const bf16x8*)(wt + (size_t)dd * 128 + 16 * s + 8 * hh); bx[s] = *(const bf16x8*)(wt + (size_t)(128 + dd) * 128 + 16 * s + 8 * hh); }
            const float bav = b_a[d], bxv = b_x[d], sp8 = 8.f * log1pf(expf(-lam[d]));
            const float w0 = cw_g[d], w1 = cw_g[1024 + d], w2 = cw_g[2048 + d], w3 = cw_g[3072 + d], wb = cb_g[d];
            LRU_BAR();
            { const int c8 = tid & 15; const float* cwp = cw_g + blk * 128 + c8 * 8; float cw[4][8], cbv[8];
#pragma unroll
              for (int jj = 0; jj < 4; ++jj) { const float4 q0 = *(const float4*)(cwp + jj * 1024), q1 = *(const float4*)(cwp + jj * 1024 + 4); cw[jj][0] = q0.x; cw[jj][1] = q0.y; cw[jj][2] = q0.z; cw[jj][3] = q0.w; cw[jj][4] = q1.x; cw[jj][5] = q1.y; cw[jj][6] = q1.z; cw[jj][7] = q1.w; }
              { const float4 q0 = *(const float4*)(cb_g + blk * 128 + c8 * 8), q1 = *(const float4*)(cb_g + blk * 128 + c8 * 8 + 4); cbv[0] = q0.x; cbv[1] = q0.y; cbv[2] = q0.z; cbv[3] = q0.w; cbv[4] = q1.x; cbv[5] = q1.y; cbv[6] = q1.z; cbv[7] = q1.w; }
#pragma unroll
              for (int i = 0; i < 4; ++i) { const int t = (tid >> 4) + 32 * i; float xv[8];
#pragma unroll
                  for (int e = 0; e < 8; ++e) xv[e] = cbv[e];
#pragma unroll
                  for (int jj = 0; jj < 4; ++jj) { const u32x4v raw = *(const LAS u32x4v*)(RAW + (t + jj) * 128 + c8 * 8);
                      xv[0] += cw[jj][0] * lo_bf(raw[0]); xv[1] += cw[jj][1] * hi_bf(raw[0]); xv[2] += cw[jj][2] * lo_bf(raw[1]); xv[3] += cw[jj][3] * hi_bf(raw[1]);
                      xv[4] += cw[jj][4] * lo_bf(raw[2]); xv[5] += cw[jj][5] * hi_bf(raw[2]); xv[6] += cw[jj][6] * lo_bf(raw[3]); xv[7] += cw[jj][7] * hi_bf(raw[3]); }
                  *(LAS bf16x8*)(XC + t * 256 + ((c8 ^ (t & 15)) << 4)) = pack8(xv); } }
            LRU_BAR();
            float* pa = LA + (size_t)(tok0 + 64 * th + 4 * hh) * 1024 + d; float* pu = LU + (size_t)(tok0 + 64 * th + 4 * hh) * 1024 + d;
#pragma unroll
            for (int tt = 0; tt < 2; ++tt) {
                const int tl0 = 64 * th + 32 * tt;
                f32x16 accA, accX;
#pragma unroll
                for (int i = 0; i < 16; ++i) { accA[i] = 0.f; accX[i] = 0.f; }
#pragma unroll
                for (int s = 0; s < 8; ++s) { const bf16x8 af = *(const LAS bf16x8*)(XC + (tl0 + r) * 256 + (((2 * s + hh) ^ (r & 15)) << 4)); accA = MFMA32(af, ba[s], accA); accX = MFMA32(af, bx[s], accX); }
#pragma unroll
                for (int gq = 0; gq < 4; ++gq) { const int t0 = tl0 + 8 * gq + 4 * hh; float cxr[7];
#pragma unroll
                    for (int q = 0; q < 7; ++q) cxr[q] = bf2f(RAW[(t0 + q) * 128 + dd]);
#pragma unroll
                    for (int e = 0; e < 4; ++e) { const int i = 4 * gq + e;
                        const float xc = wb + w0 * cxr[e] + w1 * cxr[e + 1] + w2 * cxr[e + 2] + w3 * cxr[e + 3];
                        const float rr = __builtin_amdgcn_rcpf(1.f + __expf(-(accA[i] + bav))), ig = __builtin_amdgcn_rcpf(1.f + __expf(-(accX[i] + bxv)));
                        const float la = -sp8 * rr, a_ = __expf(la); av[tt][i] = a_; uv[tt][i] = __builtin_amdgcn_sqrtf(neg_expm1_small(2.f * la, a_)) * (ig * xc);
                        pa[(32 * tt + 8 * gq + e) * 1024] = av[tt][i]; pu[(32 * tt + 8 * gq + e) * 1024] = uv[tt][i]; } }
            }
        } else {
            { int t_ = tid; asm volatile("" : "+v"(t_));
#pragma unroll
              for (int i = 0; i < 4; ++i) { const int idx = t_ + 512 * i, row = idx >> 4, c = idx & 15; *(LAS u32x4v*)(GT + row * 128 + c * 8) = *(const u32x4v*)(Z + (size_t)(tok0 + row) * NZ + Z_CG + blk * 128 + c * 8); } }
            const float* pa = LA + (size_t)(tok0 + 64 * th + 4 * hh) * 1024 + d; const float* pu = LU + (size_t)(tok0 + 64 * th + 4 * hh) * 1024 + d;
#pragma unroll
            for (int tt = 0; tt < 2; ++tt)
#pragma unroll
                for (int i = 0; i < 16; ++i) { av[tt][i] = pa[(32 * tt + 8 * (i >> 2) + (i & 3)) * 1024]; uv[tt][i] = pu[(32 * tt + 8 * (i >> 2) + (i & 3)) * 1024]; }
            for (int q0 = 0; q0 < R; q0 += 8) { float2 cc[8];
#pragma unroll
                for (int j = 0; j < 8; ++j) cc[j] = (q0 + j < R) ? CARRY[(size_t)(q0 + j) * 1024 + d] : make_float2(1.f, 0.f);
#pragma unroll
                for (int j = 0; j < 8; ++j) hc = hc * cc[j].x + cc[j].y; }
        }
        float Aw = 1.f, Hw = 0.f; float Ag[2][4], Hg[2][4], Ap[2][4], Hp[2][4];
#pragma unroll
        for (int tt = 0; tt < 2; ++tt) {
#pragma unroll
            for (int gq = 0; gq < 4; ++gq) { float A = av[tt][4 * gq], H = uv[tt][4 * gq];
#pragma unroll
                for (int e = 1; e < 4; ++e) { H = H * av[tt][4 * gq + e] + uv[tt][4 * gq + e]; A *= av[tt][4 * gq + e]; }
                Ag[tt][gq] = A; Hg[tt][gq] = H; Ap[tt][gq] = __shfl_xor(A, 32); Hp[tt][gq] = __shfl_xor(H, 32); }
#pragma unroll
            for (int p = 0; p < 8; ++p) { const bool own = ((p & 1) == hh); const float A = own ? Ag[tt][p >> 1] : Ap[tt][p >> 1], H = own ? Hg[tt][p >> 1] : Hp[tt][p >> 1]; Hw = Hw * A + H; Aw *= A; }
        }
        if (hh == 0) { xcomp[(wave * 32 + r) * 2] = Aw; xcomp[(wave * 32 + r) * 2 + 1] = Hw; }
        LRU_BAR();
        if (PASS == 1) {
            if (th == 0 && hh == 0) { const float A1 = xcomp[((wave + 4) * 32 + r) * 2], H1 = xcomp[((wave + 4) * 32 + r) * 2 + 1]; CARRY[(size_t)R * 1024 + d] = make_float2(Aw * A1, Hw * A1 + H1); }
        } else {
            if (th == 1) { const float A0 = xcomp[((wave - 4) * 32 + r) * 2], H0 = xcomp[((wave - 4) * 32 + r) * 2 + 1]; hc = hc * A0 + H0; }
#pragma unroll
            for (int tt = 0; tt < 2; ++tt) { const int tl0 = 64 * th + 32 * tt; float hin[4];
#pragma unroll
                for (int p = 0; p < 8; ++p) { const bool own = ((p & 1) == hh); if (own) hin[p >> 1] = hc; const float A = own ? Ag[tt][p >> 1] : Ap[tt][p >> 1], H = own ? Hg[tt][p >> 1] : Hp[tt][p >> 1]; hc = hc * A + H; }
#pragma unroll
                for (int gq = 0; gq < 4; ++gq) { float h = hin[gq]; const int t0 = tl0 + 8 * gq + 4 * hh;
#pragma unroll
                    for (int e = 0; e < 4; ++e) { h = h * av[tt][4 * gq + e] + uv[tt][4 * gq + e];
                        YC[(size_t)(tok0 + t0 + e) * 1024 + d] = f2bf(h * gelu_tanh_f(bf2f(GT[(t0 + e) * 128 + dd]))); } } }
        }
    }
    LRU_BAR();
}
template <int PASS> __device__ __forceinline__ void lru_unit(const int u, const bf16* __restrict__ Z, const bf16* __restrict__ LW, const float* __restrict__ cw_g, const float* __restrict__ cb_g, const float* __restrict__ b_a, const float* __restrict__ b_x, const float* __restrict__ lam,
                                                              float2* __restrict__ CARRY, bf16* __restrict__ YC, float (&av)[2][16], float (&uv)[2][16], LAS unsigned char* lds) {
    int tid_ = threadIdx.x; asm volatile("" : "+v"(tid_));
    const int tid = tid_, lane = tid & 63, wave = __builtin_amdgcn_readfirstlane(tid >> 6), r = lane & 31, hh = lane >> 5, jt = wave & 3, th = wave >> 2;
    LAS unsigned short* RAW = (LAS unsigned short*)lds; LAS unsigned char* XC = lds + 36864; LAS unsigned short* GT = (LAS unsigned short*)(lds + 69632);
    LAS float* xcomp = (LAS float*)(lds + LDS_MISC + 1024);
    {
        const int R = u >> 3, blk = u & 7, tok0 = R * 128, dd = 32 * jt + r, d = blk * 128 + dd;
        LRU_BAR();
        float hc = 0.f;
        if constexpr (PASS == 1) {
            { int t_ = tid; asm volatile("" : "+v"(t_));
#pragma unroll
              for (int i = 0; i < 5; ++i) { const int idx = t_ + 512 * i; if (idx < 131 * 16) { const int row = idx >> 4, c = idx & 15, t = tok0 - 3 + row; u32x4v v = (u32x4v){0u, 0u, 0u, 0u};
                  if (t >= 0) v = *(const u32x4v*)(Z + (size_t)t * NZ + Z_CX + blk * 128 + c * 8); *(LAS u32x4v*)(RAW + row * 128 + c * 8) = v; } } }
            const bf16* wt = LW + (size_t)blk * 256 * 128;
            bf16x8 ba[8], bx[8];
#pragma unroll
            for (int s = 0; s < 8; ++s) { ba[s] = *(const bf16x8*)(wt + (size_t)dd * 128 + 16 * s + 8 * hh); bx[s] = *(const bf16x8*)(wt + (size_t)(128 + dd) * 128 + 16 * s + 8 * hh); }
            const float bav = b_a[d], bxv = b_x[d], sp8 = 8.f * log1pf(expf(-lam[d]));
            const float w0 = cw_g[d], w1 = cw_g[1024 + d], w2 = cw_g[2048 + d], w3 = cw_g[3072 + d], wb = cb_g[d];
            LRU_BAR();
            { const int c8 = tid & 15; const float* cwp = cw_g + blk * 128 + c8 * 8; float cw[4][8], cbv[8];
#pragma unroll
              for (int jj = 0; jj < 4; ++jj) { const float4 q0 = *(const float4*)(cwp + jj * 1024), q1 = *(const float4*)(cwp + jj * 1024 + 4); cw[jj][0] = q0.x; cw[jj][1] = q0.y; cw[jj][2] = q0.z; cw[jj][3] = q0.w; cw[jj][4] = q1.x; cw[jj][5] = q1.y; cw[jj][6] = q1.z; cw[jj][7] = q1.w; }
              { const float4 q0 = *(const float4*)(cb_g + blk * 128 + c8 * 8), q1 = *(const float4*)(cb_g + blk * 128 + c8 * 8 + 4); cbv[0] = q0.x; cbv[1] = q0.y; cbv[2] = q0.z; cbv[3] = q0.w; cbv[4] = q1.x; cbv[5] = q1.y; cbv[6] = q1.z; cbv[7] = q1.w; }
#pragma unroll
              for (int i = 0; i < 4; ++i) { const int t = (tid >> 4) + 32 * i; float xv[8];
#pragma unroll
                  for (int e = 0; e < 8; ++e) xv[e] = cbv[e];
#pragma unroll
                  for (int jj = 0; jj < 4; ++jj) { const u32x4v raw = *(const LAS u32x4v*)(RAW + (t + jj) * 128 + c8 * 8);
                      xv[0] += cw[jj][0] * lo_bf(raw[0]); xv[1] += cw[jj][1] * hi_bf(raw[0]); xv[2] += cw[jj][2] * lo_bf(raw[1]); xv[3] += cw[jj][3] * hi_bf(raw[1]);
                      xv[4] += cw[jj][4] * lo_bf(raw[2]); xv[5] += cw[jj][5] * hi_bf(raw[2]); xv[6] += cw[jj][6] * lo_bf(raw[3]); xv[7] += cw[jj][7] * hi_bf(raw[3]); }
                  *(LAS bf16x8*)(XC + t * 256 + ((c8 ^ (t & 15)) << 4)) = pack8(xv); } }
            LRU_BAR();
#pragma unroll
            for (int tt = 0; tt < 2; ++tt) {
                const int tl0 = 64 * th + 32 * tt;
                f32x16 accA, accX;
#pragma unroll
                for (int i = 0; i < 16; ++i) { accA[i] = 0.f; accX[i] = 0.f; }
#pragma unroll
                for (int s = 0; s < 8; ++s) { const bf16x8 af = *(const LAS bf16x8*)(XC + (tl0 + r) * 256 + (((2 * s + hh) ^ (r & 15)) << 4)); accA = MFMA32(af, ba[s], accA); accX = MFMA32(af, bx[s], accX); }
#pragma unroll
                for (int gq = 0; gq < 4; ++gq) { const int t0 = tl0 + 8 * gq + 4 * hh; float cxr[7];
#pragma unroll
                    for (int q = 0; q < 7; ++q) cxr[q] = bf2f(RAW[(t0 + q) * 128 + dd]);
#pragma unroll
                    for (int e = 0; e < 4; ++e) { const int i = 4 * gq + e;
                        const float xc = wb + w0 * cxr[e] + w1 * cxr[e + 1] + w2 * cxr[e + 2] + w3 * cxr[e + 3];
                        const float rr = __builtin_amdgcn_rcpf(1.f + __expf(-(accA[i] + bav))), ig = __builtin_amdgcn_rcpf(1.f + __expf(-(accX[i] + bxv)));
                        const float la = -sp8 * rr, a_ = __expf(la); av[tt][i] = a_; uv[tt][i] = __builtin_amdgcn_sqrtf(neg_expm1_small(2.f * la, a_)) * (ig * xc);
                    } }
            }
        } else {
            { int t_ = tid; asm volatile("" : "+v"(t_));
#pragma unroll
              for (int i = 0; i < 4; ++i) { const int idx = t_ + 512 * i, row = idx >> 4, c = idx & 15; *(LAS u32x4v*)(GT + row * 128 + c * 8) = *(const u32x4v*)(Z + (size_t)(tok0 + row) * NZ + Z_CG + blk * 128 + c * 8); } }
            for (int q0 = 0; q0 < R; q0 += 8) { float2 cc[8];
#pragma unroll
                for (int j = 0; j < 8; ++j) cc[j] = (q0 + j < R) ? CARRY[(size_t)(q0 + j) * 1024 + d] : make_float2(1.f, 0.f);
#pragma unroll
                for (int j = 0; j < 8; ++j) hc = hc * cc[j].x + cc[j].y; }
        }
        float Aw = 1.f, Hw = 0.f; float Ag[2][4], Hg[2][4], Ap[2][4], Hp[2][4];
#pragma unroll
        for (int tt = 0; tt < 2; ++tt) {
#pragma unroll
            for (int gq = 0; gq < 4; ++gq) { float A = av[tt][4 * gq], H = uv[tt][4 * gq];
#pragma unroll
                for (int e = 1; e < 4; ++e) { H = H * av[tt][4 * gq + e] + uv[tt][4 * gq + e]; A *= av[tt][4 * gq + e]; }
                Ag[tt][gq] = A; Hg[tt][gq] = H; Ap[tt][gq] = __shfl_xor(A, 32); Hp[tt][gq] = __shfl_xor(H, 32); }
#pragma unroll
            for (int p = 0; p < 8; ++p) { const bool own = ((p & 1) == hh); const float A = own ? Ag[tt][p >> 1] : Ap[tt][p >> 1], H = own ? Hg[tt][p >> 1] : Hp[tt][p >> 1]; Hw = Hw * A + H; Aw *= A; }
        }
        if (hh == 0) { xcomp[(wave * 32 + r) * 2] = Aw; xcomp[(wave * 32 + r) * 2 + 1] = Hw; }
        LRU_BAR();
        if (PASS == 1) {
            if (th == 0 && hh == 0) { const float A1 = xcomp[((wave + 4) * 32 + r) * 2], H1 = xcomp[((wave + 4) * 32 + r) * 2 + 1]; CARRY[(size_t)R * 1024 + d] = make_float2(Aw * A1, Hw * A1 + H1); }
        } else {
            if (th == 1) { const float A0 = xcomp[((wave - 4) * 32 + r) * 2], H0 = xcomp[((wave - 4) * 32 + r) * 2 + 1]; hc = hc * A0 + H0; }
#pragma unroll
            for (int tt = 0; tt < 2; ++tt) { const int tl0 = 64 * th + 32 * tt; float hin[4];
#pragma unroll
                for (int p = 0; p < 8; ++p) { const bool own = ((p & 1) == hh); if (own) hin[p >> 1] = hc; const float A = own ? Ag[tt][p >> 1] : Ap[tt][p >> 1], H = own ? Hg[tt][p >> 1] : Hp[tt][p >> 1]; hc = hc * A + H; }
#pragma unroll
                for (int gq = 0; gq < 4; ++gq) { float h = hin[gq]; const int t0 = tl0 + 8 * gq + 4 * hh;
#pragma unroll
                    for (int e = 0; e < 4; ++e) { h = h * av[tt][4 * gq + e] + uv[tt][4 * gq + e];
                        YC[(size_t)(tok0 + t0 + e) * 1024 + d] = f2bf(h * gelu_tanh_f(bf2f(GT[(t0 + e) * 128 + dd]))); } } }
        }
    }
    LRU_BAR();
}
__device__ __forceinline__ float wave_incl_sum(float v, int lane) {
#pragma unroll
    for (int o = 1; o < 64; o <<= 1) { const float t = __shfl_up(v, o); if (lane >= o) v += t; }
    return v;
}
__device__ __forceinline__ float wave_incl_max(float v, int lane) {
#pragma unroll
    for (int o = 1; o < 64; o <<= 1) { const float t = __shfl_up(v, o); if (lane >= o) v = fmaxf(v, t); }
    return v;
}
__device__ __forceinline__ float wave_max(float v) {
#pragma unroll
    for (int o = 1; o < 64; o <<= 1) v = fmaxf(v, __shfl_xor(v, o));
    return v;
}
constexpr int ML_L = 128, ML_NC = T_SEQ / ML_L;
struct ChunkGates { float a0, a1, b0, b1, Bc; };
__device__ __forceinline__ ChunkGates chunk_gates(const float* G, float bi, float bfv, int tok0, int h, int lane) {
    const size_t t = (size_t)tok0 + 2 * lane;
    const float ip0 = G[t * 8 + h] + bi, fp0 = G[t * 8 + 4 + h] + bfv, ip1 = G[(t + 1) * 8 + h] + bi, fp1 = G[(t + 1) * 8 + 4 + h] + bfv;
    const float lf0 = fminf(fp0, 0.f) - log1pf(expf(-fabsf(fp0))), lf1 = fminf(fp1, 0.f) - log1pf(expf(-fabsf(fp1)));
    const float s1 = lf0 + lf1, inc = wave_incl_sum(s1, lane), excl = inc - s1;
    ChunkGates g; g.b0 = excl + lf0; g.b1 = inc; g.Bc = __builtin_bit_cast(float, __builtin_amdgcn_readlane(__builtin_bit_cast(int, inc), 63)); g.a0 = ip0 - g.b0; g.a1 = ip1 - g.b1; return g;
}
__device__ __forceinline__ void ml_ktrans(const bf16* __restrict__ Z, bf16* __restrict__ AKT, LAS unsigned char* lds) {
    int tid_ = threadIdx.x; asm volatile("" : "+v"(tid_));
    const int lane = tid_ & 63, wave = __builtin_amdgcn_readfirstlane(tid_ >> 6), gw = blockIdx.x * 8 + wave, nw = gridDim.x * 8;
    LAS unsigned short* tl = (LAS unsigned short*)(lds + wave * 16384);
    for (int u = gw; u < 2048; u += nw) { const int tok0 = (u >> 4) * 64, ch0 = (u & 15) * 64;
#pragma unroll
        for (int i = 0; i < 8; ++i) { const int tk = 8 * i + (lane >> 3), cc = (lane & 7) * 8;
            *(LAS u32x4v*)(tl + tk * 72 + cc) = *(const u32x4v*)(Z + (size_t)(tok0 + tk) * NZ + Z_AK + ch0 + cc); }
        asm volatile("s_waitcnt lgkmcnt(0)" ::: "memory");
#pragma unroll
        for (int i = 0; i < 8; ++i) { const int ch = 8 * i + (lane >> 3), tc = (lane & 7) * 8; unsigned w[4];
#pragma unroll
            for (int e = 0; e < 4; ++e) w[e] = (unsigned)tl[(tc + 2 * e) * 72 + ch] | ((unsigned)tl[(tc + 2 * e + 1) * 72 + ch] << 16);
            *(uint4*)(AKT + (size_t)(ch0 + ch) * T_SEQ + tok0 + tc) = make_uint4(w[0], w[1], w[2], w[3]); }
        asm volatile("s_waitcnt lgkmcnt(0)" ::: "memory");
    }
}
template <int CHUNKS> __device__ __forceinline__ void ml_stage(LAS unsigned char* dst, const bf16* src, size_t row_stride, int tid) {
    asm volatile("" : "+v"(tid));
    u32x4v v[8];
#pragma unroll
    for (int i = 0; i < 8; ++i) { const int idx = tid + 512 * i, row = idx / CHUNKS, c = idx % CHUNKS; v[i] = *(const u32x4v*)(src + (size_t)row * row_stride + c * 8); }
#pragma unroll
    for (int i = 0; i < 8; ++i) { const int idx = tid + 512 * i, row = idx / CHUNKS, c = idx % CHUNKS; *(LAS u32x4v*)(dst + row * (CHUNKS * 16) + ((c ^ (row & 15)) << 4)) = v[i]; }
}
#define ML_BAR() do { asm volatile("s_waitcnt vmcnt(0) lgkmcnt(0)" ::: "memory"); __builtin_amdgcn_s_barrier(); asm volatile("" ::: "memory"); } while (0)
template <int CHUNKS> __device__ __forceinline__ void ml_load(u32x4v (&v)[8], const bf16* src, size_t row_stride, int tid) {
    asm volatile("" : "+v"(tid));
#pragma unroll
    for (int i = 0; i < 8; ++i) { const int idx = tid + 512 * i, row = idx / CHUNKS, c = idx % CHUNKS; v[i] = *(const u32x4v*)(src + (size_t)row * row_stride + c * 8); }
}
template <int CHUNKS> __device__ __forceinline__ void ml_store(LAS unsigned char* dst, const u32x4v (&v)[8], int tid) {
    asm volatile("" : "+v"(tid));
#pragma unroll
    for (int i = 0; i < 8; ++i) { const int idx = tid + 512 * i, row = idx / CHUNKS, c = idx % CHUNKS; *(LAS u32x4v*)(dst + row * (CHUNKS * 16) + ((c ^ (row & 15)) << 4)) = v[i]; }
}
#define ML_BAR_L() do { asm volatile("s_waitcnt lgkmcnt(0)" ::: "memory"); __builtin_amdgcn_s_barrier(); asm volatile("" ::: "memory"); } while (0)
__device__ __forceinline__ void ml_local(const bf16* __restrict__ ZT, const bf16* __restrict__ AKT, const float* __restrict__ G, const float* __restrict__ b_i, const float* __restrict__ b_f, float* __restrict__ LST, float* __restrict__ NL, float2* __restrict__ BG, LAS unsigned char* lds) {
    int tid_ = threadIdx.x; asm volatile("" : "+v"(tid_));
    const int tid = tid_, lane = tid & 63, wave = __builtin_amdgcn_readfirstlane(tid >> 6), r = lane & 31, hh = lane >> 5, it = wave;
    LAS float* wl = (LAS float*)(lds + LDS_MISC + 12288);
    for (int u = blockIdx.x; u < ML_NC * 4; u += gridDim.x) { const int c = u >> 2, h = u & 3, tok0 = c * ML_L;
        ML_BAR();
        u32x4v sva[8], svb[8];
        ml_load<16>(sva, ZT + (size_t)(ZT_AV + h * 256) * T_SEQ + tok0, T_SEQ, tid);
        ml_load<16>(svb, AKT + (size_t)(h * 256) * T_SEQ + tok0, T_SEQ, tid);
        if (wave == 0) { const ChunkGates cg = chunk_gates(G, b_i[h], b_f[h], tok0, h, lane);
            const float g0 = cg.Bc + cg.a0, g1 = cg.Bc + cg.a1, Gc = wave_max(fmaxf(g0, g1));
            wl[2 * lane] = __expf(g0 - Gc); wl[2 * lane + 1] = __expf(g1 - Gc);
            if (lane == 0) BG[h * ML_NC + c] = make_float2(cg.Bc, Gc); }
        ml_store<16>(lds, sva, tid); ml_store<16>(lds + 65536, svb, tid);
        ML_BAR();
        f32x16 acc[8];
#pragma unroll
        for (int jt = 0; jt < 8; ++jt)
#pragma unroll
            for (int i = 0; i < 16; ++i) acc[jt][i] = 0.f;
        const int vrow = 32 * it + r, x = r & 15;
#pragma unroll 2
        for (int s = 0; s < 8; ++s) {
            const u32x4v vr = *(const LAS u32x4v*)(lds + vrow * 256 + (((2 * s + hh) ^ x) << 4));
            const f32x4v w0 = *(const LAS f32x4v*)(wl + 16 * s + 8 * hh), w1 = *(const LAS f32x4v*)(wl + 16 * s + 8 * hh + 4);
            float vv[8] = {lo_bf(vr[0]) * w0[0], hi_bf(vr[0]) * w0[1], lo_bf(vr[1]) * w0[2], hi_bf(vr[1]) * w0[3], lo_bf(vr[2]) * w1[0], hi_bf(vr[2]) * w1[1], lo_bf(vr[3]) * w1[2], hi_bf(vr[3]) * w1[3]};
            const bf16x8 af = pack8(vv);
#pragma unroll
            for (int jt = 0; jt < 8; ++jt) { const bf16x8 bfr = *(const LAS bf16x8*)(lds + 65536 + (32 * jt + r) * 256 + (((2 * s + hh) ^ x) << 4)); acc[jt] = MFMA32(af, bfr, acc[jt]); }
        }
        unsigned short* lo16 = (unsigned short*)LST + ((size_t)(c * 4 + h) * 256 + 32 * it + 4 * hh) * 256; const bool odd = (r & 1) != 0;
#pragma unroll
        for (int jt = 0; jt < 8; ++jt)
#pragma unroll
            for (int ip = 0; ip < 8; ++ip) { const int i0 = 2 * ip, i1 = i0 + 1, rr0 = (i0 & 3) + 8 * (i0 >> 2);
                const float recv = __shfl_xor(odd ? acc[jt][i0] : acc[jt][i1], 1);
                const unsigned w = odd ? pk_bf16(recv, acc[jt][i1]) : pk_bf16(acc[jt][i0], recv);
                *(unsigned*)(lo16 + (size_t)(odd ? rr0 + 1 : rr0) * 256 + 32 * jt + (r & ~1)) = w; }
        { float ns = 0.f;
#pragma unroll
            for (int q = 0; q < 8; ++q) { const u32x4v kv = *(const LAS u32x4v*)(lds + 65536 + vrow * 256 + (((8 * hh + q) ^ x) << 4)); const f32x4v w0 = *(const LAS f32x4v*)(wl + 64 * hh + 8 * q), w1 = *(const LAS f32x4v*)(wl + 64 * hh + 8 * q + 4);
                ns += lo_bf(kv[0]) * w0[0] + hi_bf(kv[0]) * w0[1] + lo_bf(kv[1]) * w0[2] + hi_bf(kv[1]) * w0[3] + lo_bf(kv[2]) * w1[0] + hi_bf(kv[2]) * w1[1] + lo_bf(kv[3]) * w1[2] + hi_bf(kv[3]) * w1[3]; }
            ns += __shfl_xor(ns, 32);
            if (hh == 0) NL[(size_t)(c * 4 + h) * 256 + 32 * it + r] = ns; }
    }
    ML_BAR();
}
__device__ __forceinline__ void ml_scan(const float* __restrict__ LST, const float* __restrict__ NL, const float2* __restrict__ BG, bf16* __restrict__ CST, float* __restrict__ NST, float* __restrict__ MST) {
    int tid_ = threadIdx.x; asm volatile("" : "+v"(tid_));
    const int lane = tid_ & 63, wave = __builtin_amdgcn_readfirstlane(tid_ >> 6), gw = blockIdx.x * 8 + wave, nw = gridDim.x * 8;
    for (int u = gw; u < 2048; u += nw) {
        const int h = u >> 9; const size_t e = ((size_t)u * 64 + lane) * 2;
        const size_t eh = e - (size_t)h * 65536;
        float c0 = 0.f, c1 = 0.f, m = 0.f;
        const bool do_n = (u & 511) < 4;  const int nk = (u & 511) * 64 + lane;
        float nv = 0.f;
        unsigned lv[2][8]; float2 bg[2][8]; float nl[2][8];
#define SC_LOAD(B, cb_) do { _Pragma("unroll") for (int j = 0; j < 8; ++j) { lv[B][j] = *(const unsigned*)((const unsigned short*)LST + (size_t)(((cb_) + j) * 4 + h) * 65536 + eh); bg[B][j] = BG[h * ML_NC + (cb_) + j]; \
            nl[B][j] = do_n ? NL[(size_t)(((cb_) + j) * 4 + h) * 256 + nk] : 0.f; } } while (0)
#define SC_PROC(B, cb_) do { _Pragma("unroll") for (int j = 0; j < 8; ++j) { const int c = (cb_) + j; \
            *(unsigned*)(CST + (size_t)(c * 4 + h) * 65536 + eh) = pk_bf16(c0, c1); \
            if (eh == 0) MST[h * ML_NC + c] = m; \
            const float mn = fmaxf(bg[B][j].x + m, bg[B][j].y), dec = __expf(bg[B][j].x + m - mn), inj = __expf(bg[B][j].y - mn); \
            c0 = dec * c0 + inj * lo_bf(lv[B][j]); c1 = dec * c1 + inj * hi_bf(lv[B][j]); \
            if (do_n) { NST[(size_t)(c * 4 + h) * 256 + nk] = nv; nv = dec * nv + inj * nl[B][j]; } \
            m = mn; } } while (0)
        SC_LOAD(0, 0);
        for (int cb = 0; cb < ML_NC; cb += 16) {
            SC_LOAD(1, cb + 8); SC_PROC(0, cb);
            { const int nx = (cb + 16 < ML_NC) ? cb + 16 : ML_NC - 8; SC_LOAD(0, nx); }
            SC_PROC(1, cb + 8); }
#undef SC_LOAD
#undef SC_PROC
    }
}
__device__ __forceinline__ void ml_out(const bf16* __restrict__ Z, const bf16* __restrict__ ZT, const float* __restrict__ G, const float* __restrict__ b_i, const float* __restrict__ b_f, const bf16* __restrict__ CST, const float* __restrict__ NST, const float* __restrict__ MST, const float* __restrict__ gain, bf16* __restrict__ YA, LAS unsigned char* lds) {
    int tid_ = threadIdx.x; asm volatile("" : "+v"(tid_));
    const int tid = tid_, lane = tid & 63, wave = __builtin_amdgcn_readfirstlane(tid >> 6), r = lane & 31, hh = lane >> 5, qt = wave >> 1, dvh = wave & 1;
    LAS float* al = (LAS float*)(lds + LDS_MISC + 12288);
    LAS float* xch = (LAS float*)(lds + LDS_MISC + 1024);
    LAS float* gl = (LAS float*)(lds + LDS_MISC + 2048); LAS float* nl = (LAS float*)(lds + LDS_MISC + 3072);
    LAS unsigned char* TA = lds; LAS unsigned char* TB = lds + 65536;
    const int x = r & 15, kr = kperm(r), kx = kr & 15;
    for (int u = blockIdx.x; u < ML_NC * 4; u += gridDim.x) { const int c = u >> 2, h = u & 3, tok0 = c * ML_L;
        ML_BAR();
        ml_stage<32>(TA, Z + (size_t)tok0 * NZ + Z_AQ + h * 256, NZ, tid);
        ml_stage<16>(TB, CST + (size_t)(c * 4 + h) * 65536, 256, tid);
        { int t_ = tid; asm volatile("" : "+v"(t_)); if (t_ < 256) gl[t_] = gain[h * 256 + t_]; else nl[t_ - 256] = NST[(size_t)(c * 4 + h) * 256 + t_ - 256]; }
        if (wave == 0) { const ChunkGates cg = chunk_gates(G, b_i[h], b_f[h], tok0, h, lane);
            const float pm1 = fmaxf(cg.a0, cg.a1), inc = wave_incl_max(pm1, lane); float ex = __shfl_up(inc, 1); if (lane == 0) ex = -INFINITY;
            al[2 * lane] = cg.a0; al[2 * lane + 1] = cg.a1; al[128 + 2 * lane] = fmaxf(ex, cg.a0); al[128 + 2 * lane + 1] = inc; al[256 + 2 * lane] = cg.b0; al[256 + 2 * lane + 1] = cg.b1; }
        u32x4v pre[8];
        ml_load<16>(pre, CST + (size_t)(c * 4 + h) * 65536 + 128, 256, tid);
        ML_BAR_L();
        const float mc = MST[h * ML_NC + c];
        const int tq = 32 * qt + r; const size_t tglob = (size_t)tok0 + tq;
        const float Mt = fmaxf(mc, al[128 + tq]), wi = __expf(mc - Mt), emt = __expf(-(al[256 + tq] + Mt));
        f32x16 acc[4];
#pragma unroll
        for (int dt = 0; dt < 4; ++dt)
#pragma unroll
            for (int i = 0; i < 16; ++i) acc[dt][i] = 0.f;
        const LAS float* nrow = nl + 8 * hh;
        float qn = 0.f;
#pragma unroll
        for (int half = 0; half < 2; ++half) {
            if (half == 1) { ML_BAR_L(); ml_store<16>(TB, pre, tid); ml_load<32>(pre, Z + (size_t)tok0 * NZ + Z_AK + h * 256, NZ, tid); ML_BAR_L(); }
#pragma unroll 2
            for (int s8 = 0; s8 < 8; ++s8) { const int s = 8 * half + s8;
                const u32x4v qr = *(const LAS u32x4v*)(TA + tq * 512 + (((2 * s + hh) ^ x) << 4)); const bf16x8 qf = __builtin_bit_cast(bf16x8, qr);
                const f32x4v n0 = *(const LAS f32x4v*)(nrow + 16 * s), n1 = *(const LAS f32x4v*)(nrow + 16 * s + 4);
                qn += lo_bf(qr[0]) * n0[0] + hi_bf(qr[0]) * n0[1] + lo_bf(qr[1]) * n0[2] + hi_bf(qr[1]) * n0[3] + lo_bf(qr[2]) * n1[0] + hi_bf(qr[2]) * n1[1] + lo_bf(qr[3]) * n1[2] + hi_bf(qr[3]) * n1[3];
#pragma unroll
                for (int dt = 0; dt < 4; ++dt) { const bf16x8 cf = *(const LAS bf16x8*)(TB + (128 * dvh + 32 * dt + r) * 256 + (((2 * s8 + hh) ^ x) << 4)); acc[dt] = MFMA32(cf, qf, acc[dt]); }
            }
        }
        qn += __shfl_xor(qn, 32);
#pragma unroll
        for (int dt = 0; dt < 4; ++dt)
#pragma unroll
            for (int i = 0; i < 16; ++i) acc[dt][i] *= wi;
        ML_BAR_L(); ml_store<32>(TB, pre, tid); ml_load<16>(pre, ZT + (size_t)(ZT_AV + h * 256) * T_SEQ + tok0, T_SEQ, tid); ML_BAR_L();
        bf16x8 pf[4][2]; float dsum = 0.f;
#pragma unroll
        for (int kt = 0; kt < 4; ++kt) { if (kt <= qt) {
            f32x16 X;
#pragma unroll
            for (int i = 0; i < 16; ++i) X[i] = 0.f;
#pragma unroll 2
            for (int s = 0; s < 16; ++s) { const bf16x8 kf = *(const LAS bf16x8*)(TB + (32 * kt + kr) * 512 + (((2 * s + hh) ^ kx) << 4)), qf = *(const LAS bf16x8*)(TA + tq * 512 + (((2 * s + hh) ^ x) << 4)); X = MFMA32(kf, qf, X); }
            float P[16];
#pragma unroll
            for (int g8 = 0; g8 < 2; ++g8) { const int s0 = 32 * kt + 16 * g8 + 8 * hh; const f32x4v a0 = *(const LAS f32x4v*)(al + s0), a1 = *(const LAS f32x4v*)(al + s0 + 4);
#pragma unroll
                for (int e = 0; e < 8; ++e) { const float av = (e < 4) ? a0[e & 3] : a1[e & 3]; const float p = (s0 + e <= tq) ? X[8 * g8 + e] * __expf(av - Mt) : 0.f; P[8 * g8 + e] = p; dsum += p; } }
            pf[kt][0] = pack8(P); pf[kt][1] = pack8(P + 8); } }
        dsum += __shfl_xor(dsum, 32);
        ML_BAR_L(); ml_store<16>(TB, pre, tid); ML_BAR_L();
        uint2 ow[16];
#pragma unroll
        for (int j = 0; j < 16; ++j) ow[j] = *(const uint2*)(Z + tglob * NZ + Z_AO + h * 256 + 128 * dvh + 32 * (j >> 2) + 8 * (j & 3) + 4 * hh);
#pragma unroll
        for (int kt = 0; kt < 4; ++kt) { if (kt <= qt) {
#pragma unroll
            for (int s2 = 0; s2 < 2; ++s2)
#pragma unroll
                for (int dt = 0; dt < 4; ++dt) { const bf16x8 vf = *(const LAS bf16x8*)(TB + (128 * dvh + 32 * dt + r) * 256 + (((4 * kt + 2 * s2 + hh) ^ x) << 4)); acc[dt] = MFMA32(vf, pf[kt][s2], acc[dt]); } } }
        const float den = dsum + wi * qn, inv = 1.f / fmaxf(fabsf(den), emt);
        float ss = 0.f;
#pragma unroll
        for (int dt = 0; dt < 4; ++dt)
#pragma unroll
            for (int i = 0; i < 16; ++i) { acc[dt][i] *= inv; ss += acc[dt][i] * acc[dt][i]; }
        ss += __shfl_xor(ss, 32);
        if (hh == 0) xch[wave * 32 + r] = ss;
        ML_BAR();
        const float rs = rsqrtf((ss + xch[(wave ^ 1) * 32 + r]) * (1.f / 256.f) + RMS_EPS);
#pragma unroll
        for (int dt = 0; dt < 4; ++dt)
#pragma unroll
            for (int gq = 0; gq < 4; ++gq) { const int dv0 = 128 * dvh + 32 * dt + 8 * gq + 4 * hh;
                const uint2 o2 = ow[4 * dt + gq]; const f32x4v gg = *(const LAS f32x4v*)(gl + dv0);
                const float y0 = sigmoidf_(lo_bf(o2.x)) * acc[dt][4 * gq] * rs * gg[0], y1 = sigmoidf_(hi_bf(o2.x)) * acc[dt][4 * gq + 1] * rs * gg[1],
                            y2 = sigmoidf_(lo_bf(o2.y)) * acc[dt][4 * gq + 2] * rs * gg[2], y3 = sigmoidf_(hi_bf(o2.y)) * acc[dt][4 * gq + 3] * rs * gg[3];
                *(uint2*)(YA + tglob * 1024 + h * 256 + dv0) = make_uint2(pk_bf16(y0, y1), pk_bf16(y2, y3)); }
    }
    ML_BAR();
}
constexpr float MOBA_SCALE = 0.08838834764831845f;
__device__ __forceinline__ void moba_kmean(const bf16* __restrict__ Z, float* __restrict__ KMP) {
    int tid_ = threadIdx.x; asm volatile("" : "+v"(tid_));
    const int lane = tid_ & 63, wave = __builtin_amdgcn_readfirstlane(tid_ >> 6), gw = blockIdx.x * 8 + wave, nw = gridDim.x * 8;
    for (int u = gw; u < 512; u += nw) { const int h = u >> 6, n = (u >> 1) & 31, half = u & 1; float s[8];
#pragma unroll
        for (int e = 0; e < 8; ++e) s[e] = 0.f;
        const bf16* kp = Z + (size_t)(n * 256 + half * 128 + (lane >> 4)) * NZ + Z_BK + h * 128 + (lane & 15) * 8;
        uint4 kw[32];
#pragma unroll
        for (int j = 0; j < 32; ++j) kw[j] = *(const uint4*)(kp + (size_t)(4 * j) * NZ);
#pragma unroll
        for (int j = 0; j < 32; ++j) { const uint4 w = kw[j];
            s[0] += lo_bf(w.x); s[1] += hi_bf(w.x); s[2] += lo_bf(w.y); s[3] += hi_bf(w.y); s[4] += lo_bf(w.z); s[5] += hi_bf(w.z); s[6] += lo_bf(w.w); s[7] += hi_bf(w.w); }
#pragma unroll
        for (int e = 0; e < 8; ++e) { s[e] += __shfl_xor(s[e], 16); s[e] += __shfl_xor(s[e], 32); }
        if (lane < 16) { float* o = KMP + (size_t)u * 128 + lane * 8; *(float4*)o = make_float4(s[0], s[1], s[2], s[3]); *(float4*)(o + 4) = make_float4(s[4], s[5], s[6], s[7]); } }
}
__device__ __forceinline__ void top3_insert(float g, int n, float& v1, float& v2, float& v3, int& i1, int& i2, int& i3) {
    const bool b1 = (g > v1) || (g == v1 && n < i1), b2 = (g > v2) || (g == v2 && n < i2), b3 = (g > v3) || (g == v3 && n < i3);
    const float nv3 = b2 ? v2 : (b3 ? g : v3), nv2 = b1 ? v1 : (b2 ? g : v2), nv1 = b1 ? g : v1;
    const int ni3 = b2 ? i2 : (b3 ? n : i3), ni2 = b1 ? i1 : (b2 ? n : i2), ni1 = b1 ? n : i1;
    v1 = nv1; v2 = nv2; v3 = nv3; i1 = ni1; i2 = ni2; i3 = ni3;
}
__device__ __forceinline__ void moba_select(const bf16* __restrict__ Z, const float* __restrict__ KM, unsigned* __restrict__ SEL, float* __restrict__ PLSE, LAS unsigned char* lds) {
    int tid_ = threadIdx.x; asm volatile("" : "+v"(tid_));
    const int tid = tid_, lane = tid & 63, wave = __builtin_amdgcn_readfirstlane(tid >> 6), r = lane & 31, hh = lane >> 5;
    for (int U = blockIdx.x; U < 256; U += gridDim.x) { const int h = U & 7, qb = U >> 3; const size_t t = (size_t)qb * 256 + 32 * wave + r;
        asm volatile("s_waitcnt lgkmcnt(0)" ::: "memory"); __builtin_amdgcn_s_barrier();
        f32x16 X;
#pragma unroll
        for (int i = 0; i < 16; ++i) X[i] = 0.f;
        if (qb > 0) {
            bf16x8 qf[8];
            const bf16* qp = Z + t * NZ + Z_BQ + h * 128 + 8 * hh;
#pragma unroll
            for (int s = 0; s < 8; ++s) qf[s] = *(const bf16x8*)(qp + 16 * s);
            { int t_ = tid; asm volatile("" : "+v"(t_)); const int es = t_ >> 6, eh = (t_ >> 5) & 1, en = t_ & 31;
              const float* kq = KM + ((size_t)(h * 32 + en) * 2) * 128 + 16 * es + 8 * eh;
              const float4 a0 = *(const float4*)(kq), a1 = *(const float4*)(kq + 4), b0 = *(const float4*)(kq + 128), b1 = *(const float4*)(kq + 132);
              float km[8] = {(a0.x + b0.x) * (1.f / 256.f), (a0.y + b0.y) * (1.f / 256.f), (a0.z + b0.z) * (1.f / 256.f), (a0.w + b0.w) * (1.f / 256.f), (a1.x + b1.x) * (1.f / 256.f), (a1.y + b1.y) * (1.f / 256.f), (a1.z + b1.z) * (1.f / 256.f), (a1.w + b1.w) * (1.f / 256.f)};
              float hi[8], lo[8];
#pragma unroll
              for (int e = 0; e < 8; ++e) { hi[e] = __uint_as_float(__float_as_uint(km[e]) & 0xffff0000u); lo[e] = km[e] - hi[e]; }
              *(LAS bf16x8*)(lds + t_ * 16) = pack8(hi); *(LAS bf16x8*)(lds + 8192 + t_ * 16) = pack8(lo); }
            asm volatile("s_waitcnt lgkmcnt(0)" ::: "memory"); __builtin_amdgcn_s_barrier(); asm volatile("" ::: "memory");
#pragma unroll
            for (int s = 0; s < 8; ++s) { const bf16x8 ah = *(const LAS bf16x8*)(lds + ((s * 2 + hh) * 32 + r) * 16), al = *(const LAS bf16x8*)(lds + 8192 + ((s * 2 + hh) * 32 + r) * 16);
                X = MFMA32(ah, qf[s], X); X = MFMA32(al, qf[s], X); }
        }
        float v1 = -INFINITY, v2 = -INFINITY, v3 = -INFINITY; int i1 = 255, i2 = 255, i3 = 255;
#pragma unroll
        for (int i = 0; i < 16; ++i) { const int n = (i & 3) + 8 * (i >> 2) + 4 * hh; top3_insert((n < qb) ? X[i] : -INFINITY, (n < qb) ? n : 255, v1, v2, v3, i1, i2, i3); }
        const float p1 = __shfl_xor(v1, 32), p2 = __shfl_xor(v2, 32), p3 = __shfl_xor(v3, 32); const int j1 = __shfl_xor(i1, 32), j2 = __shfl_xor(i2, 32), j3 = __shfl_xor(i3, 32);
        top3_insert(p1, j1, v1, v2, v3, i1, i2, i3); top3_insert(p2, j2, v1, v2, v3, i1, i2, i3); top3_insert(p3, j3, v1, v2, v3, i1, i2, i3);
        if (hh == 0) { SEL[(size_t)h * T_SEQ + t] = (unsigned)i1 | ((unsigned)i2 << 8) | ((unsigned)i3 << 16);
            float* pl = PLSE + (t * 8 + h) * 3;
            if (i1 == 255) pl[0] = -INFINITY;
            if (i2 == 255) pl[1] = -INFINITY;
            if (i3 == 255) pl[2] = -INFINITY; }
    }
    asm volatile("s_waitcnt lgkmcnt(0)" ::: "memory"); __builtin_amdgcn_s_barrier();
}
__device__ __forceinline__ void moba_stage(const bf16* __restrict__ Z, const bf16* __restrict__ ZT, int h, int kb, LAS unsigned char* lds, int tid) {
    asm volatile("" : "+v"(tid));
    u32x4v kv[8], vv[8];
#pragma unroll
    for (int i = 0; i < 8; ++i) { const int idx = tid + 512 * i, row = idx >> 4, c = idx & 15; kv[i] = *(const u32x4v*)(Z + (size_t)(kb * 256 + row) * NZ + Z_BK + h * 128 + c * 8); }
#pragma unroll
    for (int i = 0; i < 8; ++i) { const int idx = tid + 512 * i, row = idx >> 5, c = idx & 31; vv[i] = *(const u32x4v*)(ZT + (size_t)(ZT_BV + h * 128 + row) * T_SEQ + kb * 256 + c * 8); }
#pragma unroll
    for (int i = 0; i < 8; ++i) { const int idx = tid + 512 * i, row = idx >> 4, c = idx & 15; *(LAS u32x4v*)(lds + row * 256 + ((c ^ (row & 15)) << 4)) = kv[i]; }
#pragma unroll
    for (int i = 0; i < 8; ++i) { const int idx = tid + 512 * i, row = idx >> 5, c = idx & 31; *(LAS u32x4v*)(lds + 65536 + row * 512 + ((c ^ (row & 15)) << 4)) = vv[i]; }
}
__device__ __forceinline__ void moba_tile(const bf16* __restrict__ Z, LAS unsigned char* lds, int h, int nkt, int diag, size_t tq, int qloc, int r, int hh, f32x16 (&acc)[4], float& m_out, float& l_out) {
    bf16x8 qf[8];
    const bf16* qp = Z + tq * NZ + Z_BQ + h * 128 + 8 * hh;
#pragma unroll
    for (int s = 0; s < 8; ++s) qf[s] = *(const bf16x8*)(qp + 16 * s);
#pragma unroll
    for (int dt = 0; dt < 4; ++dt)
#pragma unroll
        for (int i = 0; i < 16; ++i) acc[dt][i] = 0.f;
    float m = -1e30f, l = 0.f;
    const int kr = kperm(r), kx = kr & 15, vx = r & 15;
    for (int kt = 0; kt < nkt; ++kt) {
        f32x16 X;
#pragma unroll
        for (int i = 0; i < 16; ++i) X[i] = 0.f;
        LAS unsigned char* kb_ = lds + (32 * kt + kr) * 256;
#pragma unroll
        for (int s = 0; s < 8; ++s) { const bf16x8 kf = *(const LAS bf16x8*)(kb_ + (((2 * s + hh) ^ kx) << 4)); X = MFMA32(kf, qf[s], X); }
        float mx = -1e30f;
#pragma unroll
        for (int i = 0; i < 16; ++i) { float x = X[i] * MOBA_SCALE; if (kt == diag && (32 * kt + (i & 7) + 8 * hh + 16 * (i >> 3)) > qloc) x = -1e30f; X[i] = x; mx = fmaxf(mx, x); }
        mx = fmaxf(mx, __shfl_xor(mx, 32));
        const float mn = fmaxf(m, mx), alpha = __expf(m - mn);
        l *= alpha;
#pragma unroll
        for (int dt = 0; dt < 4; ++dt)
#pragma unroll
            for (int i = 0; i < 16; ++i) acc[dt][i] *= alpha;
        float P[16];
#pragma unroll
        for (int i = 0; i < 16; ++i) { const float p = (X[i] > -1e29f) ? __expf(X[i] - mn) : 0.f; P[i] = p; l += p; }
        m = mn;
#pragma unroll
        for (int s2 = 0; s2 < 2; ++s2) { const bf16x8 pf = pack8(P + 8 * s2);
#pragma unroll
            for (int dt = 0; dt < 4; ++dt) { const bf16x8 vf = *(const LAS bf16x8*)(lds + 65536 + (32 * dt + r) * 512 + (((4 * kt + 2 * s2 + hh) ^ vx) << 4)); acc[dt] = MFMA32(vf, pf, acc[dt]); } }
    }
    l += __shfl_xor(l, 32);
    m_out = m; l_out = l;
}
__device__ __forceinline__ void moba_tile_full(const bf16* __restrict__ Z, LAS unsigned char* lds, int h, size_t tq, int r, int hh, f32x16 (&acc)[4], float& m_out, float& l_out) {
    const int kr = kperm(r), kx = kr & 15, vx = r & 15;
    f32x16 X[8];
    { bf16x8 qf[8];
      const bf16* qp = Z + tq * NZ + Z_BQ + h * 128 + 8 * hh;
#pragma unroll
      for (int s = 0; s < 8; ++s) qf[s] = *(const bf16x8*)(qp + 16 * s);
#pragma unroll
      for (int kt = 0; kt < 8; ++kt) {
#pragma unroll
          for (int i = 0; i < 16; ++i) X[kt][i] = 0.f;
          LAS unsigned char* kb_ = lds + (32 * kt + kr) * 256;
#pragma unroll
          for (int s = 0; s < 8; ++s) { const bf16x8 kf = *(const LAS bf16x8*)(kb_ + (((2 * s + hh) ^ kx) << 4)); X[kt] = MFMA32(kf, qf[s], X[kt]); } } }
    float mx = -1e30f;
#pragma unroll
    for (int kt = 0; kt < 8; ++kt)
#pragma unroll
        for (int i = 0; i < 16; ++i) mx = fmaxf(mx, X[kt][i]);
    mx = fmaxf(mx, __shfl_xor(mx, 32));
    constexpr float C2 = MOBA_SCALE * 1.4426950408889634f; const float m2 = mx * C2; float l = 0.f;
    bf16x8 pf[8][2];
#pragma unroll
    for (int kt = 0; kt < 8; ++kt) { float P[16];
#pragma unroll
        for (int i = 0; i < 16; ++i) { const float p = __builtin_amdgcn_exp2f(X[kt][i] * C2 - m2); P[i] = p; l += p; }
        pf[kt][0] = pack8(P); pf[kt][1] = pack8(P + 8); }
#pragma unroll
    for (int dt = 0; dt < 4; ++dt)
#pragma unroll
        for (int i = 0; i < 16; ++i) acc[dt][i] = 0.f;
#pragma unroll
    for (int kt = 0; kt < 8; ++kt)
#pragma unroll
        for (int s2 = 0; s2 < 2; ++s2)
#pragma unroll
            for (int dt = 0; dt < 4; ++dt) { const bf16x8 vf = *(const LAS bf16x8*)(lds + 65536 + (32 * dt + r) * 512 + (((4 * kt + 2 * s2 + hh) ^ vx) << 4)); acc[dt] = MFMA32(vf, pf[kt][s2], acc[dt]); }
    l += __shfl_xor(l, 32);
    m_out = mx * MOBA_SCALE; l_out = l;
}
__device__ __forceinline__ void moba_tile_causal(const bf16x8 (&qf)[8], LAS unsigned char* lds, int r, int hh, int kd, f32x16 (&acc)[4], float& m_out, float& l_out) {
    const int kr = kperm(r), kx = kr & 15, vx = r & 15;
    f32x16 X[8];
#pragma unroll
    for (int kt = 0; kt < 8; ++kt) { if (kt <= kd) {
#pragma unroll
        for (int i = 0; i < 16; ++i) X[kt][i] = 0.f;
        LAS unsigned char* kb_ = lds + (32 * kt + kr) * 256;
#pragma unroll
        for (int s = 0; s < 8; ++s) { const bf16x8 kf = *(const LAS bf16x8*)(kb_ + (((2 * s + hh) ^ kx) << 4)); X[kt] = MFMA32(kf, qf[s], X[kt]); } } }
    float mx = -1e30f;
#pragma unroll
    for (int kt = 0; kt < 8; ++kt) { if (kt <= kd) {
#pragma unroll
        for (int i = 0; i < 16; ++i) { float x = X[kt][i]; if (kt == kd && ((i & 7) + 8 * hh + 16 * (i >> 3)) > r) x = -1e30f; X[kt][i] = x; mx = fmaxf(mx, x); } } }
    mx = fmaxf(mx, __shfl_xor(mx, 32));
    constexpr float C2 = MOBA_SCALE * 1.4426950408889634f; const float m2 = mx * C2; float l = 0.f;
    bf16x8 pf[8][2];
#pragma unroll
    for (int kt = 0; kt < 8; ++kt) { if (kt <= kd) { float P[16];
#pragma unroll
        for (int i = 0; i < 16; ++i) { const float p = (X[kt][i] > -1e29f) ? __builtin_amdgcn_exp2f(X[kt][i] * C2 - m2) : 0.f; P[i] = p; l += p; }
        pf[kt][0] = pack8(P); pf[kt][1] = pack8(P + 8); } }
#pragma unroll
    for (int dt = 0; dt < 4; ++dt)
#pragma unroll
        for (int i = 0; i < 16; ++i) acc[dt][i] = 0.f;
#pragma unroll
    for (int kt = 0; kt < 8; ++kt) { if (kt <= kd) {
#pragma unroll
        for (int s2 = 0; s2 < 2; ++s2)
#pragma unroll
            for (int dt = 0; dt < 4; ++dt) { const bf16x8 vf = *(const LAS bf16x8*)(lds + 65536 + (32 * dt + r) * 512 + (((4 * kt + 2 * s2 + hh) ^ vx) << 4)); acc[dt] = MFMA32(vf, pf[kt][s2], acc[dt]); } } }
    l += __shfl_xor(l, 32);
    m_out = mx * MOBA_SCALE; l_out = l;
}
constexpr int MOBA_SEGS = 9, MOBA_ITEMS_PER_HEAD = 98, MOBA_ITEMS = 8 * MOBA_ITEMS_PER_HEAD;
__device__ __forceinline__ void moba_gather(const bf16* __restrict__ Z, const bf16* __restrict__ ZT, const unsigned* __restrict__ SEL, bf16* __restrict__ PO, float* __restrict__ PLSE, unsigned* qctr, LAS unsigned char* lds) {
    int tid_ = threadIdx.x; asm volatile("" : "+v"(tid_));
    const int tid = tid_, lane = tid & 63, wave = __builtin_amdgcn_readfirstlane(tid >> 6), r = lane & 31, hh = lane >> 5;
    LAS unsigned* cntp = (LAS unsigned*)(lds + LDS_MISC + 2048); LAS unsigned* lst = (LAS unsigned*)(lds + LDS_MISC + 4096);
    LAS unsigned* itp = (LAS unsigned*)(lds + LDS_MISC + 2048 + 64);
    const unsigned hx = xb_xcc_id() & 7u; LAS unsigned* hsp = (LAS unsigned*)(lds + LDS_MISC + 2048 + 128);
    if (tid == 0) *hsp = 0u;
    for (;;) {
        __syncthreads();
        if (tid == 0) { unsigned hs = *hsp, kk = 0u;
            while (hs < 8u) { kk = __hip_atomic_fetch_add(qctr + ((hx + hs) & 7u), 1u, __ATOMIC_RELAXED, __HIP_MEMORY_SCOPE_AGENT); if (kk < (unsigned)MOBA_ITEMS_PER_HEAD) break; ++hs; }
            *hsp = hs; *itp = (hs < 8u) ? (kk * 8u + ((hx + hs) & 7u)) : 0x7fffffffu; }
        asm volatile("s_waitcnt vmcnt(0) lgkmcnt(0)" ::: "memory"); __syncthreads();
        const int it = (int)*itp; if (it >= MOBA_ITEMS) break;
        const int h = it & 7; int k = it >> 3, seg = 0, sa = 1, sb = 2;
        if (k < 76) { for (;;) { const int cnt = (sa < sb - 1) ? sa : sb - 1; if (k < cnt) break; k -= cnt; ++seg; sa = sb; sb = (seg < 3) ? sb + 1 : (seg < 5 ? sb + 2 : (seg < 7 ? sb + 4 : sb + 8)); } }
        else { k -= 76; for (;;) { const int cnt = (sb - 1 > sa) ? sb - 1 - sa : 0; if (k < cnt) break; k -= cnt; ++seg; sa = sb; sb = (seg < 3) ? sb + 1 : (seg < 5 ? sb + 2 : (seg < 7 ? sb + 4 : sb + 8)); } k += sa; }
        const int n = k, qa = (sa > n + 1) ? sa : n + 1;
        __syncthreads();
        moba_stage(Z, ZT, h, n, lds, tid);
        for (int base = qa * 256; base < sb * 256; base += 1024) {
            if (tid == 0) *cntp = 0u;
            asm volatile("s_waitcnt lgkmcnt(0)" ::: "memory"); __syncthreads();
#pragma unroll
            for (int sub = 0; sub < 2; ++sub) { const int t = base + sub * 512 + tid; int slot = -1;
                if (t < sb * 256) { const unsigned sel = SEL[(size_t)h * T_SEQ + t]; slot = ((sel & 0xffu) == (unsigned)n) ? 0 : ((((sel >> 8) & 0xffu) == (unsigned)n) ? 1 : ((((sel >> 16) & 0xffu) == (unsigned)n) ? 2 : -1)); }
                const unsigned long long bal = __ballot(slot >= 0); const int nb = __popcll(bal);
                unsigned wbase = 0u; if (lane == 0 && nb) wbase = __hip_atomic_fetch_add(cntp, (unsigned)nb, __ATOMIC_RELAXED, __HIP_MEMORY_SCOPE_WORKGROUP);
                wbase = __builtin_amdgcn_readfirstlane(wbase);
                if (slot >= 0) lst[wbase + __popcll(bal & ((1ull << lane) - 1ull))] = (unsigned)t | ((unsigned)slot << 16); }
            asm volatile("s_waitcnt lgkmcnt(0)" ::: "memory"); __syncthreads();
            const int count = (int)*cntp;
            for (int tb = wave * 32; tb < count; tb += 256) {
                const bool live = (tb + r) < count; const unsigned ent = lst[live ? tb + r : tb];
                const size_t tq = ent & 0xffffu; const int slot = (int)(ent >> 16);
                f32x16 acc[4]; float m, l;
                moba_tile_full(Z, lds, h, tq, r, hh, acc, m, l);
                const float inv = 1.f / l;
                if (live) { bf16* po = PO + (((size_t)tq * 8 + h) * 3 + slot) * 128;
#pragma unroll
                    for (int dt = 0; dt < 4; ++dt)
#pragma unroll
                        for (int gq = 0; gq < 4; ++gq) *(uint2*)(po + 32 * dt + 8 * gq + 4 * hh) = make_uint2(pk_bf16(acc[dt][4 * gq] * inv, acc[dt][4 * gq + 1] * inv), pk_bf16(acc[dt][4 * gq + 2] * inv, acc[dt][4 * gq + 3] * inv));
                    if (hh == 0) PLSE[((size_t)tq * 8 + h) * 3 + slot] = m + __logf(l); }
            }
            __syncthreads();
        }
    }
    __syncthreads();
}
__device__ __forceinline__ void moba_own(const bf16* __restrict__ Z, const bf16* __restrict__ ZT, const bf16* __restrict__ PO, const float* __restrict__ PLSE, bf16* __restrict__ YB, LAS unsigned char* lds) {
    int tid_ = threadIdx.x; asm volatile("" : "+v"(tid_));
    const int tid = tid_, lane = tid & 63, wave = __builtin_amdgcn_readfirstlane(tid >> 6), r = lane & 31, hh = lane >> 5;
    for (int it = blockIdx.x; it < 256; it += gridDim.x) { const int h = it & 7, qb = it >> 3, kd = wave < 4 ? wave : 11 - wave;
        __syncthreads();
        moba_stage(Z, ZT, h, qb, lds, tid);
        asm volatile("s_waitcnt lgkmcnt(0)" ::: "memory"); __syncthreads();
        const size_t tq = (size_t)qb * 256 + 32 * kd + r; const int qloc = 32 * kd + r;
        f32x16 acc[4]; float m, l;
        { bf16x8 qf[8]; const bf16* qp = Z + tq * NZ + Z_BQ + h * 128 + 8 * hh;
#pragma unroll
          for (int s = 0; s < 8; ++s) qf[s] = *(const bf16x8*)(qp + 16 * s);
          moba_tile_causal(qf, lds, r, hh, kd, acc, m, l); (void)qloc; }
        const float* pl = PLSE + (tq * 8 + h) * 3; const float e0 = pl[0], e1 = pl[1], e2 = pl[2];
        const float M = fmaxf(fmaxf(m, e0), fmaxf(e1, e2));
        const float wo = __expf(m - M), w0 = __expf(e0 - M), w1 = __expf(e1 - M), w2 = __expf(e2 - M), inv = 1.f / (l * wo + w0 + w1 + w2);
        const bf16* po = PO + ((tq * 8 + h) * 3) * 128;
        uint2 pp[3][16];
#pragma unroll
        for (int sl = 0; sl < 3; ++sl)
#pragma unroll
            for (int j = 0; j < 16; ++j) pp[sl][j] = *(const uint2*)(po + 128 * sl + 32 * (j >> 2) + 8 * (j & 3) + 4 * hh);
#pragma unroll
        for (int dt = 0; dt < 4; ++dt)
#pragma unroll
            for (int gq = 0; gq < 4; ++gq) { const int d0 = 32 * dt + 8 * gq + 4 * hh, j = 4 * dt + gq;
                float o0 = acc[dt][4 * gq] * wo, o1 = acc[dt][4 * gq + 1] * wo, o2 = acc[dt][4 * gq + 2] * wo, o3 = acc[dt][4 * gq + 3] * wo;
                { const uint2 p = pp[0][j]; const bool on = w0 > 0.f; o0 += on ? w0 * lo_bf(p.x) : 0.f; o1 += on ? w0 * hi_bf(p.x) : 0.f; o2 += on ? w0 * lo_bf(p.y) : 0.f; o3 += on ? w0 * hi_bf(p.y) : 0.f; }
                { const uint2 p = pp[1][j]; const bool on = w1 > 0.f; o0 += on ? w1 * lo_bf(p.x) : 0.f; o1 += on ? w1 * hi_bf(p.x) : 0.f; o2 += on ? w1 * lo_bf(p.y) : 0.f; o3 += on ? w1 * hi_bf(p.y) : 0.f; }
                { const uint2 p = pp[2][j]; const bool on = w2 > 0.f; o0 += on ? w2 * lo_bf(p.x) : 0.f; o1 += on ? w2 * hi_bf(p.x) : 0.f; o2 += on ? w2 * lo_bf(p.y) : 0.f; o3 += on ? w2 * hi_bf(p.y) : 0.f; }
                *(uint2*)(YB + tq * 1024 + h * 128 + d0) = make_uint2(pk_bf16(o0 * inv, o1 * inv), pk_bf16(o2 * inv, o3 * inv)); }
    }
    __syncthreads();
}

typedef const __attribute__((address_space(4))) MegaArgs* KArgs;
#define KP() ({ KArgs kp_ = kp0; asm volatile("" : "+s"(kp_)); kp_; })
__global__ void __launch_bounds__(512, 2) mega(MegaArgs a) {
    extern __shared__ __attribute__((aligned(16))) unsigned char lds_raw[];
    LAS unsigned char* lds = (LAS unsigned char*)lds_raw;
    volatile LAS unsigned* MISC = (volatile LAS unsigned*)(lds + LDS_MISC);
    for (int u = threadIdx.x; u < (LDS_BYTES - LDS_MISC) / 4; u += 512) ((LAS unsigned*)(lds + LDS_MISC))[u] = 0u;
    __syncthreads();
    const KArgs kp0 = (KArgs)__builtin_amdgcn_kernarg_segment_ptr();
    XcdBarrier bar = xcd_barrier_post((unsigned*)(a.ws + WS_CTL) + CW_BAR + a.li * XCD_BAR_WORDS, MISC + 8);
#define G_ ({ int g__ = (int)gridDim.x; asm volatile("" : "+s"(g__)); g__; })
#define c_ ({ int c__ = (int)blockIdx.x; asm volatile("" : "+s"(c__)); c__; })
#define IT(f) (KP()->items[it].f)
#define PH(k) (IT(p_lo) <= (k) && (k) < IT(p_hi))
    if (a.do_pro) { convert_range(kp0, lds, 0, CVT_PRO, c_, G_);
        phase_xinit(a.in[0], (float*)(a.ws + WS_X), (bf16*)(a.ws + WS_HN), (float*)(a.ws + WS_SCR + SC_SSQ)); xcd_barrier(bar); }
    for (int it = 0; it < kp0->n_items; ++it) {
        const int l = IT(l), hf = IT(hf), half = hf & 1;
        if (PH(1)) { KArgs kp = KP(); unsigned char* ws = kp->ws; unsigned char* lw = ws + WS_W + (size_t)l * LW_STRIDE;
            pg8::Gemm g{(const bf16*)(ws + WS_HN), (const bf16*)(lw + (half ? LW_GU2 : LW_GU1)), T_SEQ, NGU, DM}; pg8::StaticOrder S; S.init(T_SEQ, NGU, G_, c_);
            PG8_LAS float* tab = (PG8_LAS float*)(lds + LDS_MISC + 1024); int panel = -1; { pg8::Unit u0; if (S.next(0, u0)) { panel = u0.pm; pg8::rstd_table((const float*)(ws + WS_SCR + SC_SSQ), tab, panel, (int)threadIdx.x); } }
            pg8::EpiSwiGLU E{(bf16*)(ws + WS_HID), (const float*)(ws + WS_SCR + SC_SSQ), tab, DFF, panel}; pg8::gemm_phase<pg8::EpiSwiGLU, pg8::StaticOrder, true, true>(lds, g, S, E);
            { const int rem = ((T_SEQ / 256) * (NGU / 256)) % G_, q = 3 * l + (half ? 2 : 0), hi = cvt_slot_hi(q) < CVT_TOTAL ? cvt_slot_hi(q) : CVT_TOTAL;
              if (!(hf & 2) && rem && c_ >= rem && cvt_slot_lo(q) < hi) { KArgs kq = KP(); convert_range(kq, lds, cvt_slot_lo(q), hi, c_ - rem, G_ - rem); } }
            xcd_barrier(bar); }
        if (PH(2)) { KArgs kp = KP(); unsigned char* ws = kp->ws; unsigned char* lw = ws + WS_W + (size_t)l * LW_STRIDE;
            pg8::Gemm g{(const bf16*)(ws + WS_HID), (const bf16*)(lw + (half ? LW_D2 : LW_D1)), T_SEQ, DM, DFF}; pg8::StaticOrder S; S.init(T_SEQ, DM, G_, c_);
            pg8::EpiResAdd E{(float*)(ws + WS_X), (bf16*)(ws + WS_HN), (float*)(ws + WS_SCR + SC_SSQ), DM, (hf & 2) ? 0.f : 0.5f}; pg8::gemm_phase<pg8::EpiResAdd, pg8::StaticOrder, true, true>(lds, g, S, E); xcd_barrier(bar); }
        if (half == 0) {
            if (PH(4)) { KArgs kp = KP(); unsigned char* ws = kp->ws; unsigned char* lw = ws + WS_W + (size_t)l * LW_STRIDE;
                pg8::Gemm g{(const bf16*)(ws + WS_HN), (const bf16*)(lw + LW_IN), T_SEQ, NZP, DM}; pg8::ZOrder S; S.init(T_SEQ, NZP, G_, c_);
                PG8_LAS float* tab = (PG8_LAS float*)(lds + LDS_MISC + 1024); int panel = -1; { pg8::Unit u0; if (S.next(0, u0)) { panel = (u0.aux == 2) ? u0.pn : u0.pm; pg8::rstd_table((const float*)(ws + WS_SCR + SC_SSQ), tab, panel, (int)threadIdx.x); } }
                pg8::EpiZ E{(bf16*)(ws + WS_Z), (float*)(ws + WS_G), (bf16*)(ws + WS_ZT), (const float*)(ws + WS_SCR + SC_SSQ), tab, NZ, T_SEQ, panel, 0}; pg8::gemm_phase<pg8::EpiZ, pg8::ZOrder, true, true>(lds, g, S, E);
                { const int rem = ((T_SEQ / 256) * (NZP / 256)) % G_, q = 3 * l + 1, hi = cvt_slot_hi(q) < CVT_TOTAL ? cvt_slot_hi(q) : CVT_TOTAL;
                  if (!(hf & 2) && rem && c_ >= rem && cvt_slot_lo(q) < hi) { KArgs kq = KP(); convert_range(kq, lds, cvt_slot_lo(q), hi, c_ - rem, G_ - rem); } }
                xcd_barrier(bar); }
            if (PH(5)) {
                float lav[2][16], luv[2][16];
#if MIX_MOBA
                { KArgs kp = KP(); unsigned char* ws = kp->ws; moba_kmean((const bf16*)(ws + WS_Z), (float*)(ws + WS_SCR + SC_KM)); }
#endif
#if MIX_ML
                { KArgs kp = KP(); unsigned char* ws = kp->ws; ml_ktrans((const bf16*)(ws + WS_Z), (bf16*)(ws + WS_SCR + SC_AKT), lds); }
#endif
#if MIX_LRU
                { KArgs kp = KP(); unsigned char* ws = kp->ws; unsigned char* lw = ws + WS_W + (size_t)l * LW_STRIDE;
                  lru_pass<1>((const bf16*)(ws + WS_Z), (const bf16*)(lw + LW_LRU), kp->in[10] + (size_t)l * 4096, kp->in[11] + (size_t)l * 1024, kp->in[13] + (size_t)l * 1024, kp->in[15] + (size_t)l * 1024, kp->in[16] + (size_t)l * 1024,
                              (float2*)(ws + WS_SCR + SC_CARRY), (bf16*)(ws + WS_YC), (float*)(ws + WS_SCR + SC_LA), (float*)(ws + WS_SCR + SC_LU), lds, 256, 512); }
#endif
#if MIX_LRU
                { KArgs kp = KP(); unsigned char* ws = kp->ws; unsigned char* lw = ws + WS_W + (size_t)l * LW_STRIDE;
                  lru_unit<1>(c_, (const bf16*)(ws + WS_Z), (const bf16*)(lw + LW_LRU), kp->in[10] + (size_t)l * 4096, kp->in[11] + (size_t)l * 1024, kp->in[13] + (size_t)l * 1024, kp->in[15] + (size_t)l * 1024, kp->in[16] + (size_t)l * 1024,
                              (float2*)(ws + WS_SCR + SC_CARRY), (bf16*)(ws + WS_YC), lav, luv, lds); }
#endif
                xcd_barrier(bar);
            if (PH(6)) {
#if MIX_LRU
                { KArgs kp = KP(); unsigned char* ws = kp->ws; unsigned char* lw = ws + WS_W + (size_t)l * LW_STRIDE;
                  lru_unit<2>(c_, (const bf16*)(ws + WS_Z), (const bf16*)(lw + LW_LRU), kp->in[10] + (size_t)l * 4096, kp->in[11] + (size_t)l * 1024, kp->in[13] + (size_t)l * 1024, kp->in[15] + (size_t)l * 1024, kp->in[16] + (size_t)l * 1024,
                              (float2*)(ws + WS_SCR + SC_CARRY), (bf16*)(ws + WS_YC), lav, luv, lds); }
#endif
#if MIX_MOBA
                { KArgs kp = KP(); unsigned char* ws = kp->ws; unsigned char* sc = ws + WS_SCR; moba_select((const bf16*)(ws + WS_Z), (const float*)(sc + SC_KM), (unsigned*)(sc + SC_SEL), (float*)(sc + SC_PLSE), lds); }
#endif
#if MIX_ML
                { KArgs kp = KP(); unsigned char* ws = kp->ws; unsigned char* sc = ws + WS_SCR;
                  ml_local((const bf16*)(ws + WS_ZT), (const bf16*)(sc + SC_AKT), (const float*)(ws + WS_G), kp->in[7] + l * 4, kp->in[8] + l * 4, (float*)(sc + SC_LST), (float*)(sc + SC_NL), (float2*)(sc + SC_BG), lds); }
#endif
#if MIX_LRU
                { KArgs kp = KP(); unsigned char* ws = kp->ws; unsigned char* lw = ws + WS_W + (size_t)l * LW_STRIDE;
                  lru_pass<2>((const bf16*)(ws + WS_Z), (const bf16*)(lw + LW_LRU), kp->in[10] + (size_t)l * 4096, kp->in[11] + (size_t)l * 1024, kp->in[13] + (size_t)l * 1024, kp->in[15] + (size_t)l * 1024, kp->in[16] + (size_t)l * 1024,
                              (float2*)(ws + WS_SCR + SC_CARRY), (bf16*)(ws + WS_YC), (float*)(ws + WS_SCR + SC_LA), (float*)(ws + WS_SCR + SC_LU), lds, 256, 512); }
#endif
                xcd_barrier(bar); } }
            if (PH(7)) {
#if MIX_MOBA
                { KArgs kp = KP(); unsigned char* ws = kp->ws; unsigned char* sc = ws + WS_SCR; moba_gather((const bf16*)(ws + WS_Z), (const bf16*)(ws + WS_ZT), (const unsigned*)(sc + SC_SEL), (bf16*)(sc + SC_PO), (float*)(sc + SC_PLSE), (unsigned*)(ws + WS_CTL) + CW_Q + it * 8, lds); }
#endif
#if MIX_ML
                { KArgs kp = KP(); unsigned char* sc = kp->ws + WS_SCR;
                  ml_scan((const float*)(sc + SC_LST), (const float*)(sc + SC_NL), (const float2*)(sc + SC_BG), (bf16*)(sc + SC_CST), (float*)(sc + SC_NST), (float*)(sc + SC_MST)); }
#endif
                xcd_barrier(bar); }
            if (PH(8)) {
#if MIX_MOBA
                { KArgs kp = KP(); unsigned char* ws = kp->ws; unsigned char* sc = ws + WS_SCR; moba_own((const bf16*)(ws + WS_Z), (const bf16*)(ws + WS_ZT), (const bf16*)(sc + SC_PO), (const float*)(sc + SC_PLSE), (bf16*)(ws + WS_YB), lds); }
#endif
#if MIX_ML
                { KArgs kp = KP(); unsigned char* ws = kp->ws; unsigned char* sc = ws + WS_SCR;
                  ml_out((const bf16*)(ws + WS_Z), (const bf16*)(ws + WS_ZT), (const float*)(ws + WS_G), kp->in[7] + l * 4, kp->in[8] + l * 4, (const bf16*)(sc + SC_CST), (const float*)(sc + SC_NST), (const float*)(sc + SC_MST),
                         kp->in[9] + (size_t)l * 1024, (bf16*)(ws + WS_YA), lds); }
#endif
                xcd_barrier(bar); }
            if (PH(9)) { KArgs kp = KP(); unsigned char* ws = kp->ws; unsigned char* lw = ws + WS_W + (size_t)l * LW_STRIDE;
                pg8::Gemm g{(const bf16*)(ws + WS_YA), (const bf16*)(lw + LW_UPA), T_SEQ, DM, 1024}; pg8::MergeOrder S; S.init(T_SEQ, DM, G_, c_); static_assert(SZ_Y / 2 == pg8::MergeOrder::astride && SZ_WUP / 2 == pg8::MergeOrder::bstride, "MergeOrder strides");
                pg8::EpiMerge E{(bf16*)(ws + WS_MG), (const bf16*)(ws + WS_Z) + Z_GA}; static_assert(DM == 2048 && NZ == 13312, "EpiMerge pitches"); pg8::gemm_phase<pg8::EpiMerge, pg8::MergeOrder, true, true>(lds, g, S, E); xcd_barrier(bar); }
            if (PH(10)) { KArgs kp = KP(); unsigned char* ws = kp->ws; unsigned char* lw = ws + WS_W + (size_t)l * LW_STRIDE;
                pg8::Gemm g{(const bf16*)(ws + WS_MG), (const bf16*)(lw + LW_OUT), T_SEQ, DM, DM}; pg8::StaticOrder S; S.init(T_SEQ, DM, G_, c_);
                pg8::EpiResAdd E{(float*)(ws + WS_X), (bf16*)(ws + WS_HN), (float*)(ws + WS_SCR + SC_SSQ), DM, (hf & 2) ? 0.f : 1.0f}; pg8::gemm_phase<pg8::EpiResAdd, pg8::StaticOrder, true, true>(lds, g, S, E); xcd_barrier(bar); }
        }
    }
    if (a.do_fin) phase_final((const bf16*)(a.ws + WS_HN), a.in[25], a.out);
#undef PH
#undef IT
#undef G_
#undef c_
}
extern "C" void kernel_launch(void* const* d_in, const int* in_sizes, int n_in, void* d_out, int out_size, void* d_ws, size_t ws_size, hipStream_t stream) {
    if (n_in != 26 || out_size != T_SEQ * DM || ws_size < WS_END) { fprintf(stderr, "kernel_launch: unexpected problem (n_in %d out %d ws %zu need %zu)\n", n_in, out_size, ws_size, (size_t)WS_END); return; }
    static int grid = 0;
    if (!grid) { int dev = 0, cus = 0, per_cu = 0; (void)hipGetDevice(&dev); (void)hipDeviceGetAttribute(&cus, hipDeviceAttributeMultiprocessorCount, dev);
        (void)hipFuncSetAttribute((const void*)mega, hipFuncAttributeMaxDynamicSharedMemorySize, LDS_BYTES);
        if (hipOccupancyMaxActiveBlocksPerMultiprocessor(&per_cu, (const void*)mega, 512, LDS_BYTES) != hipSuccess || per_cu < 1) fprintf(stderr, "kernel_launch: occupancy query reports %d blocks per CU\n", per_cu);
        (void)hipGetLastError();
        grid = 256; if (cus != 256) fprintf(stderr, "kernel_launch: built for 256 CUs (one workgroup per CU), device reports %d\n", cus); }
    unsigned char* ws = (unsigned char*)d_ws;
    (void)hipMemsetAsync(ws + WS_CTL, 0, CTL_BYTES, stream);
    MegaArgs a; memset(&a, 0, sizeof a); for (int i = 0; i < 26; ++i) a.in[i] = (const float*)d_in[i]; a.out = (float*)d_out; a.ws = ws;
    a.do_pro = 1; a.do_fin = 1; a.li = 0; int n = 0;
    for (int l = 0; l < NLAYER; ++l) {
        a.items[n++] = PItem{l, 0, 0, 11};
#ifdef DUP_LO
        a.items[n++] = PItem{l, 2 | DUP_HF, DUP_LO, DUP_HI};
#endif
        a.items[n++] = PItem{l, 1, 0, 11}; }
    a.n_items = n;
    hipLaunchKernelGGL(mega, dim3(grid), dim3(512), LDS_BYTES, stream, a);
}
```
